# Optimizing an MI355X kernel written in HIP

```python
import jax
import jax.numpy as jnp
from jax import lax
import numpy as np

D_MODEL = 1024
BATCH = 8
SEQ = 4096
DEPTH = 4

HEAD_DIM = 64
FOX_HEADS = 4
SWA_HEADS = 8
SWA_KV_HEADS = 2
SWA_WINDOW = 128
MOBA_HEADS = 4
MOBA_BLOCK = 256
MOBA_TOPK = 3
MOBA_Q_CHUNK = 64
Q_BLOCK = 128
N_BRANCH = 3
ALIBI_HEADS = SWA_HEADS + MOBA_HEADS
N_EXPERTS = 32
TOP_K = 4
D_EXPERT = D_MODEL
SWIGLU_ALPHA = 1.702
SWIGLU_LIMIT = 7.0
EPS = 1e-6
NEG = -1e30
W_FOX = FOX_HEADS * HEAD_DIM
W_SWA = SWA_HEADS * HEAD_DIM
W_SWA_KV = SWA_KV_HEADS * HEAD_DIM
W_MOBA = MOBA_HEADS * HEAD_DIM
IN_SPLITS = (W_FOX, W_FOX, W_FOX, FOX_HEADS, W_SWA, W_SWA_KV, W_SWA_KV, W_MOBA, W_MOBA, W_MOBA, N_BRANCH * D_MODEL)
D_IN = sum(IN_SPLITS)

kernel_name = 'hybrid_fox_swa_moba_moe_block'


def rms_norm(x, gain):
    xf = x.astype(jnp.float32)
    y = xf * lax.rsqrt(jnp.mean(xf * xf, axis=-1, keepdims=True) + EPS)
    return (y * gain.astype(jnp.float32)).astype(x.dtype)


def alibi_slopes(n):
    return jnp.exp2(-8.0 * jnp.arange(1, n + 1, dtype=jnp.float32) / n)


def fox_attention(q, k, v, log_f):
    b, s, h, d = q.shape
    nq = s // Q_BLOCK
    cum = jnp.cumsum(log_f, axis=1).transpose(0, 2, 1)
    q_blocks = q.reshape(b, nq, Q_BLOCK, h, d).transpose(1, 0, 2, 3, 4)
    c_blocks = cum.reshape(b, h, nq, Q_BLOCK).transpose(2, 0, 1, 3)
    k_pos = jnp.arange(s)

    def block(args):
        i, q_i, c_i = args
        logits = jnp.einsum('bqhd,bkhd->bhqk', q_i, k, preferred_element_type=jnp.float32) * HEAD_DIM ** -0.5
        logits = logits + (c_i[..., :, None] - cum[:, :, None, :])
        q_pos = i * Q_BLOCK + jnp.arange(Q_BLOCK)
        logits = jnp.where(k_pos[None, :] <= q_pos[:, None], logits, NEG)
        p = jax.nn.softmax(logits, axis=-1).astype(v.dtype)
        return jnp.einsum('bhqk,bkhd->bqhd', p, v)

    out = lax.map(block, (jnp.arange(nq), q_blocks, c_blocks))
    return out.transpose(1, 0, 2, 3, 4).reshape(b, s, h, d)


def swa_attention(q, k, v, sinks, slopes):
    b, s, hq, d = q.shape
    hkv = k.shape[2]
    g = hq // hkv
    w = SWA_WINDOW
    nb = s // w
    q_b = q.reshape(b, nb, w, hkv, g, d)

    def band(t):
        t_b = t.reshape(b, nb, w, hkv, d)
        prev = jnp.pad(t_b, ((0, 0), (1, 0), (0, 0), (0, 0), (0, 0)))[:, :-1]
        return jnp.concatenate([prev, t_b], axis=2)

    k_b, v_b = band(k), band(v)
    logits = jnp.einsum('bnqhgd,bnkhd->bnhgqk', q_b, k_b, preferred_element_type=jnp.float32) * HEAD_DIM ** -0.5
    dist = (jnp.arange(w)[:, None] + w - jnp.arange(2 * w)[None, :]).astype(jnp.float32)
    in_window = (dist >= 0) & (dist < w)
    has_prev = (jnp.arange(nb) > 0)[:, None, None] | (jnp.arange(2 * w) >= w)[None, None, :]
    valid = in_window[None] & has_prev
    logits = logits - slopes.reshape(hkv, g, 1, 1) * dist
    logits = jnp.where(valid[None, :, None, None], logits, NEG)
    sink = jnp.broadcast_to(sinks.astype(jnp.float32).reshape(hkv, g, 1, 1), logits.shape[:-1] + (1,))
    p = jax.nn.softmax(jnp.concatenate([logits, sink], axis=-1), axis=-1)[..., :-1].astype(v.dtype)
    out = jnp.einsum('bnhgqk,bnkhd->bnqhgd', p, v_b)
    return out.reshape(b, s, hq, d)


def moba_attention(q, k, v, slopes):
    b, s, h, d = q.shape
    n_blk = max(-(-s // MOBA_BLOCK), MOBA_TOPK)
    s_pad = n_blk * MOBA_BLOCK
    pad = ((0, 0), (0, s_pad - s), (0, 0), (0, 0))
    q, k, v = jnp.pad(q, pad), jnp.pad(k, pad), jnp.pad(v, pad)
    k_blk = k.reshape(b, n_blk, MOBA_BLOCK, h, d).transpose(0, 3, 1, 2, 4)
    v_blk = v.reshape(b, n_blk, MOBA_BLOCK, h, d).transpose(0, 3, 1, 2, 4)
    k_mean = jnp.mean(k_blk.astype(jnp.float32), axis=3)
    nc = s_pad // MOBA_Q_CHUNK
    q_chunks = q.reshape(b, nc, MOBA_Q_CHUNK, h, d).transpose(1, 0, 3, 2, 4)
    gather = jax.vmap(jax.vmap(lambda blocks, ix: blocks[ix]))
    offsets = jnp.arange(MOBA_BLOCK)
    n_sel = MOBA_TOPK * MOBA_BLOCK
    scale = HEAD_DIM ** -0.5

    def chunk(args):
        i, q_i = args
        q_pos = i * MOBA_Q_CHUNK + jnp.arange(MOBA_Q_CHUNK)
        own = (i * MOBA_Q_CHUNK) // MOBA_BLOCK
        gate = jnp.einsum('bhqd,bhnd->bhqn', q_i.astype(jnp.float32), k_mean)
        gate = jnp.where(jnp.arange(n_blk) < own, gate, NEG)
        _, idx = lax.top_k(gate, MOBA_TOPK)
        k_sel = gather(k_blk, idx)
        v_sel = gather(v_blk, idx)
        l_sel = jnp.einsum('bhqd,bhqjkd->bhqjk', q_i, k_sel, preferred_element_type=jnp.float32) * scale
        dist_sel = (q_pos[:, None, None] - (idx[..., None] * MOBA_BLOCK + offsets)).astype(jnp.float32)
        l_sel = l_sel - slopes[None, :, None, None, None] * dist_sel
        l_sel = jnp.where((jnp.arange(MOBA_TOPK) < own)[:, None], l_sel, NEG)
        k_own = lax.dynamic_index_in_dim(k_blk, own, axis=2, keepdims=False)
        v_own = lax.dynamic_index_in_dim(v_blk, own, axis=2, keepdims=False)
        l_own = jnp.einsum('bhqd,bhkd->bhqk', q_i, k_own, preferred_element_type=jnp.float32) * scale
        dist_own = (q_pos[:, None] - (own * MOBA_BLOCK + offsets)[None, :]).astype(jnp.float32)
        l_own = jnp.where(dist_own >= 0, l_own - slopes[None, :, None, None] * dist_own, NEG)
        logits = jnp.concatenate([l_sel.reshape(b, h, MOBA_Q_CHUNK, n_sel), l_own], axis=-1)
        p = jax.nn.softmax(logits, axis=-1).astype(v_blk.dtype)
        p_sel = p[..., :n_sel].reshape(b, h, MOBA_Q_CHUNK, MOBA_TOPK, MOBA_BLOCK)
        return (jnp.einsum('bhqjk,bhqjkd->bhqd', p_sel, v_sel)
                + jnp.einsum('bhqk,bhkd->bhqd', p[..., n_sel:], v_own))

    out = lax.map(chunk, (jnp.arange(nc), q_chunks))
    return out.transpose(1, 0, 3, 2, 4).reshape(b, s_pad, h, d)[:, :s]


def hybrid_mixer(h, w_in, b_f, qk_gain, sinks, w_br_fox, w_br_swa, w_br_moba, w_out, slopes_swa, slopes_moba):
    b, s, _ = h.shape
    proj = h @ w_in
    points = np.cumsum(IN_SPLITS)[:-1].tolist()
    qa, ka, va, fa, qb, kb, vb, qc, kc, vc, gates = jnp.split(proj, points, axis=-1)
    heads = lambda t: t.reshape(b, s, -1, HEAD_DIM)
    log_f = jax.nn.log_sigmoid(fa.astype(jnp.float32) + b_f.astype(jnp.float32))
    o_a = fox_attention(rms_norm(heads(qa), qk_gain[0]), rms_norm(heads(ka), qk_gain[1]), heads(va), log_f)
    o_b = swa_attention(rms_norm(heads(qb), qk_gain[2]), rms_norm(heads(kb), qk_gain[3]), heads(vb), sinks, slopes_swa)
    o_c = moba_attention(rms_norm(heads(qc), qk_gain[4]), rms_norm(heads(kc), qk_gain[5]), heads(vc), slopes_moba)
    y_a = o_a.reshape(b, s, W_FOX) @ w_br_fox
    y_b = o_b.reshape(b, s, W_SWA) @ w_br_swa
    y_c = o_c.reshape(b, s, W_MOBA) @ w_br_moba
    g_a, g_b, g_c = jnp.split(jax.nn.sigmoid(gates), N_BRANCH, axis=-1)
    return (g_a * y_a + g_b * y_b + g_c * y_c) @ w_out


def clamped_swiglu(u):
    x_glu, x_lin = u[..., ::2], u[..., 1::2]
    x_glu = jnp.minimum(x_glu, SWIGLU_LIMIT)
    x_lin = jnp.clip(x_lin, -SWIGLU_LIMIT, SWIGLU_LIMIT)
    return x_glu * jax.nn.sigmoid(SWIGLU_ALPHA * x_glu) * (x_lin + 1.0)


def moe_ffn(h, w_router, b_router, w1, b1, w2, b2):
    b, s, d = h.shape
    t = h.reshape(b * s, d)
    logits = (t @ w_router + b_router).astype(jnp.float32)
    top_vals, top_idx = lax.top_k(logits, TOP_K)
    top_w = jax.nn.softmax(top_vals, axis=-1)
    gates = jnp.sum(jax.nn.one_hot(top_idx, N_EXPERTS, dtype=jnp.float32) * top_w[..., None], axis=1).astype(t.dtype)
    out = jnp.zeros_like(t)
    for e in range(N_EXPERTS):
        y = clamped_swiglu(t @ w1[e] + b1[e]) @ w2[e] + b2[e]
        out = out + gates[:, e:e + 1] * y
    return out.reshape(b, s, d)


def setup_inputs(seed: int = 0) -> dict:
    key = jax.random.key(seed)
    ks = jax.random.split(key, 20)
    f32 = jnp.float32
    nrm = lambda k, shape, sc: jax.random.normal(k, shape, f32) * sc
    return {
        'x': nrm(ks[0], (BATCH, SEQ, D_MODEL), 1.0),
        'c': nrm(ks[1], (BATCH, D_MODEL), 1.0),
        'w_ada': nrm(ks[2], (DEPTH, D_MODEL, 6 * D_MODEL), 0.5 * D_MODEL ** -0.5),
        'b_ada': nrm(ks[3], (DEPTH, 6 * D_MODEL), 0.02),
        'norm_gain': 1.0 + nrm(ks[4], (DEPTH, 2, D_MODEL), 0.02),
        'w_in': nrm(ks[5], (DEPTH, D_MODEL, D_IN), D_MODEL ** -0.5),
        'b_fgate': 2.0 + nrm(ks[6], (DEPTH, FOX_HEADS), 0.1),
        'qk_gain': 1.0 + nrm(ks[7], (DEPTH, 6, HEAD_DIM), 0.02),
        'attn_sinks': nrm(ks[8], (DEPTH, SWA_HEADS), 0.5),
        'w_br_fox': nrm(ks[9], (DEPTH, W_FOX, D_MODEL), W_FOX ** -0.5),
        'w_br_swa': nrm(ks[10], (DEPTH, W_SWA, D_MODEL), W_SWA ** -0.5),
        'w_br_moba': nrm(ks[11], (DEPTH, W_MOBA, D_MODEL), W_MOBA ** -0.5),
        'w_out': nrm(ks[12], (DEPTH, D_MODEL, D_MODEL), D_MODEL ** -0.5),
        'w_router': nrm(ks[13], (DEPTH, D_MODEL, N_EXPERTS), D_MODEL ** -0.5),
        'b_router': nrm(ks[14], (DEPTH, N_EXPERTS), 0.01),
        'w_exp1': nrm(ks[15], (DEPTH, N_EXPERTS, D_MODEL, 2 * D_EXPERT), D_MODEL ** -0.5),
        'b_exp1': nrm(ks[16], (DEPTH, N_EXPERTS, 2 * D_EXPERT), 0.01),
        'w_exp2': nrm(ks[17], (DEPTH, N_EXPERTS, D_EXPERT, D_MODEL), D_EXPERT ** -0.5),
        'b_exp2': nrm(ks[18], (DEPTH, N_EXPERTS, D_MODEL), 0.01),
    }


def reference(x, c, w_ada, b_ada, norm_gain, w_in, b_fgate, qk_gain, attn_sinks, w_br_fox, w_br_swa, w_br_moba, w_out, w_router, b_router, w_exp1, b_exp1, w_exp2, b_exp2):
    slopes = alibi_slopes(ALIBI_HEADS)
    slopes_swa, slopes_moba = slopes[:SWA_HEADS], slopes[SWA_HEADS:]
    cond = jax.nn.silu(c)
    for l in range(DEPTH):
        mod = cond @ w_ada[l] + b_ada[l]
        sh1, sc1, g1, sh2, sc2, g2 = jnp.split(mod[:, None, :], 6, axis=-1)
        h = rms_norm(x, norm_gain[l, 0]) * (1.0 + sc1) + sh1
        x = x + g1 * hybrid_mixer(h, w_in[l], b_fgate[l], qk_gain[l], attn_sinks[l], w_br_fox[l], w_br_swa[l], w_br_moba[l], w_out[l], slopes_swa, slopes_moba)
        h = rms_norm(x, norm_gain[l, 1]) * (1.0 + sc2) + sh2
        x = x + g2 * moe_ffn(h, w_router[l], b_router[l], w_exp1[l], b_exp1[l], w_exp2[l], b_exp2[l])
    return x
```

```cpp
#include <hip/hip_runtime.h>
#include <stdint.h>
#include <stdio.h>
#include <string.h>

typedef unsigned short bf16_t;
typedef short bf16x8 __attribute__((ext_vector_type(8)));
typedef float f32x4 __attribute__((ext_vector_type(4)));
typedef float f32x16 __attribute__((ext_vector_type(16)));
typedef unsigned u32x4 __attribute__((ext_vector_type(4)));
typedef unsigned u32x2 __attribute__((ext_vector_type(2)));

constexpr int NB = 8, S = 4096, T = NB * S, D = 1024, NL = 4, DIN = 5380, PW = 5376, NE = 32, CAP = 32768;
constexpr int ROWS_MAX = T * 4 + NE * 256;
constexpr float EPS = 1e-6f;
constexpr float LOG2E = 1.4426950408889634f;
constexpr float C2 = 0.125f * LOG2E;
constexpr int FQ = 0, FK = 256, FV = 512, SQ = 768, SK = 1280, SV = 1408, MQ = 1536, MK = 1792, MV = 2048, GA = 2304, GB = 3328, GC = 4352;
enum { I_X = 0, I_C, I_WADA, I_BADA, I_NGAIN, I_WIN, I_BF, I_QKG, I_SINK, I_WBF, I_WBS, I_WBM, I_WOUT, I_WR, I_BR, I_W1, I_B1, I_W2, I_B2 };

constexpr size_t MiB = 1ull << 20;
constexpr size_t WS_CTL = 0, CTL_BYTES = 2 * MiB;
constexpr size_t CTL_CNT = 64 * 1024;
constexpr size_t CTL_KMEAN = 1 * MiB;
constexpr size_t WS_MOD = 2 * MiB;
constexpr size_t WS_LF = 3 * MiB;
constexpr size_t WS_CUM = 4 * MiB;
constexpr size_t WS_TOKE = 5 * MiB;
constexpr size_t WS_TOKP = 6 * MiB;
constexpr size_t WS_LIST = 8 * MiB;
constexpr size_t WS_LISTW = 12 * MiB;
constexpr size_t WS_H = 16 * MiB;
constexpr size_t WS_OCAT = 80 * MiB;
constexpr size_t WS_MERGED = 144 * MiB;
constexpr size_t WS_PROJ = 208 * MiB;
constexpr size_t WS_A2 = 544 * MiB;
constexpr size_t WS_Y = 816 * MiB;
constexpr size_t WS_NAIVE = 1088 * MiB;
constexpr size_t WS_WT = 2304 * MiB;
constexpr size_t WS_END = WS_WT + 4 * 216 * MiB;

__device__ __forceinline__ unsigned f2bf(float f) { unsigned u = __float_as_uint(f); return (u + 0x7fffu + ((u >> 16) & 1u)) >> 16; }
__device__ __forceinline__ float bf2f(unsigned b) { return __uint_as_float(b << 16); }
__device__ __forceinline__ unsigned pk2(float lo, float hi) { return f2bf(lo) | (f2bf(hi) << 16); }
__device__ __forceinline__ float wave_sum(float v) {
#pragma unroll
    for (int o = 1; o < 64; o <<= 1) v += __shfl_xor(v, o);
    return v;
}
__device__ __forceinline__ float wave_max(float v) {
#pragma unroll
    for (int o = 1; o < 64; o <<= 1) v = fmaxf(v, __shfl_xor(v, o));
    return v;
}
__device__ __forceinline__ float alibi_slope(int i) { return exp2f(-8.0f * (float)(i + 1) / 12.0f); }
__device__ __forceinline__ float sigmoidf_(float x) { return 1.0f / (1.0f + __expf(-x)); }

__device__ __forceinline__ void seg_build(const int* cnt, int* seg) {
    int a = 0;
    for (int e = 0; e < NE; ++e) { seg[e] = a; a += (cnt[e] + 255) & ~255; }
    seg[NE] = a;
}

__global__ void __launch_bounds__(256) k_mod(const float* __restrict__ c, const float* __restrict__ w_ada, const float* __restrict__ b_ada, float* __restrict__ mod) {
    __shared__ float sc[NB * D];
    for (int i = threadIdx.x; i < NB * D; i += 256) { const float v = c[i]; sc[i] = v / (1.0f + __expf(-v)); }
    __syncthreads();
    const int col = blockIdx.x * 256 + threadIdx.x;
    const int l = col / 6144, j = col % 6144;
    const float* w = w_ada + (size_t)l * D * 6144 + j;
    float acc[NB];
#pragma unroll
    for (int b = 0; b < NB; ++b) acc[b] = 0.f;
#pragma unroll 4
    for (int k = 0; k < D; ++k) { const float wv = w[(size_t)k * 6144];
#pragma unroll
        for (int b = 0; b < NB; ++b) acc[b] += sc[b * D + k] * wv; }
    const float bv = b_ada[l * 6144 + j];
#pragma unroll
    for (int b = 0; b < NB; ++b) mod[(size_t)(l * NB + b) * 6144 + j] = acc[b] + bv;
}

struct NormP {
    const float* xin;
    float* X;
    bf16_t* H;
    const float* mod;
    const float* modprev;
    const float* gain;
    const bf16_t* Y; const int* toke; const int* tokp; const int* cntprev;
    const float* wf;
    const float* bf;
    float* lf;
    const float* wr; const float* br;
    int* cnt; int* toke_o; int* tokp_o; int* list; float* listw;
};

template <int MODE>
__device__ __forceinline__ void norm_row(const NormP& p, int t, int lane, const int* seg  ) {
    const int b = t / S, s = t % S;
    f32x4 v[4];
    const f32x4* xr = (const f32x4*)(p.xin + (size_t)t * D) + lane;
#pragma unroll
    for (int j = 0; j < 4; ++j) v[j] = xr[64 * j];
    if (MODE != 1 && p.modprev) {
        f32x4 a[4];
#pragma unroll
        for (int j = 0; j < 4; ++j) a[j] = (f32x4){0.f, 0.f, 0.f, 0.f};
#pragma unroll
        for (int kk = 0; kk < 4; ++kk) {
            const int e = p.toke[t * 4 + kk], pos = p.tokp[t * 4 + kk];
            const u32x2* yr = (const u32x2*)(p.Y + (size_t)(seg[e] + pos) * D) + lane;
#pragma unroll
            for (int j = 0; j < 4; ++j) { const u32x2 w = yr[64 * j];
                a[j][0] += bf2f(w.x & 0xffffu); a[j][1] += bf2f(w.x >> 16); a[j][2] += bf2f(w.y & 0xffffu); a[j][3] += bf2f(w.y >> 16); }
        }
        const f32x4* g2 = (const f32x4*)(p.modprev + (size_t)b * 6144 + 5 * D) + lane;
#pragma unroll
        for (int j = 0; j < 4; ++j) v[j] += g2[64 * j] * a[j];
    }
    if (MODE != 1) {
        f32x4* xo = (f32x4*)(p.X + (size_t)t * D) + lane;
#pragma unroll
        for (int j = 0; j < 4; ++j) xo[64 * j] = v[j];
    }
    if (MODE == 2) return;
    float ss = 0.f;
#pragma unroll
    for (int j = 0; j < 4; ++j) ss += (v[j][0] * v[j][0] + v[j][1] * v[j][1]) + (v[j][2] * v[j][2] + v[j][3] * v[j][3]);
    ss = wave_sum(ss);
    const float r = rsqrtf(ss * (1.0f / D) + EPS);
    const int off = (MODE == 0) ? 0 : 3 * D;
    const f32x4* sh = (const f32x4*)(p.mod + (size_t)b * 6144 + off) + lane;
    const f32x4* sc = (const f32x4*)(p.mod + (size_t)b * 6144 + off + D) + lane;
    const f32x4* gn = (const f32x4*)p.gain + lane;
    u32x2* ho = (u32x2*)(p.H + (size_t)t * D) + lane;
#pragma unroll
    for (int j = 0; j < 4; ++j) {
        const f32x4 g = gn[64 * j], c1 = sc[64 * j], s1 = sh[64 * j];
        v[j] = (v[j] * r) * g * (1.0f + c1) + s1;
        u32x2 w; w.x = pk2(v[j][0], v[j][1]); w.y = pk2(v[j][2], v[j][3]); ho[64 * j] = w;
    }
    if (MODE == 0) {
        float f0 = 0.f, f1 = 0.f, f2 = 0.f, f3 = 0.f;
#pragma unroll
        for (int j = 0; j < 4; ++j)
#pragma unroll
            for (int i = 0; i < 4; ++i) { const int k = 4 * lane + 256 * j + i; const f32x4 w = *(const f32x4*)(p.wf + (size_t)k * DIN);
                f0 += v[j][i] * w[0]; f1 += v[j][i] * w[1]; f2 += v[j][i] * w[2]; f3 += v[j][i] * w[3]; }
        f0 = wave_sum(f0); f1 = wave_sum(f1); f2 = wave_sum(f2); f3 = wave_sum(f3);
        if (lane < 4) { float z = (lane == 0 ? f0 : lane == 1 ? f1 : lane == 2 ? f2 : f3) + p.bf[lane];
            const float ls = fminf(z, 0.f) - log1pf(__expf(-fabsf(z)));
            p.lf[(size_t)(b * 4 + lane) * S + s] = ls; }
    }
    if (MODE == 1) {
        float mine = 0.f;
        for (int e = 0; e < NE; ++e) {
            float a = 0.f;
#pragma unroll
            for (int j = 0; j < 4; ++j)
#pragma unroll
                for (int i = 0; i < 4; ++i) { const int k = 4 * lane + 256 * j + i; a += v[j][i] * p.wr[(size_t)k * NE + e]; }
            a = wave_sum(a);
            if (lane == e) mine = a + p.br[e];
        }
        float val = (lane < NE) ? mine : -INFINITY;
        float tv[4]; int te[4];
#pragma unroll
        for (int kk = 0; kk < 4; ++kk) {
            const float m = wave_max(val);
            const unsigned long long bal = __ballot(val == m);
            const int idx = __ffsll((long long)bal) - 1;
            tv[kk] = m; te[kk] = idx;
            if (lane == idx) val = -INFINITY;
        }
        float w[4], sum = 0.f;
#pragma unroll
        for (int kk = 0; kk < 4; ++kk) { w[kk] = __expf(tv[kk] - tv[0]); sum += w[kk]; }
        const float inv = 1.0f / sum;
        if (lane < 4) {
            const int e = (lane == 0 ? te[0] : lane == 1 ? te[1] : lane == 2 ? te[2] : te[3]);
            const float wk = (lane == 0 ? w[0] : lane == 1 ? w[1] : lane == 2 ? w[2] : w[3]) * inv;
            const int pos = atomicAdd(p.cnt + e, 1);
            p.toke_o[t * 4 + lane] = e; p.tokp_o[t * 4 + lane] = pos;
            p.list[(size_t)e * CAP + pos] = t; p.listw[(size_t)e * CAP + pos] = wk;
        }
    }
}
template <int MODE> __global__ void __launch_bounds__(256) k_norm(NormP p) {
    __shared__ int seg[NE + 1];
    if (MODE != 1 && p.modprev) { if (threadIdx.x == 0) seg_build(p.cntprev, seg); __syncthreads(); }
    const int t = blockIdx.x * 4 + (threadIdx.x >> 6);
    norm_row<MODE>(p, t, threadIdx.x & 63, seg);
}

struct NG { const bf16_t* A; const float* B; float* C; const int* cnt; const int* list; size_t bstride; int lda, ldb, ldc, M, N, K; };
static NG mk_ng(const bf16_t* A, int lda, const float* B, int ldb, float* C, int ldc, int M, int N, int K, const int* cnt, const int* list, size_t bstride) {
    NG g; memset(&g, 0, sizeof(g)); g.A = A; g.B = B; g.C = C; g.cnt = cnt; g.list = list; g.bstride = bstride; g.lda = lda; g.ldb = ldb; g.ldc = ldc; g.M = M; g.N = N; g.K = K; return g; }
template <int MOE  >
__global__ void __launch_bounds__(256) k_gemm_naive(NG g) {
    const int lane = threadIdx.x & 63, w = threadIdx.x >> 6, r32 = lane & 31, hi = lane >> 5;
    const int col0 = (blockIdx.x * 4 + w) * 32, row0 = blockIdx.y * 32;
    if (col0 >= g.N) return;
    const float* Bp = g.B; size_t arow = (size_t)(row0 + r32);
    if (MOE) {
        int e = -1;
        { int a = 0; for (int i = 0; i < NE; ++i) { const int c = g.cnt[i]; const int nx = a + ((c + 255) & ~255); if (row0 >= a && row0 < nx) e = i; a = nx; } }
        if (e < 0) return;
        int a0 = 0; for (int i = 0; i < e; ++i) a0 += (g.cnt[i] + 255) & ~255;
        Bp += (size_t)e * g.bstride;
        if (MOE == 1) { int pos = row0 + r32 - a0; const int c = g.cnt[e]; if (pos > c - 1) pos = c - 1; arow = (size_t)g.list[(size_t)e * CAP + pos]; }
    }
    const bf16_t* Ap = g.A + arow * g.lda + hi * 8;
    const int col = col0 + r32; const bool cok = col < g.N;
    const float* Bc = Bp + (cok ? col : 0) + (size_t)(hi * 8) * g.ldb;
    f32x16 acc = {};
    for (int k0 = 0; k0 < g.K; k0 += 16) {
        const bf16x8 a = *(const bf16x8*)(Ap + k0);
        unsigned bw[4];
#pragma unroll
        for (int i = 0; i < 4; ++i) { const float b0 = Bc[(size_t)(k0 + 2 * i) * g.ldb], b1 = Bc[(size_t)(k0 + 2 * i + 1) * g.ldb]; bw[i] = cok ? pk2(b0, b1) : 0u; }
        bf16x8 bfr; { u32x4 t = {bw[0], bw[1], bw[2], bw[3]}; bfr = __builtin_bit_cast(bf16x8, t); }
        acc = __builtin_amdgcn_mfma_f32_32x32x16_bf16(a, bfr, acc, 0, 0, 0);
    }
    if (cok) {
#pragma unroll
        for (int r = 0; r < 16; ++r) { const int row = row0 + (r & 3) + 8 * (r >> 2) + 4 * hi; g.C[(size_t)row * g.ldc + col] = acc[r]; }
    }
}

__global__ void __launch_bounds__(256) k_post_proj(const float* __restrict__ raw, const float* __restrict__ qkg  , bf16_t* __restrict__ proj) {
    const int gid = blockIdx.x * 256 + threadIdx.x;
    const int t = gid / 84, g = gid % 84, c0 = g * 64;
    const float* src = raw + (size_t)t * DIN + (c0 < 768 ? c0 : c0 + 4);
    bf16_t* dst = proj + (size_t)t * PW + c0;
    int kind, gi = 0;
    if (c0 < 256) { kind = 1; gi = 0; } else if (c0 < 512) { kind = 2; gi = 1; } else if (c0 < 768) kind = 0;
    else if (c0 < 1280) { kind = 1; gi = 2; } else if (c0 < 1408) { kind = 2; gi = 3; } else if (c0 < 1536) kind = 0;
    else if (c0 < 1792) { kind = 1; gi = 4; } else if (c0 < 2048) { kind = 2; gi = 5; } else if (c0 < 2304) kind = 0; else kind = 3;
    float v[64]; float ss = 0.f;
#pragma unroll
    for (int i = 0; i < 64; ++i) { v[i] = src[i]; ss += v[i] * v[i]; }
    if (kind == 1 || kind == 2) { const float r = rsqrtf(ss * (1.0f / 64.0f) + EPS) * (kind == 1 ? C2 : 1.0f);
#pragma unroll
        for (int i = 0; i < 64; ++i) v[i] = v[i] * r * qkg[gi * 64 + i]; }
    if (kind == 3) {
#pragma unroll
        for (int i = 0; i < 64; ++i) v[i] = sigmoidf_(v[i]); }
#pragma unroll
    for (int i = 0; i < 64; i += 2) *(unsigned*)(dst + i) = pk2(v[i], v[i + 1]);
}

__global__ void k_scan_naive(const float* __restrict__ lf, float* __restrict__ cum) {
    const int i = blockIdx.x * blockDim.x + threadIdx.x; if (i >= NB * 4) return;
    float a = 0.f; for (int s = 0; s < S; ++s) { a += lf[(size_t)i * S + s]; cum[(size_t)i * S + s] = a; }
}
__global__ void __launch_bounds__(256) k_kmean_naive(const bf16_t* __restrict__ proj, float* __restrict__ kmean) {
    const int gid = blockIdx.x * 256 + threadIdx.x;
    const int hd = gid % 256, blk = (gid / 256) % 16, b = gid / 4096;
    float a = 0.f; for (int i = 0; i < 256; ++i) a += bf2f(proj[(size_t)(b * S + blk * 256 + i) * PW + MK + hd]);
    kmean[(size_t)(b * 16 + blk) * 256 + hd] = a;
}

template <int VAR  >
__global__ void __launch_bounds__(64) k_attn_naive(const bf16_t* __restrict__ proj, const float* __restrict__ cum, const float* __restrict__ kmean, const float* __restrict__ sinks, bf16_t* __restrict__ ocat) {
    const int t = blockIdx.x * 64 + threadIdx.x, h = blockIdx.y, b = blockIdx.z;
    int qoff, koff, voff, ooff; float slope2 = 0.f;
    if (VAR == 0) { qoff = FQ + h * 64; koff = FK + h * 64; voff = FV + h * 64; ooff = h * 64; }
    else if (VAR == 1) { qoff = SQ + h * 64; koff = SK + (h >> 2) * 64; voff = SV + (h >> 2) * 64; ooff = 256 + h * 64; slope2 = alibi_slope(h) * LOG2E; }
    else { qoff = MQ + h * 64; koff = MK + h * 64; voff = MV + h * 64; ooff = 768 + h * 64; slope2 = alibi_slope(8 + h) * LOG2E; }
    const bf16_t* base = proj + (size_t)b * S * PW;
    float q[64], o[64];
    { const u32x4* qp = (const u32x4*)(base + (size_t)t * PW + qoff);
#pragma unroll
      for (int c = 0; c < 8; ++c) { const u32x4 w = qp[c];
#pragma unroll
          for (int i = 0; i < 4; ++i) { q[8 * c + 2 * i] = bf2f(w[i] & 0xffffu); q[8 * c + 2 * i + 1] = bf2f(w[i] >> 16); } } }
#pragma unroll
    for (int d = 0; d < 64; ++d) o[d] = 0.f;
    float m = -1e30f, l = 0.f;
    const float ct = (VAR == 0) ? cum[(size_t)(b * 4 + h) * S + t] : 0.f;
    auto key = [&](int s) {
        const u32x4* kp = (const u32x4*)(base + (size_t)s * PW + koff);
        float dot = 0.f;
#pragma unroll
        for (int c = 0; c < 8; ++c) { const u32x4 w = kp[c];
#pragma unroll
            for (int i = 0; i < 4; ++i) dot += q[8 * c + 2 * i] * bf2f(w[i] & 0xffffu) + q[8 * c + 2 * i + 1] * bf2f(w[i] >> 16); }
        float lg;
        if (VAR == 0) lg = dot + (ct - cum[(size_t)(b * 4 + h) * S + s]) * LOG2E;
        else lg = dot - slope2 * (float)(t - s);
        if (lg > m) { const float f = exp2f(m - lg); l *= f;
#pragma unroll
            for (int d = 0; d < 64; ++d) o[d] *= f;
            m = lg; }
        const float pr = exp2f(lg - m); l += pr;
        const u32x4* vp = (const u32x4*)(base + (size_t)s * PW + voff);
#pragma unroll
        for (int c = 0; c < 8; ++c) { const u32x4 w = vp[c];
#pragma unroll
            for (int i = 0; i < 4; ++i) { o[8 * c + 2 * i] += pr * bf2f(w[i] & 0xffffu); o[8 * c + 2 * i + 1] += pr * bf2f(w[i] >> 16); } }
    };
    if (VAR == 0) { for (int s = 0; s <= t; ++s) key(s); }
    else if (VAR == 1) { const int s0 = t - 127 > 0 ? t - 127 : 0; for (int s = s0; s <= t; ++s) key(s);
        l += exp2f(sinks[h] * LOG2E - m); }
    else {
        const int own = t >> 8; const int nsel = own < 3 ? own : 3;
        unsigned mask = 0u;
        for (int kk = 0; kk < nsel; ++kk) {
            int bi = 0; float bv = -INFINITY;
            for (int j = 0; j < own; ++j) {
                if ((mask >> j) & 1u) continue;
                const float* km = kmean + (size_t)(b * 16 + j) * 256 + h * 64; float a = 0.f;
#pragma unroll
                for (int d = 0; d < 64; ++d) a += q[d] * km[d];
                if (a > bv) { bv = a; bi = j; }
            }
            mask |= 1u << bi;
        }
        for (int j = 0; j < own; ++j) if ((mask >> j) & 1u) { const int s0 = j * 256; for (int s = s0; s < s0 + 256; ++s) key(s); }
        for (int s = own * 256; s <= t; ++s) key(s);
    }
    const float inv = 1.0f / l;
    bf16_t* op = ocat + (size_t)(b * S + t) * D + ooff;
#pragma unroll
    for (int d = 0; d < 64; d += 2) *(unsigned*)(op + d) = pk2(o[d] * inv, o[d + 1] * inv);
}

__global__ void __launch_bounds__(256) k_merge(const bf16_t* __restrict__ proj, const float* __restrict__ ya, const float* __restrict__ yb, const float* __restrict__ yc, bf16_t* __restrict__ merged) {
    const size_t i = (size_t)blockIdx.x * 256 + threadIdx.x; const size_t t = i / D; const int n = (int)(i % D);
    const bf16_t* pr = proj + t * PW;
    merged[i] = (bf16_t)f2bf(bf2f(pr[GA + n]) * ya[i] + bf2f(pr[GB + n]) * yb[i] + bf2f(pr[GC + n]) * yc[i]);
}
__global__ void __launch_bounds__(256) k_resid1(float* __restrict__ X, const float* __restrict__ raw, const float* __restrict__ mod) {
    const size_t i = (size_t)blockIdx.x * 256 + threadIdx.x; const size_t t = i / D; const int n = (int)(i % D); const int b = (int)(t / S);
    X[i] += mod[(size_t)b * 6144 + 2 * D + n] * raw[i];
}
__device__ __forceinline__ bool row_lookup(const int* cnt, int row, int& e, int& pos) {
    int a = 0; for (int i = 0; i < NE; ++i) { const int c = cnt[i]; const int nx = a + ((c + 255) & ~255); if (row < nx) { e = i; pos = row - a; return pos < c; } a = nx; }
    return false;
}
__global__ void __launch_bounds__(256) k_swiglu(const float* __restrict__ U, const float* __restrict__ b1  , const int* __restrict__ cnt, bf16_t* __restrict__ A2) {
    const size_t i = (size_t)blockIdx.x * 256 + threadIdx.x; const int row = (int)(i / D), j = (int)(i % D);
    int e, pos; if (!row_lookup(cnt, row, e, pos)) return;
    float g = U[(size_t)row * 2048 + 2 * j] + b1[e * 2048 + 2 * j], ln = U[(size_t)row * 2048 + 2 * j + 1] + b1[e * 2048 + 2 * j + 1];
    g = fminf(g, 7.0f); ln = fminf(fmaxf(ln, -7.0f), 7.0f);
    A2[i] = (bf16_t)f2bf(g * sigmoidf_(1.702f * g) * (ln + 1.0f));
}
__global__ void __launch_bounds__(256) k_post_y(const float* __restrict__ yraw, const float* __restrict__ b2  , const int* __restrict__ cnt, const float* __restrict__ listw, bf16_t* __restrict__ Y) {
    const size_t i = (size_t)blockIdx.x * 256 + threadIdx.x; const int row = (int)(i / D), n = (int)(i % D);
    int e, pos; if (!row_lookup(cnt, row, e, pos)) return;
    Y[i] = (bf16_t)f2bf(listw[(size_t)e * CAP + pos] * (yraw[i] + b2[e * D + n]));
}

extern "C" void kernel_launch(void* const* d_in, const int* in_sizes, int n_in, void* d_out, int out_size, void* d_ws, size_t ws_size, hipStream_t stream) {
    if (n_in != 19 || out_size != T * D || ws_size < WS_END) { fprintf(stderr, "kernel_launch: unexpected shapes (n_in %d out %d ws %zu need %zu)\n", n_in, out_size, ws_size, (size_t)WS_END); return; }
    const float* const* in = (const float* const*)d_in;
    unsigned char* ws = (unsigned char*)d_ws;
    float* X = (float*)d_out;
    float* mod = (float*)(ws + WS_MOD); float* lf = (float*)(ws + WS_LF); float* cum = (float*)(ws + WS_CUM);
    int* cnt = (int*)(ws + CTL_CNT); float* kmean = (float*)(ws + CTL_KMEAN);
    int* toke = (int*)(ws + WS_TOKE); int* tokp = (int*)(ws + WS_TOKP); int* list = (int*)(ws + WS_LIST); float* listw = (float*)(ws + WS_LISTW);
    bf16_t* H = (bf16_t*)(ws + WS_H); bf16_t* OCAT = (bf16_t*)(ws + WS_OCAT); bf16_t* MERGED = (bf16_t*)(ws + WS_MERGED); bf16_t* PROJ = (bf16_t*)(ws + WS_PROJ);
    bf16_t* A2 = (bf16_t*)(ws + WS_A2); bf16_t* Y = (bf16_t*)(ws + WS_Y);
    float* NV = (float*)(ws + WS_NAIVE);
    (void)hipMemsetAsync(ws + WS_CTL, 0, CTL_BYTES, stream);
    k_mod<<<NL * 6144 / 256, 256, 0, stream>>>(in[I_C], in[I_WADA], in[I_BADA], mod);
    for (int l = 0; l < NL; ++l) {
        const float* modl = mod + (size_t)l * NB * 6144;
        NormP p{};
        p.xin = (l == 0) ? in[I_X] : X; p.X = X; p.H = H; p.mod = modl; p.modprev = (l == 0) ? nullptr : modl - (size_t)NB * 6144;
        p.gain = in[I_NGAIN] + (size_t)(l * 2 + 0) * D; p.Y = Y; p.toke = toke; p.tokp = tokp; p.cntprev = cnt + (l > 0 ? (l - 1) * NE : 0);
        p.wf = in[I_WIN] + (size_t)l * D * DIN + 768; p.bf = in[I_BF] + l * 4; p.lf = lf;
        k_norm<0><<<T / 4, 256, 0, stream>>>(p);
        { NG g = mk_ng(H, D, in[I_WIN] + (size_t)l * D * DIN, DIN, NV, DIN, T, DIN, D, nullptr, nullptr, 0);
          k_gemm_naive<0><<<dim3((DIN + 127) / 128, T / 32), 256, 0, stream>>>(g); }
        k_post_proj<<<T * 84 / 256, 256, 0, stream>>>(NV, in[I_QKG] + l * 6 * 64, PROJ);
        k_scan_naive<<<1, 64, 0, stream>>>(lf, cum);
        k_kmean_naive<<<NB * 16, 256, 0, stream>>>(PROJ, kmean + (size_t)l * NB * 16 * 256);
        k_attn_naive<0><<<dim3(S / 64, 4, NB), 64, 0, stream>>>(PROJ, cum, nullptr, nullptr, OCAT);
        k_attn_naive<1><<<dim3(S / 64, 8, NB), 64, 0, stream>>>(PROJ, nullptr, nullptr, in[I_SINK] + l * 8, OCAT);
        k_attn_naive<2><<<dim3(S / 64, 4, NB), 64, 0, stream>>>(PROJ, nullptr, kmean + (size_t)l * NB * 16 * 256, nullptr, OCAT);
        float* ya = NV; float* yb = NV + (size_t)T * D; float* yc = NV + (size_t)2 * T * D; float* oraw = NV + (size_t)3 * T * D;
        { NG g = mk_ng(OCAT, D, in[I_WBF] + (size_t)l * 256 * D, D, ya, D, T, D, 256, nullptr, nullptr, 0); k_gemm_naive<0><<<dim3(D / 128, T / 32), 256, 0, stream>>>(g); }
        { NG g = mk_ng(OCAT + 256, D, in[I_WBS] + (size_t)l * 512 * D, D, yb, D, T, D, 512, nullptr, nullptr, 0); k_gemm_naive<0><<<dim3(D / 128, T / 32), 256, 0, stream>>>(g); }
        { NG g = mk_ng(OCAT + 768, D, in[I_WBM] + (size_t)l * 256 * D, D, yc, D, T, D, 256, nullptr, nullptr, 0); k_gemm_naive<0><<<dim3(D / 128, T / 32), 256, 0, stream>>>(g); }
        k_merge<<<T * D / 256, 256, 0, stream>>>(PROJ, ya, yb, yc, MERGED);
        { NG g = mk_ng(MERGED, D, in[I_WOUT] + (size_t)l * D * D, D, oraw, D, T, D, D, nullptr, nullptr, 0); k_gemm_naive<0><<<dim3(D / 128, T / 32), 256, 0, stream>>>(g); }
        k_resid1<<<T * D / 256, 256, 0, stream>>>(X, oraw, modl);
        NormP p2{};
        p2.xin = X; p2.X = X; p2.H = H; p2.mod = modl; p2.gain = in[I_NGAIN] + (size_t)(l * 2 + 1) * D;
        p2.wr = in[I_WR] + (size_t)l * D * NE; p2.br = in[I_BR] + l * NE; p2.cnt = cnt + l * NE; p2.toke_o = toke; p2.tokp_o = tokp; p2.list = list; p2.listw = listw;
        k_norm<1><<<T / 4, 256, 0, stream>>>(p2);
        { NG g = mk_ng(H, D, in[I_W1] + (size_t)l * NE * D * 2048, 2048, NV, 2048, ROWS_MAX, 2048, D, cnt + l * NE, list, (size_t)D * 2048);
          k_gemm_naive<1><<<dim3(2048 / 128, ROWS_MAX / 32), 256, 0, stream>>>(g); }
        k_swiglu<<<(size_t)ROWS_MAX * D / 256, 256, 0, stream>>>(NV, in[I_B1] + (size_t)l * NE * 2048, cnt + l * NE, A2);
        { NG g = mk_ng(A2, D, in[I_W2] + (size_t)l * NE * D * D, D, NV, D, ROWS_MAX, D, D, cnt + l * NE, list, (size_t)D * D);
          k_gemm_naive<2><<<dim3(D / 128, ROWS_MAX / 32), 256, 0, stream>>>(g); }
        k_post_y<<<(size_t)ROWS_MAX * D / 256, 256, 0, stream>>>(NV, in[I_B2] + (size_t)l * NE * D, cnt + l * NE, listw, Y);
    }
    { NormP p{}; p.xin = X; p.X = X; p.modprev = mod + (size_t)(NL - 1) * NB * 6144; p.Y = Y; p.toke = toke; p.tokp = tokp; p.cntprev = cnt + (NL - 1) * NE;
      k_norm<2><<<T / 4, 256, 0, stream>>>(p); }
}
```

```cpp
#include <hip/hip_runtime.h>
#include <stdint.h>
#include <stdio.h>
#include <string.h>

typedef unsigned short bf16_t;
typedef short bf16x8 __attribute__((ext_vector_type(8)));
typedef float f32x4 __attribute__((ext_vector_type(4)));
typedef float f32x16 __attribute__((ext_vector_type(16)));
typedef unsigned u32x4 __attribute__((ext_vector_type(4)));
typedef unsigned u32x2 __attribute__((ext_vector_type(2)));

constexpr int NB = 8, S = 4096, T = NB * S, D = 1024, NL = 4, DIN = 5380, PW = 5376, NE = 32, CAP = 32768;
constexpr int ROWS_MAX = T * 4 + NE * 256;
constexpr float EPS = 1e-6f;
constexpr float LOG2E = 1.4426950408889634f;
constexpr float C2 = 0.125f * LOG2E;
constexpr int FQ = 0, FK = 256, FV = 512, SQ = 768, SK = 1280, SV = 1408, MQ = 1536, MK = 1792, MV = 2048, GA = 2304, GB = 3328, GC = 4352;
enum { I_X = 0, I_C, I_WADA, I_BADA, I_NGAIN, I_WIN, I_BF, I_QKG, I_SINK, I_WBF, I_WBS, I_WBM, I_WOUT, I_WR, I_BR, I_W1, I_B1, I_W2, I_B2 };

constexpr size_t MiB = 1ull << 20;
constexpr size_t WS_CTL = 0, CTL_BYTES = 2 * MiB;
constexpr size_t CTL_CNT = 512 * 1024;
constexpr size_t CTL_KMEAN = 1 * MiB;
constexpr size_t WS_MOD = 2 * MiB;
constexpr size_t WS_LF = 3 * MiB;
constexpr size_t WS_CUM = 4 * MiB;
constexpr size_t WS_TOKE = 5 * MiB;
constexpr size_t WS_TOKP = 6 * MiB;
constexpr size_t WS_LIST = 8 * MiB;
constexpr size_t WS_LISTW = 12 * MiB;
constexpr size_t WS_H = 16 * MiB;
constexpr size_t WS_OCAT = 80 * MiB;
constexpr size_t WS_MERGED = 144 * MiB;
constexpr size_t WS_PROJ = 208 * MiB;
constexpr size_t WS_A2 = 544 * MiB;
constexpr size_t WS_Y = 816 * MiB;
constexpr size_t WS_NAIVE = 1088 * MiB;
constexpr size_t WS_WT = 2304 * MiB;
constexpr size_t WS_END = WS_WT + 4 * 216 * MiB;

__device__ __forceinline__ unsigned f2bf(float f) { unsigned u = __float_as_uint(f); return (u + 0x7fffu + ((u >> 16) & 1u)) >> 16; }
__device__ __forceinline__ float bf2f(unsigned b) { return __uint_as_float(b << 16); }
__device__ __forceinline__ unsigned pk2(float lo, float hi) { return f2bf(lo) | (f2bf(hi) << 16); }
__device__ __forceinline__ float wave_sum(float v) {
#pragma unroll
    for (int o = 1; o < 64; o <<= 1) v += __shfl_xor(v, o);
    return v;
}
__device__ __forceinline__ float wave_max(float v) {
#pragma unroll
    for (int o = 1; o < 64; o <<= 1) v = fmaxf(v, __shfl_xor(v, o));
    return v;
}
__device__ __forceinline__ float alibi_slope(int i) { return exp2f(-8.0f * (float)(i + 1) / 12.0f); }
__device__ __forceinline__ float sigmoidf_(float x) { return 1.0f / (1.0f + __expf(-x)); }

__device__ __forceinline__ void seg_build(const int* cnt, int* seg) {
    int a = 0;
    for (int e = 0; e < NE; ++e) { seg[e] = a; a += (cnt[e] + 255) & ~255; }
    seg[NE] = a;
}

__global__ void __launch_bounds__(256) k_mod(const float* __restrict__ c, const float* __restrict__ w_ada, const float* __restrict__ b_ada, float* __restrict__ mod) {
    __shared__ float sc[NB * D];
    for (int i = threadIdx.x; i < NB * D; i += 256) { const float v = c[i]; sc[i] = v / (1.0f + __expf(-v)); }
    __syncthreads();
    const int col = blockIdx.x * 256 + threadIdx.x;
    const int l = col / 6144, j = col % 6144;
    const float* w = w_ada + (size_t)l * D * 6144 + j;
    float acc[NB];
#pragma unroll
    for (int b = 0; b < NB; ++b) acc[b] = 0.f;
#pragma unroll 4
    for (int k = 0; k < D; ++k) { const float wv = w[(size_t)k * 6144];
#pragma unroll
        for (int b = 0; b < NB; ++b) acc[b] += sc[b * D + k] * wv; }
    const float bv = b_ada[l * 6144 + j];
#pragma unroll
    for (int b = 0; b < NB; ++b) mod[(size_t)(l * NB + b) * 6144 + j] = acc[b] + bv;
}

struct NormP {
    const float* xin;
    float* X;
    bf16_t* H;
    const float* mod;
    const float* modprev;
    const float* gain;
    const bf16_t* Y; const int* toke; const int* tokp; const int* cntprev;
    const float* wf;
    const float* bf;
    float* lf;
    const float* wr; const float* br;
    int* cnt; int* toke_o; int* tokp_o; int* list; float* listw;
};

template <int MODE>
__device__ __forceinline__ void norm_row(const NormP& p, int t, int lane, const int* seg  ) {
    const int b = t / S, s = t % S;
    f32x4 v[4];
    const f32x4* xr = (const f32x4*)(p.xin + (size_t)t * D) + lane;
#pragma unroll
    for (int j = 0; j < 4; ++j) v[j] = xr[64 * j];
    if (MODE != 1 && p.modprev) {
        f32x4 a[4];
#pragma unroll
        for (int j = 0; j < 4; ++j) a[j] = (f32x4){0.f, 0.f, 0.f, 0.f};
#pragma unroll
        for (int kk = 0; kk < 4; ++kk) {
            const int e = p.toke[t * 4 + kk], pos = p.tokp[t * 4 + kk];
            const u32x2* yr = (const u32x2*)(p.Y + (size_t)(seg[e] + pos) * D) + lane;
#pragma unroll
            for (int j = 0; j < 4; ++j) { const u32x2 w = yr[64 * j];
                a[j][0] += bf2f(w.x & 0xffffu); a[j][1] += bf2f(w.x >> 16); a[j][2] += bf2f(w.y & 0xffffu); a[j][3] += bf2f(w.y >> 16); }
        }
        const f32x4* g2 = (const f32x4*)(p.modprev + (size_t)b * 6144 + 5 * D) + lane;
#pragma unroll
        for (int j = 0; j < 4; ++j) v[j] += g2[64 * j] * a[j];
    }
    if (MODE != 1) {
        f32x4* xo = (f32x4*)(p.X + (size_t)t * D) + lane;
#pragma unroll
        for (int j = 0; j < 4; ++j) xo[64 * j] = v[j];
    }
    if (MODE == 2) return;
    float ss = 0.f;
#pragma unroll
    for (int j = 0; j < 4; ++j) ss += (v[j][0] * v[j][0] + v[j][1] * v[j][1]) + (v[j][2] * v[j][2] + v[j][3] * v[j][3]);
    ss = wave_sum(ss);
    const float r = rsqrtf(ss * (1.0f / D) + EPS);
    const int off = (MODE == 0) ? 0 : 3 * D;
    const f32x4* sh = (const f32x4*)(p.mod + (size_t)b * 6144 + off) + lane;
    const f32x4* sc = (const f32x4*)(p.mod + (size_t)b * 6144 + off + D) + lane;
    const f32x4* gn = (const f32x4*)p.gain + lane;
    u32x2* ho = (u32x2*)(p.H + (size_t)t * D) + lane;
#pragma unroll
    for (int j = 0; j < 4; ++j) {
        const f32x4 g = gn[64 * j], c1 = sc[64 * j], s1 = sh[64 * j];
        v[j] = (v[j] * r) * g * (1.0f + c1) + s1;
        u32x2 w; w.x = pk2(v[j][0], v[j][1]); w.y = pk2(v[j][2], v[j][3]); ho[64 * j] = w;
    }
    if (MODE == 0) {
        float f0 = 0.f, f1 = 0.f, f2 = 0.f, f3 = 0.f;
#pragma unroll
        for (int j = 0; j < 4; ++j)
#pragma unroll
            for (int i = 0; i < 4; ++i) { const int k = 4 * lane + 256 * j + i; const f32x4 w = *(const f32x4*)(p.wf + (size_t)k * DIN);
                f0 += v[j][i] * w[0]; f1 += v[j][i] * w[1]; f2 += v[j][i] * w[2]; f3 += v[j][i] * w[3]; }
        f0 = wave_sum(f0); f1 = wave_sum(f1); f2 = wave_sum(f2); f3 = wave_sum(f3);
        if (lane < 4) { float z = (lane == 0 ? f0 : lane == 1 ? f1 : lane == 2 ? f2 : f3) + p.bf[lane];
            const float ls = fminf(z, 0.f) - log1pf(__expf(-fabsf(z)));
            p.lf[(size_t)(b * 4 + lane) * S + s] = ls; }
    }
    if (MODE == 1) {
        float mine = 0.f;
        for (int e = 0; e < NE; ++e) {
            float a = 0.f;
#pragma unroll
            for (int j = 0; j < 4; ++j)
#pragma unroll
                for (int i = 0; i < 4; ++i) { const int k = 4 * lane + 256 * j + i; a += v[j][i] * p.wr[(size_t)k * NE + e]; }
            a = wave_sum(a);
            if (lane == e) mine = a + p.br[e];
        }
        float val = (lane < NE) ? mine : -INFINITY;
        float tv[4]; int te[4];
#pragma unroll
        for (int kk = 0; kk < 4; ++kk) {
            const float m = wave_max(val);
            const unsigned long long bal = __ballot(val == m);
            const int idx = __ffsll((long long)bal) - 1;
            tv[kk] = m; te[kk] = idx;
            if (lane == idx) val = -INFINITY;
        }
        float w[4], sum = 0.f;
#pragma unroll
        for (int kk = 0; kk < 4; ++kk) { w[kk] = __expf(tv[kk] - tv[0]); sum += w[kk]; }
        const float inv = 1.0f / sum;
        if (lane < 4) {
            const int e = (lane == 0 ? te[0] : lane == 1 ? te[1] : lane == 2 ? te[2] : te[3]);
            const float wk = (lane == 0 ? w[0] : lane == 1 ? w[1] : lane == 2 ? w[2] : w[3]) * inv;
            const int pos = atomicAdd(p.cnt + e, 1);
            p.toke_o[t * 4 + lane] = e; p.tokp_o[t * 4 + lane] = pos;
            p.list[(size_t)e * CAP + pos] = t; p.listw[(size_t)e * CAP + pos] = wk;
        }
    }
}
template <int MODE> __global__ void __launch_bounds__(256) k_norm(NormP p) {
    __shared__ int seg[NE + 1];
    if (MODE != 1 && p.modprev) { if (threadIdx.x == 0) seg_build(p.cntprev, seg); __syncthreads(); }
    const int t = blockIdx.x * 4 + (threadIdx.x >> 6);
    norm_row<MODE>(p, t, threadIdx.x & 63, seg);
}

struct NG { const bf16_t* A; const float* B; float* C; const int* cnt; const int* list; size_t bstride; int lda, ldb, ldc, M, N, K; };
static NG mk_ng(const bf16_t* A, int lda, const float* B, int ldb, float* C, int ldc, int M, int N, int K, const int* cnt, const int* list, size_t bstride) {
    NG g; memset(&g, 0, sizeof(g)); g.A = A; g.B = B; g.C = C; g.cnt = cnt; g.list = list; g.bstride = bstride; g.lda = lda; g.ldb = ldb; g.ldc = ldc; g.M = M; g.N = N; g.K = K; return g; }
template <int MOE  >
__global__ void __launch_bounds__(256) k_gemm_naive(NG g) {
    const int lane = threadIdx.x & 63, w = threadIdx.x >> 6, r32 = lane & 31, hi = lane >> 5;
    const int col0 = (blockIdx.x * 4 + w) * 32, row0 = blockIdx.y * 32;
    if (col0 >= g.N) return;
    const float* Bp = g.B; size_t arow = (size_t)(row0 + r32);
    if (MOE) {
        int e = -1;
        { int a = 0; for (int i = 0; i < NE; ++i) { const int c = g.cnt[i]; const int nx = a + ((c + 255) & ~255); if (row0 >= a && row0 < nx) e = i; a = nx; } }
        if (e < 0) return;
        int a0 = 0; for (int i = 0; i < e; ++i) a0 += (g.cnt[i] + 255) & ~255;
        Bp += (size_t)e * g.bstride;
        if (MOE == 1) { int pos = row0 + r32 - a0; const int c = g.cnt[e]; if (pos > c - 1) pos = c - 1; arow = (size_t)g.list[(size_t)e * CAP + pos]; }
    }
    const bf16_t* Ap = g.A + arow * g.lda + hi * 8;
    const int col = col0 + r32; const bool cok = col < g.N;
    const float* Bc = Bp + (cok ? col : 0) + (size_t)(hi * 8) * g.ldb;
    f32x16 acc = {};
    for (int k0 = 0; k0 < g.K; k0 += 16) {
        const bf16x8 a = *(const bf16x8*)(Ap + k0);
        unsigned bw[4];
#pragma unroll
        for (int i = 0; i < 4; ++i) { const float b0 = Bc[(size_t)(k0 + 2 * i) * g.ldb], b1 = Bc[(size_t)(k0 + 2 * i + 1) * g.ldb]; bw[i] = cok ? pk2(b0, b1) : 0u; }
        bf16x8 bfr; { u32x4 t = {bw[0], bw[1], bw[2], bw[3]}; bfr = __builtin_bit_cast(bf16x8, t); }
        acc = __builtin_amdgcn_mfma_f32_32x32x16_bf16(a, bfr, acc, 0, 0, 0);
    }
    if (cok) {
#pragma unroll
        for (int r = 0; r < 16; ++r) { const int row = row0 + (r & 3) + 8 * (r >> 2) + 4 * hi; g.C[(size_t)row * g.ldc + col] = acc[r]; }
    }
}

__global__ void __launch_bounds__(256) k_post_proj(const float* __restrict__ raw, const float* __restrict__ qkg  , bf16_t* __restrict__ proj) {
    const int gid = blockIdx.x * 256 + threadIdx.x;
    const int t = gid / 84, g = gid % 84, c0 = g * 64;
    const float* src = raw + (size_t)t * DIN + (c0 < 768 ? c0 : c0 + 4);
    bf16_t* dst = proj + (size_t)t * PW + c0;
    int kind, gi = 0;
    if (c0 < 256) { kind = 1; gi = 0; } else if (c0 < 512) { kind = 2; gi = 1; } else if (c0 < 768) kind = 0;
    else if (c0 < 1280) { kind = 1; gi = 2; } else if (c0 < 1408) { kind = 2; gi = 3; } else if (c0 < 1536) kind = 0;
    else if (c0 < 1792) { kind = 1; gi = 4; } else if (c0 < 2048) { kind = 2; gi = 5; } else if (c0 < 2304) kind = 0; else kind = 3;
    float v[64]; float ss = 0.f;
#pragma unroll
    for (int i = 0; i < 64; ++i) { v[i] = src[i]; ss += v[i] * v[i]; }
    if (kind == 1 || kind == 2) { const float r = rsqrtf(ss * (1.0f / 64.0f) + EPS) * (kind == 1 ? C2 : 1.0f);
#pragma unroll
        for (int i = 0; i < 64; ++i) v[i] = v[i] * r * qkg[gi * 64 + i]; }
    if (kind == 3) {
#pragma unroll
        for (int i = 0; i < 64; ++i) v[i] = sigmoidf_(v[i]); }
#pragma unroll
    for (int i = 0; i < 64; i += 2) *(unsigned*)(dst + i) = pk2(v[i], v[i + 1]);
}

__global__ void k_scan_naive(const float* __restrict__ lf, float* __restrict__ cum) {
    const int i = blockIdx.x * blockDim.x + threadIdx.x; if (i >= NB * 4) return;
    float a = 0.f; for (int s = 0; s < S; ++s) { a += lf[(size_t)i * S + s]; cum[(size_t)i * S + s] = a; }
}
__global__ void __launch_bounds__(256) k_kmean_naive(const bf16_t* __restrict__ proj, float* __restrict__ kmean) {
    const int gid = blockIdx.x * 256 + threadIdx.x;
    const int hd = gid % 256, blk = (gid / 256) % 16, b = gid / 4096;
    float a = 0.f; for (int i = 0; i < 256; ++i) a += bf2f(proj[(size_t)(b * S + blk * 256 + i) * PW + MK + hd]);
    kmean[(size_t)(b * 16 + blk) * 256 + hd] = a;
}

template <int VAR  >
__global__ void __launch_bounds__(64) k_attn_naive(const bf16_t* __restrict__ proj, const float* __restrict__ cum, const float* __restrict__ kmean, const float* __restrict__ sinks, bf16_t* __restrict__ ocat) {
    const int t = blockIdx.x * 64 + threadIdx.x, h = blockIdx.y, b = blockIdx.z;
    int qoff, koff, voff, ooff; float slope2 = 0.f;
    if (VAR == 0) { qoff = FQ + h * 64; koff = FK + h * 64; voff = FV + h * 64; ooff = h * 64; }
    else if (VAR == 1) { qoff = SQ + h * 64; koff = SK + (h >> 2) * 64; voff = SV + (h >> 2) * 64; ooff = 256 + h * 64; slope2 = alibi_slope(h) * LOG2E; }
    else { qoff = MQ + h * 64; koff = MK + h * 64; voff = MV + h * 64; ooff = 768 + h * 64; slope2 = alibi_slope(8 + h) * LOG2E; }
    const bf16_t* base = proj + (size_t)b * S * PW;
    float q[64], o[64];
    { const u32x4* qp = (const u32x4*)(base + (size_t)t * PW + qoff);
#pragma unroll
      for (int c = 0; c < 8; ++c) { const u32x4 w = qp[c];
#pragma unroll
          for (int i = 0; i < 4; ++i) { q[8 * c + 2 * i] = bf2f(w[i] & 0xffffu); q[8 * c + 2 * i + 1] = bf2f(w[i] >> 16); } } }
#pragma unroll
    for (int d = 0; d < 64; ++d) o[d] = 0.f;
    float m = -1e30f, l = 0.f;
    const float ct = (VAR == 0) ? cum[(size_t)(b * 4 + h) * S + t] : 0.f;
    auto key = [&](int s) {
        const u32x4* kp = (const u32x4*)(base + (size_t)s * PW + koff);
        float dot = 0.f;
#pragma unroll
        for (int c = 0; c < 8; ++c) { const u32x4 w = kp[c];
#pragma unroll
            for (int i = 0; i < 4; ++i) dot += q[8 * c + 2 * i] * bf2f(w[i] & 0xffffu) + q[8 * c + 2 * i + 1] * bf2f(w[i] >> 16); }
        float lg;
        if (VAR == 0) lg = dot + (ct - cum[(size_t)(b * 4 + h) * S + s]) * LOG2E;
        else lg = dot - slope2 * (float)(t - s);
        if (lg > m) { const float f = exp2f(m - lg); l *= f;
#pragma unroll
            for (int d = 0; d < 64; ++d) o[d] *= f;
            m = lg; }
        const float pr = exp2f(lg - m); l += pr;
        const u32x4* vp = (const u32x4*)(base + (size_t)s * PW + voff);
#pragma unroll
        for (int c = 0; c < 8; ++c) { const u32x4 w = vp[c];
#pragma unroll
            for (int i = 0; i < 4; ++i) { o[8 * c + 2 * i] += pr * bf2f(w[i] & 0xffffu); o[8 * c + 2 * i + 1] += pr * bf2f(w[i] >> 16); } }
    };
    if (VAR == 0) { for (int s = 0; s <= t; ++s) key(s); }
    else if (VAR == 1) { const int s0 = t - 127 > 0 ? t - 127 : 0; for (int s = s0; s <= t; ++s) key(s);
        l += exp2f(sinks[h] * LOG2E - m); }
    else {
        const int own = t >> 8; const int nsel = own < 3 ? own : 3;
        unsigned mask = 0u;
        for (int kk = 0; kk < nsel; ++kk) {
            int bi = 0; float bv = -INFINITY;
            for (int j = 0; j < own; ++j) {
                if ((mask >> j) & 1u) continue;
                const float* km = kmean + (size_t)(b * 16 + j) * 256 + h * 64; float a = 0.f;
#pragma unroll
                for (int d = 0; d < 64; ++d) a += q[d] * km[d];
                if (a > bv) { bv = a; bi = j; }
            }
            mask |= 1u << bi;
        }
        for (int j = 0; j < own; ++j) if ((mask >> j) & 1u) { const int s0 = j * 256; for (int s = s0; s < s0 + 256; ++s) key(s); }
        for (int s = own * 256; s <= t; ++s) key(s);
    }
    const float inv = 1.0f / l;
    bf16_t* op = ocat + (size_t)(b * S + t) * D + ooff;
#pragma unroll
    for (int d = 0; d < 64; d += 2) *(unsigned*)(op + d) = pk2(o[d] * inv, o[d + 1] * inv);
}

__global__ void __launch_bounds__(256) k_merge(const bf16_t* __restrict__ proj, const float* __restrict__ ya, const float* __restrict__ yb, const float* __restrict__ yc, bf16_t* __restrict__ merged) {
    const size_t i = (size_t)blockIdx.x * 256 + threadIdx.x; const size_t t = i / D; const int n = (int)(i % D);
    const bf16_t* pr = proj + t * PW;
    merged[i] = (bf16_t)f2bf(bf2f(pr[GA + n]) * ya[i] + bf2f(pr[GB + n]) * yb[i] + bf2f(pr[GC + n]) * yc[i]);
}
__global__ void __launch_bounds__(256) k_resid1(float* __restrict__ X, const float* __restrict__ raw, const float* __restrict__ mod) {
    const size_t i = (size_t)blockIdx.x * 256 + threadIdx.x; const size_t t = i / D; const int n = (int)(i % D); const int b = (int)(t / S);
    X[i] += mod[(size_t)b * 6144 + 2 * D + n] * raw[i];
}
__device__ __forceinline__ bool row_lookup(const int* cnt, int row, int& e, int& pos) {
    int a = 0; for (int i = 0; i < NE; ++i) { const int c = cnt[i]; const int nx = a + ((c + 255) & ~255); if (row < nx) { e = i; pos = row - a; return pos < c; } a = nx; }
    return false;
}
__global__ void __launch_bounds__(256) k_swiglu(const float* __restrict__ U, const float* __restrict__ b1  , const int* __restrict__ cnt, bf16_t* __restrict__ A2) {
    const size_t i = (size_t)blockIdx.x * 256 + threadIdx.x; const int row = (int)(i / D), j = (int)(i % D);
    int e, pos; if (!row_lookup(cnt, row, e, pos)) return;
    float g = U[(size_t)row * 2048 + 2 * j] + b1[e * 2048 + 2 * j], ln = U[(size_t)row * 2048 + 2 * j + 1] + b1[e * 2048 + 2 * j + 1];
    g = fminf(g, 7.0f); ln = fminf(fmaxf(ln, -7.0f), 7.0f);
    A2[i] = (bf16_t)f2bf(g * sigmoidf_(1.702f * g) * (ln + 1.0f));
}
__global__ void __launch_bounds__(256) k_post_y(const float* __restrict__ yraw, const float* __restrict__ b2  , const int* __restrict__ cnt, const float* __restrict__ listw, bf16_t* __restrict__ Y) {
    const size_t i = (size_t)blockIdx.x * 256 + threadIdx.x; const int row = (int)(i / D), n = (int)(i % D);
    int e, pos; if (!row_lookup(cnt, row, e, pos)) return;
    Y[i] = (bf16_t)f2bf(listw[(size_t)e * CAP + pos] * (yraw[i] + b2[e * D + n]));
}


#define LAS __attribute__((address_space(3)))
#define GAS __attribute__((address_space(1)))
constexpr int NWAVES = 8, NTHR = 512;
constexpr int LDS_BYTES = 163840;
constexpr int LDS_CTL = 131072;
constexpr int LC_BAR = 0, LC_SEG = 16, LC_TPF = 64, LC_CNT = 128;
constexpr int CW_BAR = 1024;
constexpr size_t WT_IN = 0, WT_BR = (size_t)PW * D, WT_OUT = WT_BR + (size_t)D * D, WT_W1 = WT_OUT + (size_t)D * D, WT_W2 = WT_W1 + (size_t)NE * 2048 * D, WT_LAYER = 216ull * MiB / 2;
static_assert(WT_W2 + (size_t)NE * D * D <= WT_LAYER, "weights per layer");

#define XB_TMO      128
#define XB_XCNT(j)  (256  + 64 * (j))
#define XB_XSUB(j)  (1280 + 64 * (j))
#define XB_XGEN(j)  (2304 + 64 * (j))
#define XB_TOP      3328
#define XB_TOPGEN   3392
#define XCD_BAR_WORDS 3456
#define XB_SPIN_CAP (1u << 18)
__device__ __forceinline__ unsigned xb_ld(unsigned* p)              { return __hip_atomic_load(p, __ATOMIC_RELAXED, __HIP_MEMORY_SCOPE_AGENT); }
__device__ __forceinline__ unsigned xb_add(unsigned* p, unsigned v) { return __hip_atomic_fetch_add(p, v, __ATOMIC_RELAXED, __HIP_MEMORY_SCOPE_AGENT); }
__device__ __forceinline__ unsigned xb_xcc_id() { return (unsigned)__builtin_amdgcn_s_getreg((3 << 11) | 20) & 0xFu; }
#define XB_SPIN(cond, bar) do { unsigned _sp = 0; while (cond) { __builtin_amdgcn_s_sleep(1); \
    if ((++_sp & 255u) == 0u) { if (xb_ld(&(bar)[XB_TMO])) break; if (_sp > XB_SPIN_CAP) { atomicAdd(&(bar)[XB_TMO], 1u); break; } } } } while (0)
struct XcdBarrier { unsigned* bar; unsigned x; volatile LAS unsigned* st; };
__device__ __forceinline__ XcdBarrier xcd_barrier_post(unsigned* bar, volatile LAS unsigned* st) {
    XcdBarrier b; b.bar = bar; b.x = xb_xcc_id(); b.st = st;
    if (threadIdx.x == 0) (void)xb_add(&bar[XB_XCNT(b.x)], 1u);
    return b;
}
__device__ __forceinline__ void xcd_barrier_complete(unsigned* bar, unsigned x, unsigned& nloc, unsigned& nx) {
    const unsigned G = gridDim.x * gridDim.y * gridDim.z;
    unsigned sum, cnt, mine, sp = 0u;
    for (;;) {
        sum = 0u; cnt = 0u; mine = 0u;
#pragma unroll
        for (unsigned j = 0; j < 16; ++j) { const unsigned c = xb_ld(&bar[XB_XCNT(j)]); sum += c; cnt += (c > 0u) ? 1u : 0u; mine = (j == x) ? c : mine; }
        if (sum == G) break;
        __builtin_amdgcn_s_sleep(1);
        if ((++sp & 255u) == 0u) { if (xb_ld(&bar[XB_TMO])) break; if (sp > XB_SPIN_CAP) { atomicAdd(&bar[XB_TMO], 1u); break; } }
    }
    nloc = mine > 0u ? mine : 1u; nx = cnt > 0u ? cnt : 1u;
}
__device__ __forceinline__ void xcd_barrier(const XcdBarrier& b) {
    asm volatile("s_waitcnt vmcnt(0)" ::: "memory");
    __syncthreads();
    if (threadIdx.x == 0) {
        unsigned* bar = b.bar;
        __builtin_amdgcn_s_waitcnt(0);
        unsigned nloc = b.st[0], nx = b.st[1];
        if (nloc == 0u) { xcd_barrier_complete(bar, b.x, nloc, nx); b.st[0] = nloc; b.st[1] = nx; }
        const unsigned old = xb_add(&bar[XB_XSUB(b.x)], 1u);
        const unsigned gen = old / nloc;
        if (old + 1u == (gen + 1u) * nloc) {
            __builtin_amdgcn_fence(__ATOMIC_RELEASE, "agent");
            asm volatile("s_waitcnt vmcnt(0)" ::: "memory");
            const unsigned og = xb_add(&bar[XB_TOP], 1u);
            const unsigned tg = og / nx;
            if (og + 1u == (tg + 1u) * nx) xb_add(&bar[XB_TOPGEN], 1u);
            else XB_SPIN(xb_ld(&bar[XB_TOPGEN]) == tg, bar);
            __builtin_amdgcn_fence(__ATOMIC_ACQUIRE, "agent");
            xb_add(&bar[XB_XGEN(b.x)], 1u);
            asm volatile("s_waitcnt vmcnt(0)" ::: "memory");
        } else {
            XB_SPIN(xb_ld(&bar[XB_XGEN(b.x)]) == gen, bar);
            __builtin_amdgcn_fence(__ATOMIC_ACQUIRE, "agent");
            asm volatile("s_waitcnt vmcnt(0)" ::: "memory");
        }
    }
    __syncthreads();
}

__device__ __forceinline__ int opaque(int v) { asm volatile("" : "+v"(v)); return v; }
struct MArgs { const float* in[19]; float* out; unsigned char* ws; int ph_lo, ph_hi, li, pad; };
static_assert(sizeof(MArgs) == 19 * 8 + 8 + 8 + 16, "MArgs has no padding");

__device__ __forceinline__ void p0_mod(const float* __restrict__ c, const float* __restrict__ w_ada, const float* __restrict__ b_ada, float* __restrict__ mod, LAS float* lds) {
    LAS float* sc = lds;
    LAS float* red = lds + NB * D;
    const int tid = threadIdx.x, lane = tid & 63, w = tid >> 6;
    for (int i = tid; i < NB * D; i += NTHR) { const float v = c[i]; sc[i] = v / (1.0f + __expf(-v)); }
    __syncthreads();
    for (int u = blockIdx.x; u < NL * 6144 / 64; u += gridDim.x) {
        const int col = u * 64 + lane, l = col / 6144, j = col % 6144;
        const float* wp = w_ada + (size_t)l * D * 6144 + j;
        float acc[NB];
#pragma unroll
        for (int b = 0; b < NB; ++b) acc[b] = 0.f;
#pragma unroll 8
        for (int k = w * 128; k < w * 128 + 128; ++k) { const float wv = wp[(size_t)k * 6144];
#pragma unroll
            for (int b = 0; b < NB; ++b) acc[b] += sc[b * D + k] * wv; }
#pragma unroll
        for (int b = 0; b < NB; ++b) red[(w * NB + b) * 64 + lane] = acc[b];
        __syncthreads();
        { const int b = w; float a = 0.f;
#pragma unroll
          for (int ww = 0; ww < 8; ++ww) a += red[(ww * NB + b) * 64 + lane];
          mod[(size_t)(l * NB + b) * 6144 + j] = a + b_ada[l * 6144 + j]; }
        __syncthreads();
    }
}
__device__ __forceinline__ int inproj_slot(int n) {
    if (n >= 768 && n < 772) return -1;
    const int c = n < 768 ? n : n - 4; const int pn = c >> 8, cc = c & 255;
    return pn * 256 + ((cc >> 5) & 1) * 128 + (cc >> 6) * 32 + (cc & 31);
}
template <int MAP  >
__device__ __forceinline__ void p0_transpose_item(const float* __restrict__ W, int ldn, int k0, int n0, int nvalid, bf16_t* __restrict__ WT, int kdst0, LAS float* scr, int lane) {
    const int nl = lane & 31;
#pragma unroll 8
    for (int i = 0; i < 32; ++i) { const int kk = 2 * i + (lane >> 5); scr[kk * 33 + nl] = (nl < nvalid) ? W[(size_t)(k0 + kk) * ldn + n0 + nl] : 0.f; }
    asm volatile("s_waitcnt lgkmcnt(0)" ::: "memory");
    const int c = lane & 7;
#pragma unroll
    for (int j = 0; j < 4; ++j) { const int n = (lane >> 3) + 8 * j; const LAS float* s = scr + (8 * c) * 33 + n;
        u32x4 o; o.x = pk2(s[0 * 33], s[1 * 33]); o.y = pk2(s[2 * 33], s[3 * 33]); o.z = pk2(s[4 * 33], s[5 * 33]); o.w = pk2(s[6 * 33], s[7 * 33]);
        int row = n0 + n; bool ok = n < nvalid;
        if (MAP == 1) { row = inproj_slot(ok ? row : 0); ok = ok && row >= 0; }
        if (ok) *(u32x4*)(WT + (size_t)row * D + kdst0 + k0 + 8 * c) = o; }
    asm volatile("s_waitcnt lgkmcnt(0)" ::: "memory");
}
__device__ __forceinline__ void p0_convert(const float* const* in, bf16_t* __restrict__ wt, LAS float* lds) {
    const int lane = threadIdx.x & 63, w = threadIdx.x >> 6;
    LAS float* scr = lds + w * (64 * 33 + 16);
    const int gw = blockIdx.x * NWAVES + w, NGW = gridDim.x * NWAVES;
    constexpr int I_IN = 16 * 169, I_BF = 4 * 32, I_BS = 8 * 32, I_BM = 4 * 32, I_O = 16 * 32, I_1 = NE * 16 * 64, I_2 = NE * 16 * 32;
    constexpr int PER_L = I_IN + I_BF + I_BS + I_BM + I_O + I_1 + I_2;
    for (int it = gw; it < NL * PER_L; it += NGW) {
        const int l = it / PER_L; int r = it % PER_L;
        bf16_t* wl = wt + (size_t)l * WT_LAYER;
        if (r < I_IN) { const int kb = r / 169, nb = r % 169; const int nv = (nb == 168) ? 4 : 32;
            p0_transpose_item<1>(in[I_WIN] + (size_t)l * D * DIN, DIN, kb * 64, nb * 32, nv, wl + WT_IN, 0, scr, lane); continue; } r -= I_IN;
        if (r < I_BF) { const int kb = r / 32, nb = r % 32; p0_transpose_item<0>(in[I_WBF] + (size_t)l * 256 * D, D, kb * 64, nb * 32, 32, wl + WT_BR, 0, scr, lane); continue; } r -= I_BF;
        if (r < I_BS) { const int kb = r / 32, nb = r % 32; p0_transpose_item<0>(in[I_WBS] + (size_t)l * 512 * D, D, kb * 64, nb * 32, 32, wl + WT_BR, 256, scr, lane); continue; } r -= I_BS;
        if (r < I_BM) { const int kb = r / 32, nb = r % 32; p0_transpose_item<0>(in[I_WBM] + (size_t)l * 256 * D, D, kb * 64, nb * 32, 32, wl + WT_BR, 768, scr, lane); continue; } r -= I_BM;
        if (r < I_O) { const int kb = r / 32, nb = r % 32; p0_transpose_item<0>(in[I_WOUT] + (size_t)l * D * D, D, kb * 64, nb * 32, 32, wl + WT_OUT, 0, scr, lane); continue; } r -= I_O;
        if (r < I_1) { const int e = r / 1024, q = r % 1024, kb = q / 64, nb = q % 64;
            p0_transpose_item<0>(in[I_W1] + ((size_t)l * NE + e) * D * 2048, 2048, kb * 64, nb * 32, 32, wl + WT_W1 + (size_t)e * 2048 * D, 0, scr, lane); continue; } r -= I_1;
        { const int e = r / 512, q = r % 512, kb = q / 32, nb = q % 32;
            p0_transpose_item<0>(in[I_W2] + ((size_t)l * NE + e) * D * D, D, kb * 64, nb * 32, 32, wl + WT_W2 + (size_t)e * D * D, 0, scr, lane); }
    }
}

namespace pg {
constexpr int BM = 256, BK = 64, HALF = 128, HTB = HALF * BK * 2, STAGE_BYTES = 8 * HTB, KK = 1024, NT = KK / BK;
__device__ __forceinline__ int lds_byte(int r, int c) { const int st = (r >> 4) * 2 + (c >> 5), rr = r & 15, cc = c & 31, ob = rr * 64 + cc * 2; return st * 1024 + (ob ^ (((ob >> 9) & 1) << 5)); }
__device__ __forceinline__ void stage_rc(int b, int& R, int& C) { const int st = b / 1024, sb = b % 1024, swz = sb ^ (((sb >> 9) & 1) << 5); R = (st >> 1) * 16 + swz / 64; C = (st & 1) * 32 + (swz % 64) / 2; }
__device__ __forceinline__ int perm32(int rho) { const int n = rho >> 4, i = rho & 15; return 8 * (i >> 2) + 4 * n + (i & 3); }
struct Unit { int pm, pn, e, rb; };
__device__ __forceinline__ unsigned cvt_pk_bf16(float lo, float hi) { unsigned r; asm volatile("v_cvt_pk_bf16_f32 %0, %1, %2" : "=v"(r) : "v"(lo), "v"(hi)); return r; }
typedef f32x4 Acc[2][2][4][2];
template <class G>
__device__ __forceinline__ void gemm_phase(LAS unsigned char* lds, const G& g) {
    const int tid = opaque((int)threadIdx.x), wid = __builtin_amdgcn_readfirstlane(tid >> 6), lane = tid & 63, wr = wid >> 2, wc = wid & 3, fr = lane & 15, fq = lane >> 4;
    unsigned voffA[2], voffB[2];
    int Rr[2];
#pragma unroll
    for (int i = 0; i < 2; ++i) { int R, C; stage_rc(tid * 16 + i * 8192, R, C); Rr[i] = R; const int Rb = G::PERM ? ((R & ~31) + perm32(R & 31)) : R;
        voffA[i] = G::GATHER ? (unsigned)C * 2u : (unsigned)(R * g.lda() + C) * 2u; voffB[i] = (unsigned)(Rb * KK + C) * 2u; }
    const size_t kstep = (size_t)(BK * 2), hstep = (size_t)HALF * KK * 2;
    const size_t hstepA = G::GATHER ? 0 : (size_t)HALF * g.lda() * 2;
    const unsigned ldsw = (unsigned)wid * 1024u;
    const int aoff = lds_byte(wr * 64 + fr, fq * 8), boff = lds_byte(wc * 32 + fr, fq * 8);
#define PG_SA(b, h) (((b) * 2 + (h)) * HTB)
#define PG_SB(b, h) ((4 + (b) * 2 + (h)) * HTB)
#define PG_STAGE(bufoff, gbase, voff) do { _Pragma("unroll") for (int _i = 0; _i < 2; ++_i) \
        __builtin_amdgcn_global_load_lds((const unsigned*)((const char*)(gbase) + (voff)[_i]), (LAS unsigned*)(lds + (bufoff) + ldsw + _i * 8192), 16, 0, 0); } while (0)
#define PG_STAGE_A(bufoff, ab, h, go) do { if constexpr (G::GATHER) { PG_STAGE(bufoff, ab, (go)[h]); } else { PG_STAGE(bufoff, (ab) + (h) * hstepA, voffA); } } while (0)
#define PG_LDA(dst, b, h) do { _Pragma("unroll") for (int m = 0; m < 4; ++m) _Pragma("unroll") for (int k = 0; k < 2; ++k) dst[m][k] = *(const LAS bf16x8*)(lds + PG_SA(b, h) + aoff + m * 2048 + k * 1024); } while (0)
#define PG_LDB(dst, b, h) do { _Pragma("unroll") for (int n = 0; n < 2; ++n) _Pragma("unroll") for (int k = 0; k < 2; ++k) dst[n][k] = *(const LAS bf16x8*)(lds + PG_SB(b, h) + boff + n * 2048 + k * 1024); } while (0)
#define PG_MMA(ai, bj, At, Bt) do { __builtin_amdgcn_s_setprio(1); _Pragma("unroll") for (int m = 0; m < 4; ++m) _Pragma("unroll") for (int n = 0; n < 2; ++n) _Pragma("unroll") for (int k = 0; k < 2; ++k) \
        acc[ai][bj][m][n] = __builtin_amdgcn_mfma_f32_16x16x32_bf16(Bt[n][k], At[m][k], acc[ai][bj][m][n], 0, 0, 0); __builtin_amdgcn_s_setprio(0); } while (0)
#define PG_WAIT_V(n) asm volatile("s_waitcnt vmcnt(" #n ")" ::: "memory")
#define PG_WAIT_L(n) asm volatile("s_waitcnt lgkmcnt(" #n ")" ::: "memory")
#define PG_BAR __builtin_amdgcn_s_barrier()
#define PG_SCHED __builtin_amdgcn_sched_barrier(0)
    Unit cur, nxt; int ui = 0;
    if (!g.next(0, cur)) return;
    Acc acc;
#pragma unroll
    for (int a = 0; a < 2; ++a)
#pragma unroll
        for (int b = 0; b < 2; ++b)
#pragma unroll
            for (int m = 0; m < 4; ++m)
#pragma unroll
                for (int n = 0; n < 2; ++n) acc[a][b][m][n] = (f32x4){0.f, 0.f, 0.f, 0.f};
    bf16x8 At[4][2], B0[2][2], B1[2][2];
    unsigned goC[2][2], goN[2][2];
    if constexpr (G::GATHER) g.gather_offs(0, Rr, voffA, goC);
    const char* cA = g.a_tile(cur); const char* cB = g.b_tile(cur);
    PG_STAGE(PG_SB(0, 0), cB, voffB); PG_STAGE(PG_SB(0, 1), cB + hstep, voffB); PG_STAGE_A(PG_SA(0, 0), cA, 0, goC); PG_STAGE_A(PG_SA(0, 1), cA, 1, goC);
    if (wr == 1) PG_BAR;
    PG_WAIT_V(2); PG_BAR;
    PG_STAGE(PG_SB(1, 0), cB + kstep, voffB); PG_STAGE_A(PG_SA(1, 0), cA + kstep, 0, goC); PG_STAGE(PG_SB(1, 1), cB + hstep + kstep, voffB);
    PG_WAIT_V(6); PG_BAR;
    for (;;) {
        const bool has_next = g.next(ui + 1, nxt);
        const char* nA = has_next ? g.a_tile(nxt) : cA; const char* nB = has_next ? g.b_tile(nxt) : cB;
        if constexpr (G::GATHER) { if (has_next) g.gather_offs(ui + 1, Rr, voffA, goN); else { goN[0][0] = goC[0][0]; goN[0][1] = goC[0][1]; goN[1][0] = goC[1][0]; goN[1][1] = goC[1][1]; } }
        for (int t = 0; t < NT; t += 2) {
            const bool last = (t == NT - 2);
            if constexpr (G::MID) { if (t == 4 || t == 12) { g.mid(acc, cur, t, wr, wc, opaque(fr), opaque(fq)); PG_SCHED; } }
            const char* a1 = cA + (size_t)(t + 1) * kstep;
            const char* a2 = last ? nA : cA + (size_t)(t + 2) * kstep; const char* b2 = last ? nB : cB + (size_t)(t + 2) * kstep;
            const char* a3 = a2 + kstep; const char* b3 = b2 + kstep;
            unsigned go2[2][2];
            if constexpr (G::GATHER) {
#pragma unroll
                for (int h = 0; h < 2; ++h)
#pragma unroll
                    for (int i = 0; i < 2; ++i) go2[h][i] = last ? goN[h][i] : goC[h][i]; }
            PG_LDB(B0, 0, 0); PG_LDB(B1, 0, 1); PG_SCHED; PG_LDA(At, 0, 0); PG_STAGE_A(PG_SA(1, 1), a1, 1, goC);
            PG_WAIT_V(8); PG_WAIT_L(0); PG_BAR; PG_MMA(0, 0, At, B0); PG_MMA(0, 1, At, B1); PG_BAR; PG_SCHED;
            PG_LDA(At, 0, 1); PG_STAGE(PG_SB(0, 0), b2, voffB); PG_STAGE(PG_SB(0, 1), b2 + hstep, voffB); PG_STAGE_A(PG_SA(0, 0), a2, 0, go2);
            PG_WAIT_V(8); PG_WAIT_L(0); PG_BAR; PG_MMA(1, 0, At, B0); PG_MMA(1, 1, At, B1); PG_BAR; PG_SCHED;
            PG_LDB(B0, 1, 0); PG_LDB(B1, 1, 1); PG_SCHED; PG_LDA(At, 1, 0); PG_STAGE_A(PG_SA(0, 1), a2, 1, go2);
            PG_WAIT_V(8); PG_WAIT_L(0); PG_BAR; PG_MMA(0, 0, At, B0); PG_MMA(0, 1, At, B1); PG_BAR; PG_SCHED;
            PG_LDA(At, 1, 1); PG_STAGE(PG_SB(1, 0), b3, voffB); PG_STAGE(PG_SB(1, 1), b3 + hstep, voffB); PG_STAGE_A(PG_SA(1, 0), a3, 0, go2);
            PG_WAIT_V(8); PG_WAIT_L(0); PG_BAR; PG_MMA(1, 0, At, B0); PG_MMA(1, 1, At, B1); PG_BAR; PG_SCHED;
        }
        if (wr == 0) PG_BAR;
        g.epi(acc, cur, wr, wc, opaque(fr), opaque(fq));
        if (!has_next) break;
#pragma unroll
        for (int a = 0; a < 2; ++a)
#pragma unroll
            for (int b = 0; b < 2; ++b)
#pragma unroll
                for (int m = 0; m < 4; ++m)
#pragma unroll
                    for (int n = 0; n < 2; ++n) acc[a][b][m][n] = (f32x4){0.f, 0.f, 0.f, 0.f};
        cur = nxt; cA = nA; cB = nB; ++ui;
        if constexpr (G::GATHER) {
#pragma unroll
            for (int h = 0; h < 2; ++h)
#pragma unroll
                for (int i = 0; i < 2; ++i) goC[h][i] = goN[h][i]; }
        if (wr == 1) PG_BAR;
    }
    PG_WAIT_V(0);
    PG_BAR;
#undef PG_SA
#undef PG_SB
#undef PG_STAGE
#undef PG_STAGE_A
#undef PG_LDA
#undef PG_LDB
#undef PG_MMA
#undef PG_WAIT_V
#undef PG_WAIT_L
#undef PG_BAR
#undef PG_SCHED
}

struct TileOrder {
    int nM, nN, nwg, G, c;
    __device__ __forceinline__ void init(int nM_, int nN_, int G_, int c_) { nM = nM_; nN = nN_; nwg = nM * nN; G = G_; c = c_; }
    __device__ __forceinline__ bool next(int i, Unit& u) const {
        const long L = (long)i * G + c; if (L >= nwg) return false;
        int wgid = (int)L; { const int q = nwg / 8, r = nwg % 8, xcd = wgid % 8, off = wgid / 8; wgid = (xcd < r ? xcd * (q + 1) : r * (q + 1) + (xcd - r) * q) + off; }
        const int nig = 8 * nN, gid = wgid / nig, fm = gid * 8, gsz = (nM - fm) < 8 ? (nM - fm) : 8;
        u.pm = fm + ((wgid % nig) % gsz); u.pn = (wgid % nig) / gsz; u.e = 0; u.rb = u.pm * BM; return true;
    }
};
struct GOut {
    static constexpr bool PERM = false, MID = false, GATHER = false;
    TileOrder ord; const bf16_t* A; const bf16_t* Bt; float* X; const float* modl;
    __device__ __forceinline__ bool next(int i, Unit& u) const { return ord.next(i, u); }
    __device__ __forceinline__ int lda() const { return D; }
    __device__ __forceinline__ void gather_offs(int, const int (&)[2], const unsigned (&)[2], unsigned (&)[2][2]) const {}
    __device__ __forceinline__ const char* a_tile(const Unit& u) const { return (const char*)(A + (size_t)u.pm * BM * D); }
    __device__ __forceinline__ const char* b_tile(const Unit& u) const { return (const char*)(Bt + (size_t)u.pn * BM * KK); }
    __device__ __forceinline__ void mid(Acc&, const Unit&, int, int, int, int, int) const {}
    __device__ __forceinline__ void epi(Acc& acc, const Unit& u, int wr, int wc, int fr, int fq) const {
        const int row0 = u.pm * BM + wr * 64 + fr, col0 = u.pn * BM + wc * 32 + 4 * fq;
        const float* g1 = modl + (size_t)(u.pm >> 4) * 6144 + 2 * D;
        f32x4 gv[2][2];
#pragma unroll
        for (int bj = 0; bj < 2; ++bj)
#pragma unroll
            for (int n = 0; n < 2; ++n) gv[bj][n] = *(const f32x4*)(g1 + col0 + bj * HALF + n * 16);
#pragma unroll
        for (int ai = 0; ai < 2; ++ai)
#pragma unroll
            for (int m = 0; m < 4; ++m) { float* rowp = X + (size_t)(row0 + ai * HALF + m * 16) * D + col0;
#pragma unroll
                for (int bj = 0; bj < 2; ++bj)
#pragma unroll
                    for (int n = 0; n < 2; ++n) { f32x4 x = *(const f32x4*)(rowp + bj * HALF + n * 16); x += gv[bj][n] * acc[ai][bj][m][n]; *(f32x4*)(rowp + bj * HALF + n * 16) = x; }
                asm volatile("" ::: "memory"); }
    }
};

struct GBranch {
    static constexpr bool PERM = true, MID = true, GATHER = false;
    TileOrder ord; const bf16_t* A; const bf16_t* Bt; const bf16_t* PROJ; bf16_t* MERGED;
    __device__ __forceinline__ bool next(int i, Unit& u) const { return ord.next(i, u); }
    __device__ __forceinline__ int lda() const { return D; }
    __device__ __forceinline__ void gather_offs(int, const int (&)[2], const unsigned (&)[2], unsigned (&)[2][2]) const {}
    __device__ __forceinline__ const char* a_tile(const Unit& u) const { return (const char*)(A + (size_t)u.pm * BM * D); }
    __device__ __forceinline__ const char* b_tile(const Unit& u) const { return (const char*)(Bt + (size_t)u.pn * BM * KK); }
    __device__ __forceinline__ void mid(Acc& acc, const Unit& u, int t, int wr, int wc, int fr, int fq) const {
        const int num = (t == 4) ? GA : GB, den = (t == 4) ? GB : GC;
        const int row0 = u.pm * BM + wr * 64 + fr, col0 = u.pn * BM + wc * 32 + 8 * fq;
#pragma unroll
        for (int ai = 0; ai < 2; ++ai)
#pragma unroll
            for (int m = 0; m < 4; ++m) { const bf16_t* pr = PROJ + (size_t)(row0 + ai * HALF + m * 16) * PW + col0;
#pragma unroll
                for (int bj = 0; bj < 2; ++bj) { const u32x4 gn = *(const u32x4*)(pr + num + bj * HALF), gd = *(const u32x4*)(pr + den + bj * HALF);
#pragma unroll
                    for (int i = 0; i < 4; ++i) {
                        const float r0 = bf2f(gn[i] & 0xffffu) * __builtin_amdgcn_rcpf(fmaxf(bf2f(gd[i] & 0xffffu), 1e-30f));
                        const float r1 = bf2f(gn[i] >> 16) * __builtin_amdgcn_rcpf(fmaxf(bf2f(gd[i] >> 16), 1e-30f));
                        acc[ai][bj][m][i >> 1][(i & 1) * 2] *= r0; acc[ai][bj][m][i >> 1][(i & 1) * 2 + 1] *= r1; } }
                asm volatile("" ::: "memory"); }
    }
    __device__ __forceinline__ void epi(Acc& acc, const Unit& u, int wr, int wc, int fr, int fq) const {
        const int row0 = u.pm * BM + wr * 64 + fr, col0 = u.pn * BM + wc * 32 + 8 * fq;
#pragma unroll
        for (int ai = 0; ai < 2; ++ai)
#pragma unroll
            for (int m = 0; m < 4; ++m) { const size_t row = (size_t)(row0 + ai * HALF + m * 16);
#pragma unroll
                for (int bj = 0; bj < 2; ++bj) { const u32x4 gc = *(const u32x4*)(PROJ + row * PW + GC + col0 + bj * HALF);
                    const f32x4 v0 = acc[ai][bj][m][0], v1 = acc[ai][bj][m][1];
                    u32x4 w; w.x = cvt_pk_bf16(v0[0] * bf2f(gc.x & 0xffffu), v0[1] * bf2f(gc.x >> 16)); w.y = cvt_pk_bf16(v0[2] * bf2f(gc.y & 0xffffu), v0[3] * bf2f(gc.y >> 16));
                    w.z = cvt_pk_bf16(v1[0] * bf2f(gc.z & 0xffffu), v1[1] * bf2f(gc.z >> 16)); w.w = cvt_pk_bf16(v1[2] * bf2f(gc.w & 0xffffu), v1[3] * bf2f(gc.w >> 16));
                    *(u32x4*)(MERGED + row * D + col0 + bj * HALF) = w; }
                asm volatile("" ::: "memory"); }
    }
};

struct GIn {
    static constexpr bool PERM = true, MID = false, GATHER = false;
    TileOrder ord; const bf16_t* A; const bf16_t* Bt; bf16_t* PROJ; const float* qkg; float* kmean;
    __device__ __forceinline__ bool next(int i, Unit& u) const { return ord.next(i, u); }
    __device__ __forceinline__ int lda() const { return D; }
    __device__ __forceinline__ void gather_offs(int, const int (&)[2], const unsigned (&)[2], unsigned (&)[2][2]) const {}
    __device__ __forceinline__ const char* a_tile(const Unit& u) const { return (const char*)(A + (size_t)u.pm * BM * D); }
    __device__ __forceinline__ const char* b_tile(const Unit& u) const { return (const char*)(Bt + (size_t)u.pn * BM * KK); }
    __device__ __forceinline__ void mid(Acc&, const Unit&, int, int, int, int, int) const {}
    __device__ __forceinline__ void epi(Acc& acc, const Unit& u, int wr, int wc, int fr, int fq) const {
        const int c0 = u.pn * BM + wc * 64;
        int kind, gi = 0;
        if (c0 < 256) { kind = 1; gi = 0; } else if (c0 < 512) { kind = 2; gi = 1; } else if (c0 < 768) kind = 0;
        else if (c0 < 1280) { kind = 1; gi = 2; } else if (c0 < 1408) { kind = 2; gi = 3; } else if (c0 < 1536) kind = 0;
        else if (c0 < 1792) { kind = 1; gi = 4; } else if (c0 < 2048) { kind = 2; gi = 5; } else if (c0 < 2304) kind = 0; else kind = 3;
        const bool mk = (c0 >= MK && c0 < MV);
        const int row0 = u.pm * BM + wr * 64 + fr;
        bf16_t* pbase = PROJ + (size_t)row0 * PW + c0 + 8 * fq;
        if (kind == 1 || kind == 2) {
            f32x4 gq[2][2]; f32x4 ks[2][2];
#pragma unroll
            for (int bj = 0; bj < 2; ++bj)
#pragma unroll
                for (int n = 0; n < 2; ++n) { gq[bj][n] = *(const f32x4*)(qkg + gi * 64 + 32 * bj + 8 * fq + 4 * n); ks[bj][n] = (f32x4){0.f, 0.f, 0.f, 0.f}; }
            const float post = (kind == 1) ? C2 : 1.0f;
#pragma unroll
            for (int ai = 0; ai < 2; ++ai)
#pragma unroll
                for (int m = 0; m < 4; ++m) {
                    float ss = 0.f;
#pragma unroll
                    for (int bj = 0; bj < 2; ++bj)
#pragma unroll
                        for (int n = 0; n < 2; ++n) { const f32x4 x = acc[ai][bj][m][n]; ss += (x[0] * x[0] + x[1] * x[1]) + (x[2] * x[2] + x[3] * x[3]); }
                    ss += __shfl_xor(ss, 16); ss += __shfl_xor(ss, 32);
                    const float r = rsqrtf(ss * (1.0f / 64.0f) + EPS) * post;
                    bf16_t* rowp = pbase + (size_t)(ai * HALF + m * 16) * PW;
#pragma unroll
                    for (int bj = 0; bj < 2; ++bj) { const f32x4 v0 = acc[ai][bj][m][0] * r * gq[bj][0], v1 = acc[ai][bj][m][1] * r * gq[bj][1];
                        u32x4 w; w.x = cvt_pk_bf16(v0[0], v0[1]); w.y = cvt_pk_bf16(v0[2], v0[3]); w.z = cvt_pk_bf16(v1[0], v1[1]); w.w = cvt_pk_bf16(v1[2], v1[3]);
                        *(u32x4*)(rowp + 32 * bj) = w;
                        if (mk) { ks[bj][0][0] += bf2f(w.x & 0xffffu); ks[bj][0][1] += bf2f(w.x >> 16); ks[bj][0][2] += bf2f(w.y & 0xffffu); ks[bj][0][3] += bf2f(w.y >> 16);
                                  ks[bj][1][0] += bf2f(w.z & 0xffffu); ks[bj][1][1] += bf2f(w.z >> 16); ks[bj][1][2] += bf2f(w.w & 0xffffu); ks[bj][1][3] += bf2f(w.w >> 16); } }
                    asm volatile("" ::: "memory");
                }
            if (mk) {
                float* km = kmean + (size_t)u.pm * 256 + wc * 64 + 8 * fq;
#pragma unroll
                for (int bj = 0; bj < 2; ++bj)
#pragma unroll
                    for (int n = 0; n < 2; ++n)
#pragma unroll
                        for (int i = 0; i < 4; ++i) { float v = ks[bj][n][i]; v += __shfl_xor(v, 1); v += __shfl_xor(v, 2); v += __shfl_xor(v, 4); v += __shfl_xor(v, 8);
                            if (fr == 0) atomicAdd(km + 32 * bj + 4 * n + i, v); }
            }
        } else {
#pragma unroll
            for (int ai = 0; ai < 2; ++ai)
#pragma unroll
                for (int m = 0; m < 4; ++m) { bf16_t* rowp = pbase + (size_t)(ai * HALF + m * 16) * PW;
#pragma unroll
                    for (int bj = 0; bj < 2; ++bj) { f32x4 v0 = acc[ai][bj][m][0], v1 = acc[ai][bj][m][1];
                        if (kind == 3) {
#pragma unroll
                            for (int i = 0; i < 4; ++i) { v0[i] = __builtin_amdgcn_rcpf(1.0f + __expf(-v0[i])); v1[i] = __builtin_amdgcn_rcpf(1.0f + __expf(-v1[i])); } }
                        u32x4 w; w.x = cvt_pk_bf16(v0[0], v0[1]); w.y = cvt_pk_bf16(v0[2], v0[3]); w.z = cvt_pk_bf16(v1[0], v1[1]); w.w = cvt_pk_bf16(v1[2], v1[3]);
                        *(u32x4*)(rowp + 32 * bj) = w; }
                    asm volatile("" ::: "memory"); }
        }
    }
};

constexpr int LDS_GTAB = LDS_CTL + 2048, GTAB_UNITS = 24;
__device__ __forceinline__ int moe_find(const volatile LAS unsigned* LC, int mg) { int e = 0;
#pragma unroll 1
    for (int i = 1; i < NE; ++i) e = ((int)LC[LC_TPF + i] <= mg) ? i : e;
    return __builtin_amdgcn_readfirstlane(e); }
struct GMoe1 {
    static constexpr bool PERM = true, MID = false, GATHER = true;
    const volatile LAS unsigned* LC; const LAS unsigned short* gtab; const bf16_t* A; const bf16_t* Bt; const float* b1; bf16_t* A2; int c;
    __device__ __forceinline__ bool next(int i, Unit& u) const {
        const int x = c & 7, j = c >> 3, mg = 32 * i + 8 * (j >> 3) + x;
        if (mg >= (int)LC[LC_TPF + NE]) return false;
        u.pm = mg; u.pn = j & 7; u.e = moe_find(LC, mg); u.rb = mg * BM; return true; }
    __device__ __forceinline__ int lda() const { return D; }
    __device__ __forceinline__ void gather_offs(int ui, const int (&R)[2], const unsigned (&voffA)[2], unsigned (&go)[2][2]) const {
#pragma unroll
        for (int h = 0; h < 2; ++h)
#pragma unroll
            for (int i = 0; i < 2; ++i) go[h][i] = (unsigned)gtab[ui * 256 + h * HALF + R[i]] * (unsigned)(D * 2) + voffA[i]; }
    __device__ __forceinline__ const char* a_tile(const Unit&) const { return (const char*)A; }
    __device__ __forceinline__ const char* b_tile(const Unit& u) const { return (const char*)(Bt + ((size_t)u.e * 2048 + (size_t)u.pn * BM) * KK); }
    __device__ __forceinline__ void mid(Acc&, const Unit&, int, int, int, int, int) const {}
    __device__ __forceinline__ void epi(Acc& acc, const Unit& u, int wr, int wc, int fr, int fq) const {
        const int row0 = u.rb + wr * 64 + fr, col0 = u.pn * BM + wc * 32 + 8 * fq;
        const float* bp = b1 + (size_t)u.e * 2048 + col0;
        f32x4 bv[2][2];
#pragma unroll
        for (int bj = 0; bj < 2; ++bj)
#pragma unroll
            for (int n = 0; n < 2; ++n) bv[bj][n] = *(const f32x4*)(bp + bj * HALF + 4 * n);
#pragma unroll
        for (int ai = 0; ai < 2; ++ai)
#pragma unroll
            for (int m = 0; m < 4; ++m) { bf16_t* rowp = A2 + (size_t)(row0 + ai * HALF + m * 16) * D + (col0 >> 1);
#pragma unroll
                for (int bj = 0; bj < 2; ++bj) { const f32x4 v0 = acc[ai][bj][m][0] + bv[bj][0], v1 = acc[ai][bj][m][1] + bv[bj][1];
                    float o[4];
#pragma unroll
                    for (int q = 0; q < 4; ++q) { float gl = (q < 2) ? v0[2 * q] : v1[2 * q - 4], ln = (q < 2) ? v0[2 * q + 1] : v1[2 * q - 3];
                        gl = fminf(gl, 7.0f); ln = fminf(fmaxf(ln, -7.0f), 7.0f);
                        o[q] = gl * __builtin_amdgcn_rcpf(1.0f + __expf(-1.702f * gl)) * (ln + 1.0f); }
                    u32x2 w; w.x = cvt_pk_bf16(o[0], o[1]); w.y = cvt_pk_bf16(o[2], o[3]);
                    *(u32x2*)(rowp + bj * (HALF / 2)) = w; }
                asm volatile("" ::: "memory"); }
    }
};
struct GMoe2 {
    static constexpr bool PERM = true, MID = false, GATHER = false;
    const volatile LAS unsigned* LC; const bf16_t* A; const bf16_t* Bt; const float* b2; const float* listw; bf16_t* Y; int c;
    __device__ __forceinline__ bool next(int i, Unit& u) const {
        const int x = c & 7, j = c >> 3, mg = 64 * i + 8 * (j >> 2) + x;
        if (mg >= (int)LC[LC_TPF + NE]) return false;
        u.pm = mg; u.pn = j & 3; u.e = moe_find(LC, mg); u.rb = mg * BM; return true; }
    __device__ __forceinline__ int lda() const { return D; }
    __device__ __forceinline__ void gather_offs(int, const int (&)[2], const unsigned (&)[2], unsigned (&)[2][2]) const {}
    __device__ __forceinline__ const char* a_tile(const Unit& u) const { return (const char*)(A + (size_t)u.rb * D); }
    __device__ __forceinline__ const char* b_tile(const Unit& u) const { return (const char*)(Bt + ((size_t)u.e * D + (size_t)u.pn * BM) * KK); }
    __device__ __forceinline__ void mid(Acc&, const Unit&, int, int, int, int, int) const {}
    __device__ __forceinline__ void epi(Acc& acc, const Unit& u, int wr, int wc, int fr, int fq) const {
        const int row0 = u.rb + wr * 64 + fr, col0 = u.pn * BM + wc * 32 + 8 * fq;
        const int p0 = row0 - (int)LC[LC_TPF + u.e] * BM, cn = (int)LC[LC_CNT + u.e];
        const float* bp = b2 + (size_t)u.e * D + col0;
        f32x4 bv[2][2];
#pragma unroll
        for (int bj = 0; bj < 2; ++bj)
#pragma unroll
            for (int n = 0; n < 2; ++n) bv[bj][n] = *(const f32x4*)(bp + bj * HALF + 4 * n);
#pragma unroll
        for (int ai = 0; ai < 2; ++ai)
#pragma unroll
            for (int m = 0; m < 4; ++m) { const int pos = p0 + ai * HALF + m * 16; const float gw = (pos < cn) ? listw[(size_t)u.e * CAP + pos] : 0.f;
                bf16_t* rowp = Y + (size_t)(row0 + ai * HALF + m * 16) * D + col0;
#pragma unroll
                for (int bj = 0; bj < 2; ++bj) { const f32x4 v0 = (acc[ai][bj][m][0] + bv[bj][0]) * gw, v1 = (acc[ai][bj][m][1] + bv[bj][1]) * gw;
                    u32x4 w; w.x = cvt_pk_bf16(v0[0], v0[1]); w.y = cvt_pk_bf16(v0[2], v0[3]); w.z = cvt_pk_bf16(v1[0], v1[1]); w.w = cvt_pk_bf16(v1[2], v1[3]);
                    *(u32x4*)(rowp + bj * HALF) = w; }
                asm volatile("" ::: "memory"); }
    }
};
}

namespace at {
constexpr int L_K = 0, L_V = 16384, L_BIAS = 32768, L_SEL = 49152, L_GATE = 50176, L_RED = 66560;
typedef short v4i16_t __attribute__((ext_vector_type(4)));
__device__ __forceinline__ int crow(int r, int hi) { return (r & 3) + 8 * (r >> 2) + 4 * hi; }
__device__ __forceinline__ float halves_max(float m) { auto rr = __builtin_amdgcn_permlane32_swap(__float_as_uint(m), __float_as_uint(m), false, false); return fmaxf(__uint_as_float(rr[0]), __uint_as_float(rr[1])); }
__device__ __forceinline__ float halves_sum(float m) { auto rr = __builtin_amdgcn_permlane32_swap(__float_as_uint(m), __float_as_uint(m), false, false); return __uint_as_float(rr[0]) + __uint_as_float(rr[1]); }
__device__ __forceinline__ unsigned cvtpk(float lo, float hi) { unsigned r; asm volatile("v_cvt_pk_bf16_f32 %0, %1, %2" : "=v"(r) : "v"(lo), "v"(hi)); return r; }

template <int VAR  >
__device__ __forceinline__ void attn_unit(LAS unsigned char* lds, int b, int h, int qb, const bf16_t* __restrict__ PROJ, const float* __restrict__ lf, const float* __restrict__ kmean, const float* __restrict__ sinks, bf16_t* __restrict__ OCAT) {
    const int tid = opaque((int)threadIdx.x), lane = tid & 63, w = __builtin_amdgcn_readfirstlane(tid >> 6), r32 = lane & 31, hi = lane >> 5;
    const int q0 = qb * 256, n_keys = q0 + 256;
    int qoff, koff, voff, ooff; float slope2 = 0.f;
    if (VAR == 0) { qoff = FQ + h * 64; koff = FK + h * 64; voff = FV + h * 64; ooff = h * 64; }
    else if (VAR == 1) { qoff = SQ + h * 64; koff = SK + (h >> 2) * 64; voff = SV + (h >> 2) * 64; ooff = 256 + h * 64; slope2 = alibi_slope(h) * LOG2E; }
    else { qoff = MQ + h * 64; koff = MK + h * 64; voff = MV + h * 64; ooff = 768 + h * 64; slope2 = alibi_slope(8 + h) * LOG2E; }
    const bf16_t* base = PROJ + (size_t)b * S * PW;
    LAS float* biasT = (LAS float*)(lds + L_BIAS);
    LAS float* red = (LAS float*)(lds + L_RED);
    const int t_lo = (VAR == 1) ? (qb > 0 ? 4 * qb - 2 : 0) : 0, t_hi = 4 * qb + 4;
    if (VAR == 0) {
        float c8[8]; const int s0 = 8 * tid;
        if (s0 < n_keys) { const f32x4 a = *(const f32x4*)(lf + (size_t)(b * 4 + h) * S + s0), c = *(const f32x4*)(lf + (size_t)(b * 4 + h) * S + s0 + 4);
            c8[0] = a[0]; c8[1] = c8[0] + a[1]; c8[2] = c8[1] + a[2]; c8[3] = c8[2] + a[3]; c8[4] = c8[3] + c[0]; c8[5] = c8[4] + c[1]; c8[6] = c8[5] + c[2]; c8[7] = c8[6] + c[3]; }
        else {
#pragma unroll
            for (int i = 0; i < 8; ++i) c8[i] = 0.f; }
        float incl = c8[7];
#pragma unroll
        for (int o = 1; o < 64; o <<= 1) { const float v = __shfl_up(incl, o); if (lane >= o) incl += v; }
        if (lane == 63) red[w] = incl;
        __syncthreads();
        float wp = 0.f;
#pragma unroll
        for (int i = 0; i < 8; ++i) wp += (i < w) ? red[i] : 0.f;
        const float offs = wp + incl - c8[7];
#pragma unroll
        for (int i = 0; i < 8; ++i) c8[i] += offs;
        if (s0 == q0) red[15] = c8[0];
        __syncthreads();
        const float cref = red[15];
        if (s0 < n_keys) { *(LAS f32x4*)(biasT + s0) = (f32x4){(cref - c8[0]) * LOG2E, (cref - c8[1]) * LOG2E, (cref - c8[2]) * LOG2E, (cref - c8[3]) * LOG2E};
                           *(LAS f32x4*)(biasT + s0 + 4) = (f32x4){(cref - c8[4]) * LOG2E, (cref - c8[5]) * LOG2E, (cref - c8[6]) * LOG2E, (cref - c8[7]) * LOG2E}; }
    } else {
        for (int s = 64 * t_lo + tid; s < n_keys; s += NTHR) biasT[s] = slope2 * (float)(s - q0);
    }
    unsigned selmask = 0u;
    if (VAR == 2 && qb > 0) {
        LAS float* gate = (LAS float*)(lds + L_GATE);
        { const int q = tid & 255, half = tid >> 8;
          float qf[64];
          const u32x4* qp = (const u32x4*)(base + (size_t)(q0 + q) * PW + qoff);
#pragma unroll
          for (int c = 0; c < 8; ++c) { const u32x4 x = qp[c];
#pragma unroll
              for (int i = 0; i < 4; ++i) { qf[8 * c + 2 * i] = bf2f(x[i] & 0xffffu); qf[8 * c + 2 * i + 1] = bf2f(x[i] >> 16); } }
          for (int j = half; j < qb; j += 2) { const float* km = kmean + (size_t)(b * 16 + j) * 256 + h * 64; float a = 0.f;
#pragma unroll
              for (int d = 0; d < 64; ++d) a += qf[d] * km[d];
              gate[q * 16 + j] = a; } }
        __syncthreads();
        if (tid < 256) { const int nsel = qb < 3 ? qb : 3; unsigned mask = 0u;
            for (int kk = 0; kk < nsel; ++kk) { int bi = 0; float bv = -INFINITY;
                for (int j = 0; j < qb; ++j) { const float a = gate[tid * 16 + j]; if (!((mask >> j) & 1u) && a > bv) { bv = a; bi = j; } }
                mask |= 1u << bi; }
            ((LAS unsigned*)(lds + L_SEL))[tid] = mask; }
        __syncthreads();
        selmask = ((LAS unsigned*)(lds + L_SEL))[32 * w + r32];
    }
    const int qa = q0 + 32 * w + r32;
    bf16x8 qr[4];
#pragma unroll
    for (int d0 = 0; d0 < 4; ++d0) qr[d0] = *(const bf16x8*)(base + (size_t)qa * PW + qoff + 16 * d0 + 8 * hi);
    const bf16_t* kg = base + (size_t)lane * PW + koff + w * 8;
    const bf16_t* vg = base + (size_t)(16 * (w & 3) + (lane >> 2)) * PW + voff + (w >> 2) * 32 + (lane & 3) * 8;
    const int kdst = L_K + w * 1024 + lane * 16, vdst = L_V + (w >> 2) * 4096 + (16 * (w & 3) + (lane >> 2)) * 64 + (lane & 3) * 16;
    const int kfr = L_K + hi * 1024 + r32 * 16;
    const int vfr = L_V + ((lane >> 4) & 1) * 32 + (lane & 3) * 8 + (4 * hi + ((lane & 15) >> 2)) * 64;
    u32x4 kreg = *(const u32x4*)(kg + (size_t)(64 * t_lo) * PW), vreg = *(const u32x4*)(vg + (size_t)(64 * t_lo) * PW);
    *(LAS u32x4*)(lds + kdst) = kreg; *(LAS u32x4*)(lds + vdst) = vreg;
    __syncthreads();
    f32x16 o0 = {}, o1 = {};
    float m = -1e30f, l = 0.f;
    const int qlo = q0 + 32 * w, qhi = qlo + 31;
    for (int jt = t_lo; jt < t_hi; ++jt) {
        const int slot = ((jt - t_lo) & 1) * 8192, kv0 = 64 * jt;
        const bool more = jt + 1 < t_hi;
        if (more) { kreg = *(const u32x4*)(kg + (size_t)(kv0 + 64) * PW); vreg = *(const u32x4*)(vg + (size_t)(kv0 + 64) * PW); }
        int mode; bool sel = true;
        if (VAR == 0) mode = (kv0 > qhi) ? 0 : (kv0 + 63 <= qlo ? 1 : 2);
        else if (VAR == 1) mode = (kv0 > qhi || kv0 + 63 < qlo - 127) ? 0 : ((kv0 + 63 <= qlo && kv0 >= qhi - 127) ? 1 : 2);
        else { const int jb = kv0 >> 8;
            if (jb < qb) { sel = (selmask >> jb) & 1u; const unsigned long long bal = __ballot(sel); mode = (bal == 0ull) ? 0 : (bal == ~0ull ? 1 : 2); }
            else mode = (kv0 > qhi) ? 0 : (kv0 + 63 <= qlo ? 1 : 2); }
        if (mode != 0) {
            f32x16 p0, p1;
#pragma unroll
            for (int g = 0; g < 4; ++g) { const f32x4 x0 = *(const LAS f32x4*)(biasT + kv0 + 8 * g + 4 * hi), x1 = *(const LAS f32x4*)(biasT + kv0 + 32 + 8 * g + 4 * hi);
#pragma unroll
                for (int i = 0; i < 4; ++i) { p0[4 * g + i] = x0[i]; p1[4 * g + i] = x1[i]; } }
#pragma unroll
            for (int d0 = 0; d0 < 4; ++d0) {
                const bf16x8 k0 = *(const LAS bf16x8*)(lds + slot + kfr + d0 * 2048), k1 = *(const LAS bf16x8*)(lds + slot + kfr + d0 * 2048 + 512);
                p0 = __builtin_amdgcn_mfma_f32_32x32x16_bf16(k0, qr[d0], p0, 0, 0, 0);
                p1 = __builtin_amdgcn_mfma_f32_32x32x16_bf16(k1, qr[d0], p1, 0, 0, 0); }
            if (mode == 2) {
                if (VAR == 2 && (kv0 >> 8) < qb) {
                    if (!sel) {
#pragma unroll
                        for (int r = 0; r < 16; ++r) { p0[r] = -INFINITY; p1[r] = -INFINITY; } }
                } else {
#pragma unroll
                    for (int r = 0; r < 16; ++r) { const int kv = kv0 + crow(r, hi);
                        bool bad0 = kv > qa, bad1 = kv + 32 > qa;
                        if (VAR == 1) { bad0 = bad0 || kv < qa - 127; bad1 = bad1 || kv + 32 < qa - 127; }
                        p0[r] = bad0 ? -INFINITY : p0[r]; p1[r] = bad1 ? -INFINITY : p1[r]; }
                }
            }
            float mx = fmaxf(p0[0], p1[0]);
#pragma unroll
            for (int r = 1; r < 16; ++r) mx = fmaxf(mx, fmaxf(p0[r], p1[r]));
            mx = halves_max(mx);
            const float mn = fmaxf(m, mx), alpha = __builtin_amdgcn_exp2f(m - mn);
            m = mn;
            float rs = 0.f;
#pragma unroll
            for (int r = 0; r < 16; ++r) { p0[r] = __builtin_amdgcn_exp2f(p0[r] - mn); p1[r] = __builtin_amdgcn_exp2f(p1[r] - mn); rs += p0[r] + p1[r]; }
            l = l * alpha + rs;
            if (__any(alpha != 1.0f)) {
#pragma unroll
                for (int r = 0; r < 16; ++r) { o0[r] *= alpha; o1[r] *= alpha; } }
            u32x4 pw[4];
#pragma unroll
            for (int i = 0; i < 4; ++i) { pw[0][i] = cvtpk(p0[2 * i], p0[2 * i + 1]); pw[1][i] = cvtpk(p0[8 + 2 * i], p0[8 + 2 * i + 1]); pw[2][i] = cvtpk(p1[2 * i], p1[2 * i + 1]); pw[3][i] = cvtpk(p1[8 + 2 * i], p1[8 + 2 * i + 1]); }
#pragma unroll
            for (int ks = 0; ks < 4; ++ks) {
                const bf16x8 pb = __builtin_bit_cast(bf16x8, pw[ks]);
                const v4i16_t a0 = __builtin_amdgcn_ds_read_tr16_b64_v4i16((LAS v4i16_t*)(lds + slot + vfr + ks * 1024)), a1 = __builtin_amdgcn_ds_read_tr16_b64_v4i16((LAS v4i16_t*)(lds + slot + vfr + ks * 1024 + 512));
                const v4i16_t c0 = __builtin_amdgcn_ds_read_tr16_b64_v4i16((LAS v4i16_t*)(lds + slot + vfr + 4096 + ks * 1024)), c1 = __builtin_amdgcn_ds_read_tr16_b64_v4i16((LAS v4i16_t*)(lds + slot + vfr + 4096 + ks * 1024 + 512));
                const bf16x8 v0 = (bf16x8){a0[0], a0[1], a0[2], a0[3], a1[0], a1[1], a1[2], a1[3]}, v1 = (bf16x8){c0[0], c0[1], c0[2], c0[3], c1[0], c1[1], c1[2], c1[3]};
                o0 = __builtin_amdgcn_mfma_f32_32x32x16_bf16(v0, pb, o0, 0, 0, 0);
                o1 = __builtin_amdgcn_mfma_f32_32x32x16_bf16(v1, pb, o1, 0, 0, 0); }
        }
        if (more) { *(LAS u32x4*)(lds + (slot ^ 8192) + kdst) = kreg; *(LAS u32x4*)(lds + (slot ^ 8192) + vdst) = vreg; }
        __syncthreads();
    }
    float lt = halves_sum(l);
    if (VAR == 1) lt += __builtin_amdgcn_exp2f(sinks[h] * LOG2E - (m - slope2 * (float)(qa - q0)));
    const float inv = 1.0f / lt;
    bf16_t* op = OCAT + (size_t)(b * S + qa) * D + ooff + 4 * hi;
#pragma unroll
    for (int g = 0; g < 4; ++g) {
        u32x2 w0; w0.x = cvtpk(o0[4 * g] * inv, o0[4 * g + 1] * inv); w0.y = cvtpk(o0[4 * g + 2] * inv, o0[4 * g + 3] * inv); *(u32x2*)(op + 8 * g) = w0;
        u32x2 w1; w1.x = cvtpk(o1[4 * g] * inv, o1[4 * g + 1] * inv); w1.y = cvtpk(o1[4 * g + 2] * inv, o1[4 * g + 3] * inv); *(u32x2*)(op + 32 + 8 * g) = w1; }
}

__device__ __forceinline__ void attn_phase(LAS unsigned char* lds, int l, const bf16_t* PROJ, const float* lf, const float* kmean_l, const float* sinks_l, bf16_t* OCAT) {
    const int G = gridDim.x, bx = blockIdx.x;
    const int vcu = (G % 8 == 0) ? (bx % 8) * (G / 8) + bx / 8 : bx;
    for (int p = vcu; p < 256; p += G) { const int bh = p >> 3, s = p & 7;
        attn_unit<0>(lds, bh >> 2, bh & 3, 15 - s, PROJ, lf, nullptr, nullptr, OCAT);
        attn_unit<0>(lds, bh >> 2, bh & 3, s, PROJ, lf, nullptr, nullptr, OCAT); }
    for (int p = vcu; p < 256; p += G) { const int bh = p >> 3, s = p & 7;
        attn_unit<2>(lds, bh >> 2, bh & 3, 15 - s, PROJ, nullptr, kmean_l, nullptr, OCAT);
        attn_unit<2>(lds, bh >> 2, bh & 3, s, PROJ, nullptr, kmean_l, nullptr, OCAT); }
    for (int p = vcu; p < 256; p += G)
        for (int i = 0; i < 4; ++i) { const int idx = 4 * p + i; attn_unit<1>(lds, idx >> 7, (idx >> 4) & 7, idx & 15, PROJ, nullptr, nullptr, sinks_l, OCAT); }
    (void)l;
}
}

template <int MPR  , bool GATHER>
__device__ __forceinline__ void moe_tables(volatile LAS unsigned* LC, LAS unsigned short* gtab, const int* cnt, const int* list) {
    const int tid = threadIdx.x;
    if (tid == 0) { int a = 0; for (int e = 0; e < NE; ++e) { const int cv = cnt[e]; LC[LC_CNT + e] = (unsigned)cv; LC[LC_TPF + e] = (unsigned)a; a += (cv + 255) >> 8; } LC[LC_TPF + NE] = (unsigned)a; }
    __syncthreads();
    if (GATHER) {
        const int c = blockIdx.x, x = c & 7, j = c >> 3, total = (int)LC[LC_TPF + NE];
        for (int i = 0; i < pg::GTAB_UNITS; ++i) { const int mg = MPR * i + 8 * (j >> 3) + x; if (mg >= total) break;
            const int e = pg::moe_find(LC, mg);
            if (tid < 256) { int pos = (mg - (int)LC[LC_TPF + e]) * 256 + tid; const int cn = (int)LC[LC_CNT + e]; pos = pos < cn ? pos : cn - 1; gtab[i * 256 + tid] = (unsigned short)list[(size_t)e * CAP + pos]; } }
        __syncthreads();
    }
}

constexpr int PH_END = 34;
__global__ void __launch_bounds__(NTHR, 2) mega(MArgs args) {
    extern __shared__ __attribute__((aligned(16))) unsigned char lds_raw[];
    LAS unsigned char* lds = (LAS unsigned char*)lds_raw;
    volatile LAS unsigned* LC = (volatile LAS unsigned*)(lds + LDS_CTL);
    const int tid = threadIdx.x, lane = tid & 63, wave = __builtin_amdgcn_readfirstlane(tid >> 6);
    const int G = gridDim.x;
    unsigned char* ws = args.ws;
    for (int u = tid; u < (LDS_BYTES - LDS_CTL) / 4; u += NTHR) LC[u] = 0u;
    __syncthreads();
    const int lo = args.ph_lo, hi = args.ph_hi;
    XcdBarrier bar; bar.bar = (unsigned*)ws + CW_BAR + args.li * XCD_BAR_WORDS; bar.x = 0; bar.st = nullptr;
    if (hi - lo > 1) bar = xcd_barrier_post((unsigned*)ws + CW_BAR + args.li * XCD_BAR_WORDS, LC + LC_BAR);
#define IN(k) (lo <= (k) && (k) < hi)
#define SEAM(k) do { if (IN(k) && IN((k) + 1)) xcd_barrier(bar); } while (0)
    float* X = args.out;
    float* mod = (float*)(ws + WS_MOD); float* lf = (float*)(ws + WS_LF);
    int* cnt = (int*)(ws + CTL_CNT);
    int* toke = (int*)(ws + WS_TOKE); int* tokp = (int*)(ws + WS_TOKP); int* list = (int*)(ws + WS_LIST); float* listw = (float*)(ws + WS_LISTW);
    bf16_t* H = (bf16_t*)(ws + WS_H); bf16_t* MERGED = (bf16_t*)(ws + WS_MERGED); bf16_t* PROJ = (bf16_t*)(ws + WS_PROJ); bf16_t* OCAT = (bf16_t*)(ws + WS_OCAT);
    bf16_t* Y = (bf16_t*)(ws + WS_Y); bf16_t* A2 = (bf16_t*)(ws + WS_A2); float* kmean = (float*)(ws + CTL_KMEAN);
    bf16_t* WT = (bf16_t*)(ws + WS_WT);
    const int gw = blockIdx.x * NWAVES + wave, NGW = G * NWAVES;

    if (IN(0)) { p0_mod(args.in[I_C], args.in[I_WADA], args.in[I_BADA], mod, (LAS float*)lds); p0_convert(args.in, WT, (LAS float*)lds); }
    SEAM(0);
    for (int l = 0; l < NL; ++l) {
        const int pb = 1 + 8 * l;
        const float* modl = mod + (size_t)l * NB * 6144;
        const bf16_t* wtl = WT + (size_t)l * WT_LAYER;
        if (IN(pb + 0)) {
            NormP p{};
            p.xin = (l == 0) ? args.in[I_X] : X; p.X = X; p.H = H; p.mod = modl; p.modprev = (l == 0) ? nullptr : modl - (size_t)NB * 6144;
            p.gain = args.in[I_NGAIN] + (size_t)(l * 2 + 0) * D; p.Y = Y; p.toke = toke; p.tokp = tokp; p.cntprev = cnt + (l > 0 ? (l - 1) * NE : 0);
            p.wf = args.in[I_WIN] + (size_t)l * D * DIN + 768; p.bf = args.in[I_BF] + l * 4; p.lf = lf;
            if (l > 0) { if (tid == 0) seg_build(p.cntprev, (int*)(lds_raw + LDS_CTL) + LC_SEG); __syncthreads(); }
            { const int ln = opaque(lane); for (int t = gw; t < T; t += NGW) norm_row<0>(p, t, ln, (const int*)(lds_raw + LDS_CTL) + LC_SEG); }
        }
        SEAM(pb + 0);
        if (IN(pb + 1)) {
            pg::GIn g; g.ord.init(T / 256, PW / 256, G, (int)blockIdx.x); g.A = H; g.Bt = wtl + WT_IN; g.PROJ = PROJ; g.qkg = args.in[I_QKG] + l * 6 * 64; g.kmean = kmean + (size_t)l * NB * 16 * 256;
            pg::gemm_phase(lds, g);
        }
        SEAM(pb + 1);
        if (IN(pb + 2)) at::attn_phase(lds, l, PROJ, lf, kmean + (size_t)l * NB * 16 * 256, args.in[I_SINK] + l * 8, OCAT);
        SEAM(pb + 2);
        if (IN(pb + 3)) {
            pg::GBranch g; g.ord.init(T / 256, D / 256, G, (int)blockIdx.x); g.A = OCAT; g.Bt = wtl + WT_BR; g.PROJ = PROJ; g.MERGED = MERGED;
            pg::gemm_phase(lds, g);
        }
        SEAM(pb + 3);
        if (IN(pb + 4)) {
            pg::GOut g; g.ord.init(T / 256, D / 256, G, (int)blockIdx.x); g.A = MERGED; g.Bt = wtl + WT_OUT; g.X = X; g.modl = modl;
            pg::gemm_phase(lds, g);
        }
        SEAM(pb + 4);
        if (IN(pb + 5)) {
            NormP p2{};
            p2.xin = X; p2.X = X; p2.H = H; p2.mod = modl; p2.gain = args.in[I_NGAIN] + (size_t)(l * 2 + 1) * D;
            p2.wr = args.in[I_WR] + (size_t)l * D * NE; p2.br = args.in[I_BR] + l * NE; p2.cnt = cnt + l * NE; p2.toke_o = toke; p2.tokp_o = tokp; p2.list = list; p2.listw = listw;
            { const int ln = opaque(lane); for (int t = gw; t < T; t += NGW) norm_row<1>(p2, t, ln, nullptr); }
        }
        SEAM(pb + 5);
        if (IN(pb + 6)) {
            moe_tables<32, true>(LC, (LAS unsigned short*)(lds + pg::LDS_GTAB), cnt + l * NE, list);
            pg::GMoe1 g; g.LC = LC; g.gtab = (const LAS unsigned short*)(lds + pg::LDS_GTAB); g.A = H; g.Bt = wtl + WT_W1; g.b1 = args.in[I_B1] + (size_t)l * NE * 2048; g.A2 = A2; g.c = (int)blockIdx.x;
            pg::gemm_phase(lds, g);
        }
        SEAM(pb + 6);
        if (IN(pb + 7)) {
            moe_tables<64, false>(LC, nullptr, cnt + l * NE, list);
            pg::GMoe2 g; g.LC = LC; g.A = A2; g.Bt = wtl + WT_W2; g.b2 = args.in[I_B2] + (size_t)l * NE * D; g.listw = listw; g.Y = Y; g.c = (int)blockIdx.x;
            pg::gemm_phase(lds, g);
        }
        SEAM(pb + 7);
    }
    if (IN(33)) {
        NormP p{}; p.xin = X; p.X = X; p.modprev = mod + (size_t)(NL - 1) * NB * 6144; p.Y = Y; p.toke = toke; p.tokp = tokp; p.cntprev = cnt + (NL - 1) * NE;
        if (tid == 0) seg_build(p.cntprev, (int*)(lds_raw + LDS_CTL) + LC_SEG); __syncthreads();
        { const int ln = opaque(lane); for (int t = gw; t < T; t += NGW) norm_row<2>(p, t, ln, (const int*)(lds_raw + LDS_CTL) + LC_SEG); }
    }
#undef IN
#undef SEAM
}

static int g_grid = 0;
static void launch_mega(const float* const* in, float* out, unsigned char* ws, int lo, int hi, int li, hipStream_t stream) {
    MArgs a; memset(&a, 0, sizeof(a));
    for (int i = 0; i < 19; ++i) a.in[i] = in[i];
    a.out = out; a.ws = ws; a.ph_lo = lo; a.ph_hi = hi; a.li = li; a.pad = 0;
    hipLaunchKernelGGL(mega, dim3(g_grid), dim3(NTHR), LDS_BYTES, stream, a);
    const hipError_t le = hipPeekAtLastError();
    if (le != hipSuccess) fprintf(stderr, "kernel_launch: mega launch [%d,%d) failed: %s\n", lo, hi, hipGetErrorName(le));
}
extern "C" void kernel_launch(void* const* d_in, const int* in_sizes, int n_in, void* d_out, int out_size, void* d_ws, size_t ws_size, hipStream_t stream) {
    if (n_in != 19 || out_size != T * D || ws_size < WS_END) { fprintf(stderr, "kernel_launch: unexpected shapes (n_in %d out %d ws %zu need %zu)\n", n_in, out_size, ws_size, (size_t)WS_END); return; }
    if (g_grid == 0) {
        int dev = 0, cus = 0, per_cu = 0;
        if (hipGetDevice(&dev) != hipSuccess || hipDeviceGetAttribute(&cus, hipDeviceAttributeMultiprocessorCount, dev) != hipSuccess) { g_grid = -1; return; }
        if (hipFuncSetAttribute((const void*)mega, hipFuncAttributeMaxDynamicSharedMemorySize, LDS_BYTES) != hipSuccess) { fprintf(stderr, "kernel_launch: hipFuncSetAttribute failed\n"); g_grid = -1; return; }
        if (hipOccupancyMaxActiveBlocksPerMultiprocessor(&per_cu, (const void*)mega, NTHR, LDS_BYTES) != hipSuccess || per_cu < 1) { fprintf(stderr, "kernel_launch: occupancy query says %d\n", per_cu); }
        (void)hipGetLastError();
        g_grid = cus;
    }
    if (g_grid < 0) return;
    const float* const* in = (const float* const*)d_in;
    unsigned char* ws = (unsigned char*)d_ws;
    float* X = (float*)d_out;
    float* mod = (float*)(ws + WS_MOD); float* lf = (float*)(ws + WS_LF); float* cum = (float*)(ws + WS_CUM);
    int* cnt = (int*)(ws + CTL_CNT); float* kmean = (float*)(ws + CTL_KMEAN);
    int* toke = (int*)(ws + WS_TOKE); int* tokp = (int*)(ws + WS_TOKP); int* list = (int*)(ws + WS_LIST); float* listw = (float*)(ws + WS_LISTW);
    bf16_t* H = (bf16_t*)(ws + WS_H); bf16_t* OCAT = (bf16_t*)(ws + WS_OCAT); bf16_t* MERGED = (bf16_t*)(ws + WS_MERGED); bf16_t* PROJ = (bf16_t*)(ws + WS_PROJ);
    bf16_t* A2 = (bf16_t*)(ws + WS_A2); bf16_t* Y = (bf16_t*)(ws + WS_Y);
    float* NV = (float*)(ws + WS_NAIVE);
    (void)mod; (void)toke; (void)tokp; (void)X; (void)cnt; (void)list; (void)listw; (void)H; (void)MERGED; (void)A2; (void)Y; (void)NV; (void)lf; (void)cum; (void)kmean; (void)OCAT; (void)PROJ;
    (void)hipMemsetAsync(ws + WS_CTL, 0, CTL_BYTES, stream);
    launch_mega(in, X, ws, 0, PH_END, 0, stream);
}
```

```cpp
#include <hip/hip_runtime.h>
#include <stdint.h>
#include <stdio.h>
#include <string.h>
#ifndef PROBE_KIND
#define PROBE_KIND -1
#define PROBE_REPS 0
#endif

typedef unsigned short bf16_t;
typedef short bf16x8 __attribute__((ext_vector_type(8)));
typedef float f32x4 __attribute__((ext_vector_type(4)));
typedef float f32x16 __attribute__((ext_vector_type(16)));
typedef unsigned u32x4 __attribute__((ext_vector_type(4)));
typedef unsigned u32x2 __attribute__((ext_vector_type(2)));

constexpr int NB = 8, S = 4096, T = NB * S, D = 1024, NL = 4, DIN = 5380, PW = 5376, NE = 32, CAP = 32768;
constexpr int ROWS_MAX = T * 4 + NE * 256;
constexpr float EPS = 1e-6f;
constexpr float LOG2E = 1.4426950408889634f;
constexpr float C2 = 0.125f * LOG2E;
constexpr int FQ = 0, FK = 256, FV = 512, SQ = 768, SK = 1280, SV = 1408, MQ = 1536, MK = 1792, MV = 2048, GA = 2304, GB = 3328, GC = 4352;
enum { I_X = 0, I_C, I_WADA, I_BADA, I_NGAIN, I_WIN, I_BF, I_QKG, I_SINK, I_WBF, I_WBS, I_WBM, I_WOUT, I_WR, I_BR, I_W1, I_B1, I_W2, I_B2 };

constexpr size_t MiB = 1ull << 20;
constexpr size_t WS_CTL = 0, CTL_BYTES = 2 * MiB;
constexpr size_t CTL_CNT = 512 * 1024;
constexpr size_t CTL_KMEAN = 1 * MiB;
constexpr size_t WS_MOD = 2 * MiB;
constexpr size_t WS_LF = 3 * MiB;
constexpr size_t WS_CUM = 4 * MiB;
constexpr size_t WS_WG = 7 * MiB;
constexpr size_t WS_CB = 7 * MiB + (size_t)NB * D * NE * 4;
constexpr size_t WS_TOKE = 5 * MiB;
constexpr size_t WS_TOKP = 6 * MiB;
constexpr size_t WS_LIST = 8 * MiB;
constexpr size_t WS_LISTW = 12 * MiB;
constexpr size_t WS_H = 16 * MiB;
constexpr size_t WS_OCAT = 80 * MiB;
constexpr size_t WS_MERGED = 144 * MiB;
constexpr size_t WS_PROJ = 208 * MiB;
constexpr size_t WS_A2 = 544 * MiB;
constexpr size_t WS_Y = 816 * MiB;
constexpr size_t WS_NAIVE = 1088 * MiB;
constexpr size_t WS_WT = 2304 * MiB;
constexpr size_t WS_END = WS_WT + 4 * 216 * MiB;

__device__ __forceinline__ unsigned f2bf(float f) { unsigned u = __float_as_uint(f); return (u + 0x7fffu + ((u >> 16) & 1u)) >> 16; }
__device__ __forceinline__ float bf2f(unsigned b) { return __uint_as_float(b << 16); }
__device__ __forceinline__ unsigned pk2(float lo, float hi) { return f2bf(lo) | (f2bf(hi) << 16); }
__device__ __forceinline__ float wave_sum(float v) {
#pragma unroll
    for (int o = 1; o < 64; o <<= 1) v += __shfl_xor(v, o);
    return v;
}
__device__ __forceinline__ float wave_max(float v) {
#pragma unroll
    for (int o = 1; o < 64; o <<= 1) v = fmaxf(v, __shfl_xor(v, o));
    return v;
}
__device__ __forceinline__ float alibi_slope(int i) { return exp2f(-8.0f * (float)(i + 1) / 12.0f); }
__device__ __forceinline__ float sigmoidf_(float x) { return 1.0f / (1.0f + __expf(-x)); }

__device__ __forceinline__ void seg_build(const int* cnt, int* seg) {
    int a = 0;
    for (int e = 0; e < NE; ++e) { seg[e] = a; a += (cnt[e] + 255) & ~255; }
    seg[NE] = a;
}

__global__ void __launch_bounds__(256) k_mod(const float* __restrict__ c, const float* __restrict__ w_ada, const float* __restrict__ b_ada, float* __restrict__ mod) {
    __shared__ float sc[NB * D];
    for (int i = threadIdx.x; i < NB * D; i += 256) { const float v = c[i]; sc[i] = v / (1.0f + __expf(-v)); }
    __syncthreads();
    const int col = blockIdx.x * 256 + threadIdx.x;
    const int l = col / 6144, j = col % 6144;
    const float* w = w_ada + (size_t)l * D * 6144 + j;
    float acc[NB];
#pragma unroll
    for (int b = 0; b < NB; ++b) acc[b] = 0.f;
#pragma unroll 4
    for (int k = 0; k < D; ++k) { const float wv = w[(size_t)k * 6144];
#pragma unroll
        for (int b = 0; b < NB; ++b) acc[b] += sc[b * D + k] * wv; }
    const float bv = b_ada[l * 6144 + j];
#pragma unroll
    for (int b = 0; b < NB; ++b) mod[(size_t)(l * NB + b) * 6144 + j] = acc[b] + bv;
}

struct NormP {
    const float* xin;
    float* X;
    bf16_t* H;
    const float* mod;
    const float* modprev;
    const float* gain;
    const bf16_t* Y; const int* toke; const int* tokp; const int* cntprev;
    const float* wf;
    const float* bf;
    float* lf;
    const float* wr; const float* br;
    int* cnt; int* toke_o; int* tokp_o; int* list; float* listw;
};

template <int MODE>
__device__ __forceinline__ void norm_row(const NormP& p, int t, int lane, const int* seg  ) {
    const int b = t / S, s = t % S;
    f32x4 v[4];
    const f32x4* xr = (const f32x4*)(p.xin + (size_t)t * D) + lane;
#pragma unroll
    for (int j = 0; j < 4; ++j) v[j] = xr[64 * j];
    if (MODE != 1 && p.modprev) {
        f32x4 a[4];
#pragma unroll
        for (int j = 0; j < 4; ++j) a[j] = (f32x4){0.f, 0.f, 0.f, 0.f};
#pragma unroll
        for (int kk = 0; kk < 4; ++kk) {
            const int e = p.toke[t * 4 + kk], pos = p.tokp[t * 4 + kk];
            const u32x2* yr = (const u32x2*)(p.Y + (size_t)(seg[e] + pos) * D) + lane;
#pragma unroll
            for (int j = 0; j < 4; ++j) { const u32x2 w = yr[64 * j];
                a[j][0] += bf2f(w.x & 0xffffu); a[j][1] += bf2f(w.x >> 16); a[j][2] += bf2f(w.y & 0xffffu); a[j][3] += bf2f(w.y >> 16); }
        }
        const f32x4* g2 = (const f32x4*)(p.modprev + (size_t)b * 6144 + 5 * D) + lane;
#pragma unroll
        for (int j = 0; j < 4; ++j) v[j] += g2[64 * j] * a[j];
    }
    if (MODE != 1) {
        f32x4* xo = (f32x4*)(p.X + (size_t)t * D) + lane;
#pragma unroll
        for (int j = 0; j < 4; ++j) xo[64 * j] = v[j];
    }
    if (MODE == 2) return;
    float ss = 0.f;
#pragma unroll
    for (int j = 0; j < 4; ++j) ss += (v[j][0] * v[j][0] + v[j][1] * v[j][1]) + (v[j][2] * v[j][2] + v[j][3] * v[j][3]);
    ss = wave_sum(ss);
    const float r = rsqrtf(ss * (1.0f / D) + EPS);
    const int off = (MODE == 0) ? 0 : 3 * D;
    const f32x4* sh = (const f32x4*)(p.mod + (size_t)b * 6144 + off) + lane;
    const f32x4* sc = (const f32x4*)(p.mod + (size_t)b * 6144 + off + D) + lane;
    const f32x4* gn = (const f32x4*)p.gain + lane;
    u32x2* ho = (u32x2*)(p.H + (size_t)t * D) + lane;
#pragma unroll
    for (int j = 0; j < 4; ++j) {
        const f32x4 g = gn[64 * j], c1 = sc[64 * j], s1 = sh[64 * j];
        v[j] = (v[j] * r) * g * (1.0f + c1) + s1;
        u32x2 w; w.x = pk2(v[j][0], v[j][1]); w.y = pk2(v[j][2], v[j][3]); ho[64 * j] = w;
    }
    if (MODE == 0) {
        float f0 = 0.f, f1 = 0.f, f2 = 0.f, f3 = 0.f;
#pragma unroll
        for (int j = 0; j < 4; ++j)
#pragma unroll
            for (int i = 0; i < 4; ++i) { const int k = 4 * lane + 256 * j + i; const f32x4 w = *(const f32x4*)(p.wf + (size_t)k * DIN);
                f0 += v[j][i] * w[0]; f1 += v[j][i] * w[1]; f2 += v[j][i] * w[2]; f3 += v[j][i] * w[3]; }
        f0 = wave_sum(f0); f1 = wave_sum(f1); f2 = wave_sum(f2); f3 = wave_sum(f3);
        if (lane < 4) { float z = (lane == 0 ? f0 : lane == 1 ? f1 : lane == 2 ? f2 : f3) + p.bf[lane];
            const float ls = fminf(z, 0.f) - log1pf(__expf(-fabsf(z)));
            p.lf[(size_t)(b * 4 + lane) * S + s] = ls; }
    }
    if (MODE == 1) {
        float mine = 0.f;
        for (int e = 0; e < NE; ++e) {
            float a = 0.f;
#pragma unroll
            for (int j = 0; j < 4; ++j)
#pragma unroll
                for (int i = 0; i < 4; ++i) { const int k = 4 * lane + 256 * j + i; a += v[j][i] * p.wr[(size_t)k * NE + e]; }
            a = wave_sum(a);
            if (lane == e) mine = a + p.br[e];
        }
        float val = (lane < NE) ? mine : -INFINITY;
        float tv[4]; int te[4];
#pragma unroll
        for (int kk = 0; kk < 4; ++kk) {
            const float m = wave_max(val);
            const unsigned long long bal = __ballot(val == m);
            const int idx = __ffsll((long long)bal) - 1;
            tv[kk] = m; te[kk] = idx;
            if (lane == idx) val = -INFINITY;
        }
        float w[4], sum = 0.f;
#pragma unroll
        for (int kk = 0; kk < 4; ++kk) { w[kk] = __expf(tv[kk] - tv[0]); sum += w[kk]; }
        const float inv = 1.0f / sum;
        if (lane < 4) {
            const int e = (lane == 0 ? te[0] : lane == 1 ? te[1] : lane == 2 ? te[2] : te[3]);
            const float wk = (lane == 0 ? w[0] : lane == 1 ? w[1] : lane == 2 ? w[2] : w[3]) * inv;
            const int pos = atomicAdd(p.cnt + e, 1);
            p.toke_o[t * 4 + lane] = e; p.tokp_o[t * 4 + lane] = pos;
            p.list[(size_t)e * CAP + pos] = t; p.listw[(size_t)e * CAP + pos] = wk;
        }
    }
}
template <int MODE> __global__ void __launch_bounds__(256) k_norm(NormP p) {
    __shared__ int seg[NE + 1];
    if (MODE != 1 && p.modprev) { if (threadIdx.x == 0) seg_build(p.cntprev, seg); __syncthreads(); }
    const int t = blockIdx.x * 4 + (threadIdx.x >> 6);
    norm_row<MODE>(p, t, threadIdx.x & 63, seg);
}

struct NG { const bf16_t* A; const float* B; float* C; const int* cnt; const int* list; size_t bstride; int lda, ldb, ldc, M, N, K; };
static NG mk_ng(const bf16_t* A, int lda, const float* B, int ldb, float* C, int ldc, int M, int N, int K, const int* cnt, const int* list, size_t bstride) {
    NG g; memset(&g, 0, sizeof(g)); g.A = A; g.B = B; g.C = C; g.cnt = cnt; g.list = list; g.bstride = bstride; g.lda = lda; g.ldb = ldb; g.ldc = ldc; g.M = M; g.N = N; g.K = K; return g; }
template <int MOE  >
__global__ void __launch_bounds__(256) k_gemm_naive(NG g) {
    const int lane = threadIdx.x & 63, w = threadIdx.x >> 6, r32 = lane & 31, hi = lane >> 5;
    const int col0 = (blockIdx.x * 4 + w) * 32, row0 = blockIdx.y * 32;
    if (col0 >= g.N) return;
    const float* Bp = g.B; size_t arow = (size_t)(row0 + r32);
    if (MOE) {
        int e = -1;
        { int a = 0; for (int i = 0; i < NE; ++i) { const int c = g.cnt[i]; const int nx = a + ((c + 255) & ~255); if (row0 >= a && row0 < nx) e = i; a = nx; } }
        if (e < 0) return;
        int a0 = 0; for (int i = 0; i < e; ++i) a0 += (g.cnt[i] + 255) & ~255;
        Bp += (size_t)e * g.bstride;
        if (MOE == 1) { int pos = row0 + r32 - a0; const int c = g.cnt[e]; if (pos > c - 1) pos = c - 1; arow = (size_t)g.list[(size_t)e * CAP + pos]; }
    }
    const bf16_t* Ap = g.A + arow * g.lda + hi * 8;
    const int col = col0 + r32; const bool cok = col < g.N;
    const float* Bc = Bp + (cok ? col : 0) + (size_t)(hi * 8) * g.ldb;
    f32x16 acc = {};
    for (int k0 = 0; k0 < g.K; k0 += 16) {
        const bf16x8 a = *(const bf16x8*)(Ap + k0);
        unsigned bw[4];
#pragma unroll
        for (int i = 0; i < 4; ++i) { const float b0 = Bc[(size_t)(k0 + 2 * i) * g.ldb], b1 = Bc[(size_t)(k0 + 2 * i + 1) * g.ldb]; bw[i] = cok ? pk2(b0, b1) : 0u; }
        bf16x8 bfr; { u32x4 t = {bw[0], bw[1], bw[2], bw[3]}; bfr = __builtin_bit_cast(bf16x8, t); }
        acc = __builtin_amdgcn_mfma_f32_32x32x16_bf16(a, bfr, acc, 0, 0, 0);
    }
    if (cok) {
#pragma unroll
        for (int r = 0; r < 16; ++r) { const int row = row0 + (r & 3) + 8 * (r >> 2) + 4 * hi; g.C[(size_t)row * g.ldc + col] = acc[r]; }
    }
}

__global__ void __launch_bounds__(256) k_post_proj(const float* __restrict__ raw, const float* __restrict__ qkg  , bf16_t* __restrict__ proj) {
    const int gid = blockIdx.x * 256 + threadIdx.x;
    const int t = gid / 84, g = gid % 84, c0 = g * 64;
    const float* src = raw + (size_t)t * DIN + (c0 < 768 ? c0 : c0 + 4);
    bf16_t* dst = proj + (size_t)t * PW + c0;
    int kind, gi = 0;
    if (c0 < 256) { kind = 1; gi = 0; } else if (c0 < 512) { kind = 2; gi = 1; } else if (c0 < 768) kind = 0;
    else if (c0 < 1280) { kind = 1; gi = 2; } else if (c0 < 1408) { kind = 2; gi = 3; } else if (c0 < 1536) kind = 0;
    else if (c0 < 1792) { kind = 1; gi = 4; } else if (c0 < 2048) { kind = 2; gi = 5; } else if (c0 < 2304) kind = 0; else kind = 3;
    float v[64]; float ss = 0.f;
#pragma unroll
    for (int i = 0; i < 64; ++i) { v[i] = src[i]; ss += v[i] * v[i]; }
    if (kind == 1 || kind == 2) { const float r = rsqrtf(ss * (1.0f / 64.0f) + EPS) * (kind == 1 ? C2 : 1.0f);
#pragma unroll
        for (int i = 0; i < 64; ++i) v[i] = v[i] * r * qkg[gi * 64 + i]; }
    if (kind == 3) {
#pragma unroll
        for (int i = 0; i < 64; ++i) v[i] = sigmoidf_(v[i]); }
#pragma unroll
    for (int i = 0; i < 64; i += 2) *(unsigned*)(dst + i) = pk2(v[i], v[i + 1]);
}

__global__ void k_scan_naive(const float* __restrict__ lf, float* __restrict__ cum) {
    const int i = blockIdx.x * blockDim.x + threadIdx.x; if (i >= NB * 4) return;
    float a = 0.f; for (int s = 0; s < S; ++s) { a += lf[(size_t)i * S + s]; cum[(size_t)i * S + s] = a; }
}
__global__ void __launch_bounds__(256) k_kmean_naive(const bf16_t* __restrict__ proj, float* __restrict__ kmean) {
    const int gid = blockIdx.x * 256 + threadIdx.x;
    const int hd = gid % 256, blk = (gid / 256) % 16, b = gid / 4096;
    float a = 0.f; for (int i = 0; i < 256; ++i) a += bf2f(proj[(size_t)(b * S + blk * 256 + i) * PW + MK + hd]);
    kmean[(size_t)(b * 16 + blk) * 256 + hd] = a;
}

template <int VAR  >
__global__ void __launch_bounds__(64) k_attn_naive(const bf16_t* __restrict__ proj, const float* __restrict__ cum, const float* __restrict__ kmean, const float* __restrict__ sinks, bf16_t* __restrict__ ocat) {
    const int t = blockIdx.x * 64 + threadIdx.x, h = blockIdx.y, b = blockIdx.z;
    int qoff, koff, voff, ooff; float slope2 = 0.f;
    if (VAR == 0) { qoff = FQ + h * 64; koff = FK + h * 64; voff = FV + h * 64; ooff = h * 64; }
    else if (VAR == 1) { qoff = SQ + h * 64; koff = SK + (h >> 2) * 64; voff = SV + (h >> 2) * 64; ooff = 256 + h * 64; slope2 = alibi_slope(h) * LOG2E; }
    else { qoff = MQ + h * 64; koff = MK + h * 64; voff = MV + h * 64; ooff = 768 + h * 64; slope2 = alibi_slope(8 + h) * LOG2E; }
    const bf16_t* base = proj + (size_t)b * S * PW;
    float q[64], o[64];
    { const u32x4* qp = (const u32x4*)(base + (size_t)t * PW + qoff);
#pragma unroll
      for (int c = 0; c < 8; ++c) { const u32x4 w = qp[c];
#pragma unroll
          for (int i = 0; i < 4; ++i) { q[8 * c + 2 * i] = bf2f(w[i] & 0xffffu); q[8 * c + 2 * i + 1] = bf2f(w[i] >> 16); } } }
#pragma unroll
    for (int d = 0; d < 64; ++d) o[d] = 0.f;
    float m = -1e30f, l = 0.f;
    const float ct = (VAR == 0) ? cum[(size_t)(b * 4 + h) * S + t] : 0.f;
    auto key = [&](int s) {
        const u32x4* kp = (const u32x4*)(base + (size_t)s * PW + koff);
        float dot = 0.f;
#pragma unroll
        for (int c = 0; c < 8; ++c) { const u32x4 w = kp[c];
#pragma unroll
            for (int i = 0; i < 4; ++i) dot += q[8 * c + 2 * i] * bf2f(w[i] & 0xffffu) + q[8 * c + 2 * i + 1] * bf2f(w[i] >> 16); }
        float lg;
        if (VAR == 0) lg = dot + (ct - cum[(size_t)(b * 4 + h) * S + s]) * LOG2E;
        else lg = dot - slope2 * (float)(t - s);
        if (lg > m) { const float f = exp2f(m - lg); l *= f;
#pragma unroll
            for (int d = 0; d < 64; ++d) o[d] *= f;
            m = lg; }
        const float pr = exp2f(lg - m); l += pr;
        const u32x4* vp = (const u32x4*)(base + (size_t)s * PW + voff);
#pragma unroll
        for (int c = 0; c < 8; ++c) { const u32x4 w = vp[c];
#pragma unroll
            for (int i = 0; i < 4; ++i) { o[8 * c + 2 * i] += pr * bf2f(w[i] & 0xffffu); o[8 * c + 2 * i + 1] += pr * bf2f(w[i] >> 16); } }
    };
    if (VAR == 0) { for (int s = 0; s <= t; ++s) key(s); }
    else if (VAR == 1) { const int s0 = t - 127 > 0 ? t - 127 : 0; for (int s = s0; s <= t; ++s) key(s);
        l += exp2f(sinks[h] * LOG2E - m); }
    else {
        const int own = t >> 8; const int nsel = own < 3 ? own : 3;
        unsigned mask = 0u;
        for (int kk = 0; kk < nsel; ++kk) {
            int bi = 0; float bv = -INFINITY;
            for (int j = 0; j < own; ++j) {
                if ((mask >> j) & 1u) continue;
                const float* km = kmean + (size_t)(b * 16 + j) * 256 + h * 64; float a = 0.f;
#pragma unroll
                for (int d = 0; d < 64; ++d) a += q[d] * km[d];
                if (a > bv) { bv = a; bi = j; }
            }
            mask |= 1u << bi;
        }
        for (int j = 0; j < own; ++j) if ((mask >> j) & 1u) { const int s0 = j * 256; for (int s = s0; s < s0 + 256; ++s) key(s); }
        for (int s = own * 256; s <= t; ++s) key(s);
    }
    const float inv = 1.0f / l;
    bf16_t* op = ocat + (size_t)(b * S + t) * D + ooff;
#pragma unroll
    for (int d = 0; d < 64; d += 2) *(unsigned*)(op + d) = pk2(o[d] * inv, o[d + 1] * inv);
}

__global__ void __launch_bounds__(256) k_merge(const bf16_t* __restrict__ proj, const float* __restrict__ ya, const float* __restrict__ yb, const float* __restrict__ yc, bf16_t* __restrict__ merged) {
    const size_t i = (size_t)blockIdx.x * 256 + threadIdx.x; const size_t t = i / D; const int n = (int)(i % D);
    const bf16_t* pr = proj + t * PW;
    merged[i] = (bf16_t)f2bf(bf2f(pr[GA + n]) * ya[i] + bf2f(pr[GB + n]) * yb[i] + bf2f(pr[GC + n]) * yc[i]);
}
__global__ void __launch_bounds__(256) k_resid1(float* __restrict__ X, const float* __restrict__ raw, const float* __restrict__ mod) {
    const size_t i = (size_t)blockIdx.x * 256 + threadIdx.x; const size_t t = i / D; const int n = (int)(i % D); const int b = (int)(t / S);
    X[i] += mod[(size_t)b * 6144 + 2 * D + n] * raw[i];
}
__device__ __forceinline__ bool row_lookup(const int* cnt, int row, int& e, int& pos) {
    int a = 0; for (int i = 0; i < NE; ++i) { const int c = cnt[i]; const int nx = a + ((c + 255) & ~255); if (row < nx) { e = i; pos = row - a; return pos < c; } a = nx; }
    return false;
}
__global__ void __launch_bounds__(256) k_swiglu(const float* __restrict__ U, const float* __restrict__ b1  , const int* __restrict__ cnt, bf16_t* __restrict__ A2) {
    const size_t i = (size_t)blockIdx.x * 256 + threadIdx.x; const int row = (int)(i / D), j = (int)(i % D);
    int e, pos; if (!row_lookup(cnt, row, e, pos)) return;
    float g = U[(size_t)row * 2048 + 2 * j] + b1[e * 2048 + 2 * j], ln = U[(size_t)row * 2048 + 2 * j + 1] + b1[e * 2048 + 2 * j + 1];
    g = fminf(g, 7.0f); ln = fminf(fmaxf(ln, -7.0f), 7.0f);
    A2[i] = (bf16_t)f2bf(g * sigmoidf_(1.702f * g) * (ln + 1.0f));
}
__global__ void __launch_bounds__(256) k_post_y(const float* __restrict__ yraw, const float* __restrict__ b2  , const int* __restrict__ cnt, const float* __restrict__ listw, bf16_t* __restrict__ Y) {
    const size_t i = (size_t)blockIdx.x * 256 + threadIdx.x; const int row = (int)(i / D), n = (int)(i % D);
    int e, pos; if (!row_lookup(cnt, row, e, pos)) return;
    Y[i] = (bf16_t)f2bf(listw[(size_t)e * CAP + pos] * (yraw[i] + b2[e * D + n]));
}


#define LAS __attribute__((address_space(3)))
#define GAS __attribute__((address_space(1)))
constexpr int NWAVES = 8, NTHR = 512;
constexpr int LDS_BYTES = 163840;
constexpr int LDS_CTL = 131072;
constexpr int LC_BAR = 0, LC_SEG = 16, LC_TPF = 64, LC_CNT = 128;
constexpr int CW_BAR = 1024;
constexpr size_t WT_IN = 0, WT_BR = (size_t)PW * D, WT_OUT = WT_BR + (size_t)D * D, WT_W1 = WT_OUT + (size_t)D * D, WT_W2 = WT_W1 + (size_t)NE * 2048 * D, WT_LAYER = 216ull * MiB / 2;
static_assert(WT_W2 + (size_t)NE * D * D <= WT_LAYER, "weights per layer");

#define XB_TMO      128
#define XB_XCNT(j)  (256  + 64 * (j))
#define XB_XSUB(j)  (1280 + 64 * (j))
#define XB_XGEN(j)  (2304 + 64 * (j))
#define XB_TOP      3328
#define XB_TOPGEN   3392
#define XCD_BAR_WORDS 3456
#define XB_SPIN_CAP (1u << 18)
__device__ __forceinline__ unsigned xb_ld(unsigned* p)              { return __hip_atomic_load(p, __ATOMIC_RELAXED, __HIP_MEMORY_SCOPE_AGENT); }
__device__ __forceinline__ unsigned xb_add(unsigned* p, unsigned v) { return __hip_atomic_fetch_add(p, v, __ATOMIC_RELAXED, __HIP_MEMORY_SCOPE_AGENT); }
__device__ __forceinline__ int xb_lane() { return (int)__builtin_amdgcn_mbcnt_hi(~0u, __builtin_amdgcn_mbcnt_lo(~0u, 0u)); }
__device__ __forceinline__ unsigned xb_xcc_id() { return (unsigned)__builtin_amdgcn_s_getreg((3 << 11) | 20) & 0xFu; }
#define XB_SPIN(cond, bar) do { unsigned _sp = 0; while (cond) { __builtin_amdgcn_s_sleep(1); \
    if ((++_sp & 255u) == 0u) { if (xb_ld(&(bar)[XB_TMO])) break; if (_sp > XB_SPIN_CAP) { atomicAdd(&(bar)[XB_TMO], 1u); break; } } } } while (0)
struct XcdBarrier { unsigned* bar; unsigned x; volatile LAS unsigned* st; int wv; };
__device__ __forceinline__ XcdBarrier xcd_barrier_post(unsigned* bar, volatile LAS unsigned* st, int wv) {
    XcdBarrier b; b.bar = bar; b.x = xb_xcc_id(); b.st = st; b.wv = wv;
    if (wv == 0 && xb_lane() == 0) (void)xb_add(&bar[XB_XCNT(b.x)], 1u);
    return b;
}
__device__ __forceinline__ void xcd_barrier_complete(unsigned* bar, unsigned x, unsigned& nloc, unsigned& nx) {
    const unsigned G = gridDim.x * gridDim.y * gridDim.z;
    unsigned sum, cnt, mine, sp = 0u;
    for (;;) {
        sum = 0u; cnt = 0u; mine = 0u;
#pragma unroll
        for (unsigned j = 0; j < 16; ++j) { const unsigned c = xb_ld(&bar[XB_XCNT(j)]); sum += c; cnt += (c > 0u) ? 1u : 0u; mine = (j == x) ? c : mine; }
        if (sum == G) break;
        __builtin_amdgcn_s_sleep(1);
        if ((++sp & 255u) == 0u) { if (xb_ld(&bar[XB_TMO])) break; if (sp > XB_SPIN_CAP) { atomicAdd(&bar[XB_TMO], 1u); break; } }
    }
    nloc = mine > 0u ? mine : 1u; nx = cnt > 0u ? cnt : 1u;
}
__device__ __forceinline__ void xcd_barrier(const XcdBarrier& b) {
    asm volatile("s_waitcnt vmcnt(0)" ::: "memory");
    __syncthreads();
    if (b.wv == 0 && xb_lane() == 0) {
        unsigned* bar = b.bar; unsigned bx = b.x;
        asm volatile("" : "+s"(bar), "+s"(bx));
        __builtin_amdgcn_s_waitcnt(0);
        unsigned nloc = b.st[0], nx = b.st[1];
        if (nloc == 0u) { xcd_barrier_complete(bar, bx, nloc, nx); b.st[0] = nloc; b.st[1] = nx; }
        const unsigned old = xb_add(&bar[XB_XSUB(bx)], 1u);
        const unsigned gen = old / nloc;
        if (old + 1u == (gen + 1u) * nloc) {
            __builtin_amdgcn_fence(__ATOMIC_RELEASE, "agent");
            asm volatile("s_waitcnt vmcnt(0)" ::: "memory");
            const unsigned og = xb_add(&bar[XB_TOP], 1u);
            const unsigned tg = og / nx;
            if (og + 1u == (tg + 1u) * nx) xb_add(&bar[XB_TOPGEN], 1u);
            else XB_SPIN(xb_ld(&bar[XB_TOPGEN]) == tg, bar);
            __builtin_amdgcn_fence(__ATOMIC_ACQUIRE, "agent");
            xb_add(&bar[XB_XGEN(bx)], 1u);
            asm volatile("s_waitcnt vmcnt(0)" ::: "memory");
        } else {
            XB_SPIN(xb_ld(&bar[XB_XGEN(bx)]) == gen, bar);
            __builtin_amdgcn_fence(__ATOMIC_ACQUIRE, "agent");
            asm volatile("s_waitcnt vmcnt(0)" ::: "memory");
        }
    }
    __syncthreads();
}

__device__ __forceinline__ int lane_id() { return (int)__builtin_amdgcn_mbcnt_hi(~0u, __builtin_amdgcn_mbcnt_lo(~0u, 0u)); }
__device__ __forceinline__ int tid_of(int wv) { return wv * 64 + lane_id(); }
__device__ __forceinline__ int opaque_s(int v) { asm volatile("" : "+s"(v)); return v; }
__device__ __forceinline__ int opaque(int v) { asm volatile("" : "+v"(v)); return v; }
struct MArgs { const float* in[19]; float* out; unsigned char* ws; int ph_lo, ph_hi, li, pad; };
static_assert(sizeof(MArgs) == 19 * 8 + 8 + 8 + 16, "MArgs has no padding");

__device__ __forceinline__ void p0_mod(const float* __restrict__ c, const float* __restrict__ w_ada, const float* __restrict__ b_ada, float* __restrict__ mod, LAS float* lds, int wv) {
    LAS float* sc = lds;
    LAS float* red = lds + NB * D;
    const int lane = lane_id(), w = wv, tid = w * 64 + lane;
    for (int i = tid; i < NB * D; i += NTHR) { const float v = c[i]; sc[i] = v / (1.0f + __expf(-v)); }
    __syncthreads();
    for (int u = blockIdx.x; u < NL * 6144 / 64; u += gridDim.x) {
        const int col = u * 64 + lane, l = col / 6144, j = col % 6144;
        const float* wp = w_ada + (size_t)l * D * 6144 + j;
        float acc[NB];
#pragma unroll
        for (int b = 0; b < NB; ++b) acc[b] = 0.f;
#pragma unroll 8
        for (int k = w * 128; k < w * 128 + 128; ++k) { const float wv = wp[(size_t)k * 6144];
#pragma unroll
            for (int b = 0; b < NB; ++b) acc[b] += sc[b * D + k] * wv; }
#pragma unroll
        for (int b = 0; b < NB; ++b) red[(w * NB + b) * 64 + lane] = acc[b];
        __syncthreads();
        { const int b = w; float a = 0.f;
#pragma unroll
          for (int ww = 0; ww < 8; ++ww) a += red[(ww * NB + b) * 64 + lane];
          mod[(size_t)(l * NB + b) * 6144 + j] = a + b_ada[l * 6144 + j]; }
        __syncthreads();
    }
}
__device__ __forceinline__ int inproj_slot(int n) {
    if (n >= 768 && n < 772) return -1;
    const int c = n < 768 ? n : n - 4; const int pn = c >> 8, cc = c & 255;
    return pn * 256 + ((cc >> 5) & 1) * 128 + (cc >> 6) * 32 + (cc & 31);
}
template <int MAP  >
__device__ __forceinline__ void p0_transpose_item(const float* __restrict__ W, int ldn, int k0, int n0, int nvalid, bf16_t* __restrict__ WT, int kdst0, LAS float* scr, int lane) {
    const int nl = lane & 31;
#pragma unroll 8
    for (int i = 0; i < 32; ++i) { const int kk = 2 * i + (lane >> 5); scr[kk * 33 + nl] = (nl < nvalid) ? W[(size_t)(k0 + kk) * ldn + n0 + nl] : 0.f; }
    asm volatile("s_waitcnt lgkmcnt(0)" ::: "memory");
    const int c = lane & 7;
#pragma unroll
    for (int j = 0; j < 4; ++j) { const int n = (lane >> 3) + 8 * j; const LAS float* s = scr + (8 * c) * 33 + n;
        u32x4 o; o.x = pk2(s[0 * 33], s[1 * 33]); o.y = pk2(s[2 * 33], s[3 * 33]); o.z = pk2(s[4 * 33], s[5 * 33]); o.w = pk2(s[6 * 33], s[7 * 33]);
        int row = n0 + n; bool ok = n < nvalid;
        if (MAP == 1) { row = inproj_slot(ok ? row : 0); ok = ok && row >= 0; }
        if (ok) *(u32x4*)(WT + (size_t)row * D + kdst0 + k0 + 8 * c) = o; }
    asm volatile("s_waitcnt lgkmcnt(0)" ::: "memory");
}
__device__ __forceinline__ void p0_convert(const float* const* in, bf16_t* __restrict__ wt, LAS float* lds, int wv) {
    const int lane = lane_id(), w = wv;
    LAS float* scr = lds + w * (64 * 33 + 16);
    const int gw = blockIdx.x * NWAVES + w, NGW = gridDim.x * NWAVES;
    constexpr int I_IN = 16 * 169, I_BF = 4 * 32, I_BS = 8 * 32, I_BM = 4 * 32, I_O = 16 * 32, I_1 = NE * 16 * 64, I_2 = NE * 16 * 32;
    constexpr int PER_L = I_IN + I_BF + I_BS + I_BM + I_O + I_1 + I_2;
    for (int it = gw; it < NL * PER_L; it += NGW) {
        const int l = it / PER_L; int r = it % PER_L;
        bf16_t* wl = wt + (size_t)l * WT_LAYER;
        if (r < I_IN) { const int kb = r / 169, nb = r % 169; const int nv = (nb == 168) ? 4 : 32;
            p0_transpose_item<1>(in[I_WIN] + (size_t)l * D * DIN, DIN, kb * 64, nb * 32, nv, wl + WT_IN, 0, scr, lane); continue; } r -= I_IN;
        if (r < I_BF) { const int kb = r / 32, nb = r % 32; p0_transpose_item<0>(in[I_WBF] + (size_t)l * 256 * D, D, kb * 64, nb * 32, 32, wl + WT_BR, 0, scr, lane); continue; } r -= I_BF;
        if (r < I_BS) { const int kb = r / 32, nb = r % 32; p0_transpose_item<0>(in[I_WBS] + (size_t)l * 512 * D, D, kb * 64, nb * 32, 32, wl + WT_BR, 256, scr, lane); continue; } r -= I_BS;
        if (r < I_BM) { const int kb = r / 32, nb = r % 32; p0_transpose_item<0>(in[I_WBM] + (size_t)l * 256 * D, D, kb * 64, nb * 32, 32, wl + WT_BR, 768, scr, lane); continue; } r -= I_BM;
        if (r < I_O) { const int kb = r / 32, nb = r % 32; p0_transpose_item<0>(in[I_WOUT] + (size_t)l * D * D, D, kb * 64, nb * 32, 32, wl + WT_OUT, 0, scr, lane); continue; } r -= I_O;
        if (r < I_1) { const int e = r / 1024, q = r % 1024, kb = q / 64, nb = q % 64;
            p0_transpose_item<0>(in[I_W1] + ((size_t)l * NE + e) * D * 2048, 2048, kb * 64, nb * 32, 32, wl + WT_W1 + (size_t)e * 2048 * D, 0, scr, lane); continue; } r -= I_1;
        { const int e = r / 512, q = r % 512, kb = q / 32, nb = q % 32;
            p0_transpose_item<0>(in[I_W2] + ((size_t)l * NE + e) * D * D, D, kb * 64, nb * 32, 32, wl + WT_W2 + (size_t)e * D * D, 0, scr, lane); }
    }
}

namespace pg {
constexpr int BM = 256, BK = 64, HALF = 128, HTB = HALF * BK * 2, STAGE_BYTES = 8 * HTB, KK = 1024, NT = KK / BK;
__device__ __forceinline__ int lds_byte(int r, int c) { const int st = (r >> 4) * 2 + (c >> 5), rr = r & 15, cc = c & 31, ob = rr * 64 + cc * 2; return st * 1024 + (ob ^ (((ob >> 9) & 1) << 5)); }
__device__ __forceinline__ void stage_rc(int b, int& R, int& C) { const int st = b / 1024, sb = b % 1024, swz = sb ^ (((sb >> 9) & 1) << 5); R = (st >> 1) * 16 + swz / 64; C = (st & 1) * 32 + (swz % 64) / 2; }
__device__ __forceinline__ int perm32(int rho) { const int n = rho >> 4, i = rho & 15; return 8 * (i >> 2) + 4 * n + (i & 3); }
struct Unit { int pm, pn, e, rb; };
__device__ __forceinline__ unsigned cvt_pk_bf16(float lo, float hi) { unsigned r; asm volatile("v_cvt_pk_bf16_f32 %0, %1, %2" : "=v"(r) : "v"(lo), "v"(hi)); return r; }
typedef f32x4 Acc[2][2][4][2];
template <class G>
__device__ __forceinline__ void gemm_phase(LAS unsigned char* lds, const G& g, int wv) {
    const int wid = wv, lane = opaque(lane_id()), tid = wid * 64 + lane, wr = wid >> 2, wc = wid & 3, fr = lane & 15, fq = lane >> 4;
    unsigned voffA[2], voffB[2];
    int Rr[2];
#pragma unroll
    for (int i = 0; i < 2; ++i) { int R, C; stage_rc(tid * 16 + i * 8192, R, C); Rr[i] = R; const int Rb = G::PERM ? ((R & ~31) + perm32(R & 31)) : R;
        voffA[i] = G::GATHER ? (unsigned)C * 2u : (unsigned)(R * g.lda() + C) * 2u; voffB[i] = (unsigned)(Rb * KK + C) * 2u; }
    const size_t kstep = (size_t)(BK * 2), hstep = (size_t)HALF * KK * 2;
    const size_t hstepA = G::GATHER ? 0 : (size_t)HALF * g.lda() * 2;
    const unsigned ldsw = (unsigned)wid * 1024u;
    const int aoff = lds_byte(wr * 64 + fr, fq * 8), boff = lds_byte(wc * 32 + fr, fq * 8);
#define PG_SA(b, h) (((b) * 2 + (h)) * HTB)
#define PG_SB(b, h) ((4 + (b) * 2 + (h)) * HTB)
#define PG_STAGE(bufoff, gbase, voff) do { _Pragma("unroll") for (int _i = 0; _i < 2; ++_i) \
        __builtin_amdgcn_global_load_lds((const unsigned*)((const char*)(gbase) + (voff)[_i]), (LAS unsigned*)(lds + (bufoff) + ldsw + _i * 8192), 16, 0, 0); } while (0)
#define PG_STAGE_A(bufoff, ab, h, go) do { if constexpr (G::GATHER) { PG_STAGE(bufoff, ab, (go)[h]); } else { PG_STAGE(bufoff, (ab) + (h) * hstepA, voffA); } } while (0)
#define PG_LDA(dst, b, h) do { _Pragma("unroll") for (int m = 0; m < 4; ++m) _Pragma("unroll") for (int k = 0; k < 2; ++k) dst[m][k] = *(const LAS bf16x8*)(lds + PG_SA(b, h) + aoff + m * 2048 + k * 1024); } while (0)
#define PG_LDB(dst, b, h) do { _Pragma("unroll") for (int n = 0; n < 2; ++n) _Pragma("unroll") for (int k = 0; k < 2; ++k) dst[n][k] = *(const LAS bf16x8*)(lds + PG_SB(b, h) + boff + n * 2048 + k * 1024); } while (0)
#define PG_MMA(ai, bj, At, Bt) do { __builtin_amdgcn_s_setprio(1); _Pragma("unroll") for (int m = 0; m < 4; ++m) _Pragma("unroll") for (int n = 0; n < 2; ++n) _Pragma("unroll") for (int k = 0; k < 2; ++k) \
        acc[ai][bj][m][n] = __builtin_amdgcn_mfma_f32_16x16x32_bf16(Bt[n][k], At[m][k], acc[ai][bj][m][n], 0, 0, 0); __builtin_amdgcn_s_setprio(0); } while (0)
#define PG_WAIT_V(n) asm volatile("s_waitcnt vmcnt(" #n ")" ::: "memory")
#define PG_WAIT_L(n) asm volatile("s_waitcnt lgkmcnt(" #n ")" ::: "memory")
#define PG_BAR __builtin_amdgcn_s_barrier()
#define PG_SCHED __builtin_amdgcn_sched_barrier(0)
    Unit cur, nxt; int ui = 0;
    if (!g.next(0, cur)) return;
    Acc acc;
#pragma unroll
    for (int a = 0; a < 2; ++a)
#pragma unroll
        for (int b = 0; b < 2; ++b)
#pragma unroll
            for (int m = 0; m < 4; ++m)
#pragma unroll
                for (int n = 0; n < 2; ++n) acc[a][b][m][n] = (f32x4){0.f, 0.f, 0.f, 0.f};
    bf16x8 At[4][2], B0[2][2], B1[2][2];
    unsigned goC[2][2];
    if constexpr (G::GATHER) g.gather_offs(0, Rr, voffA, goC);
    const char* cA = g.a_tile(cur); const char* cB = g.b_tile(cur);
    PG_STAGE(PG_SB(0, 0), cB, voffB); PG_STAGE(PG_SB(0, 1), cB + hstep, voffB); PG_STAGE_A(PG_SA(0, 0), cA, 0, goC); PG_STAGE_A(PG_SA(0, 1), cA, 1, goC);
    if (wr == 1) PG_BAR;
    PG_WAIT_V(2); PG_BAR;
    PG_STAGE(PG_SB(1, 0), cB + kstep, voffB); PG_STAGE_A(PG_SA(1, 0), cA + kstep, 0, goC); PG_STAGE(PG_SB(1, 1), cB + hstep + kstep, voffB);
    PG_WAIT_V(6); PG_BAR;
    for (;;) {
        const bool has_next = g.next(ui + 1, nxt);
        const char* nA = has_next ? g.a_tile(nxt) : cA; const char* nB = has_next ? g.b_tile(nxt) : cB;
        for (int t = 0; t < NT; t += 2) {
            const bool last = (t == NT - 2);
            if constexpr (G::MID) { if (t == 4 || t == 12) { g.mid(acc, cur, t, wr, wc, opaque(fr), opaque(fq)); PG_SCHED; } }
            const char* a1 = cA + (size_t)(t + 1) * kstep;
            const char* a2 = last ? nA : cA + (size_t)(t + 2) * kstep; const char* b2 = last ? nB : cB + (size_t)(t + 2) * kstep;
            const char* a3 = a2 + kstep; const char* b3 = b2 + kstep;
            unsigned go2[2][2];
            if constexpr (G::GATHER) {
                if (last && has_next) g.gather_offs(ui + 1, Rr, voffA, go2);
                else {
#pragma unroll
                    for (int h = 0; h < 2; ++h)
#pragma unroll
                        for (int i = 0; i < 2; ++i) go2[h][i] = goC[h][i]; } }
            PG_LDB(B0, 0, 0); PG_LDB(B1, 0, 1); PG_SCHED; PG_LDA(At, 0, 0); PG_STAGE_A(PG_SA(1, 1), a1, 1, goC);
            PG_WAIT_V(8); PG_WAIT_L(0); PG_BAR; PG_MMA(0, 0, At, B0); PG_MMA(0, 1, At, B1); PG_BAR; PG_SCHED;
            PG_LDA(At, 0, 1); PG_STAGE(PG_SB(0, 0), b2, voffB); PG_STAGE(PG_SB(0, 1), b2 + hstep, voffB); PG_STAGE_A(PG_SA(0, 0), a2, 0, go2);
            PG_WAIT_V(8); PG_WAIT_L(0); PG_BAR; PG_MMA(1, 0, At, B0); PG_MMA(1, 1, At, B1); PG_BAR; PG_SCHED;
            PG_LDB(B0, 1, 0); PG_LDB(B1, 1, 1); PG_SCHED; PG_LDA(At, 1, 0); PG_STAGE_A(PG_SA(0, 1), a2, 1, go2);
            PG_WAIT_V(8); PG_WAIT_L(0); PG_BAR; PG_MMA(0, 0, At, B0); PG_MMA(0, 1, At, B1); PG_BAR; PG_SCHED;
            PG_LDA(At, 1, 1); PG_STAGE(PG_SB(1, 0), b3, voffB); PG_STAGE(PG_SB(1, 1), b3 + hstep, voffB); PG_STAGE_A(PG_SA(1, 0), a3, 0, go2);
            PG_WAIT_V(8); PG_WAIT_L(0); PG_BAR; PG_MMA(1, 0, At, B0); PG_MMA(1, 1, At, B1); PG_BAR; PG_SCHED;
        }
        if (wr == 0) PG_BAR;
        if (!g.dry) g.epi(acc, cur, wr, wc, opaque(fr), opaque(fq));
        if (!has_next) break;
#pragma unroll
        for (int a = 0; a < 2; ++a)
#pragma unroll
            for (int b = 0; b < 2; ++b)
#pragma unroll
                for (int m = 0; m < 4; ++m)
#pragma unroll
                    for (int n = 0; n < 2; ++n) acc[a][b][m][n] = (f32x4){0.f, 0.f, 0.f, 0.f};
        cur = nxt; cA = nA; cB = nB; ++ui;
        if constexpr (G::GATHER) g.gather_offs(ui, Rr, voffA, goC);
        if (wr == 1) PG_BAR;
    }
    PG_WAIT_V(0);
    PG_BAR;
#undef PG_SA
#undef PG_SB
#undef PG_STAGE
#undef PG_STAGE_A
#undef PG_LDA
#undef PG_LDB
#undef PG_MMA
#undef PG_WAIT_V
#undef PG_WAIT_L
#undef PG_BAR
#undef PG_SCHED
}

struct TileOrder {
    int nM, nN, nwg, G, c;
    __device__ __forceinline__ void init(int nM_, int nN_, int G_, int c_) { nM = nM_; nN = nN_; nwg = nM * nN; G = G_; c = c_; }
    __device__ __forceinline__ bool next(int i, Unit& u) const {
        const long L = (long)i * G + c; if (L >= nwg) return false;
        int wgid = (int)L; { const int q = nwg / 8, r = nwg % 8, xcd = wgid % 8, off = wgid / 8; wgid = (xcd < r ? xcd * (q + 1) : r * (q + 1) + (xcd - r) * q) + off; }
        const int nig = 8 * nN, gid = wgid / nig, fm = gid * 8, gsz = (nM - fm) < 8 ? (nM - fm) : 8;
        u.pm = fm + ((wgid % nig) % gsz); u.pn = (wgid % nig) / gsz; u.e = 0; u.rb = u.pm * BM; return true;
    }
};
struct GOut {
    static constexpr bool PERM = false, MID = false, GATHER = false;
    TileOrder ord; const bf16_t* A; const bf16_t* Bt; float* X; const float* modl; int dry;
    __device__ __forceinline__ bool next(int i, Unit& u) const { return ord.next(i, u); }
    __device__ __forceinline__ int lda() const { return D; }
    __device__ __forceinline__ void gather_offs(int, const int (&)[2], const unsigned (&)[2], unsigned (&)[2][2]) const {}
    __device__ __forceinline__ const char* a_tile(const Unit& u) const { return (const char*)(A + (size_t)u.pm * BM * D); }
    __device__ __forceinline__ const char* b_tile(const Unit& u) const { return (const char*)(Bt + (size_t)u.pn * BM * KK); }
    __device__ __forceinline__ void mid(Acc&, const Unit&, int, int, int, int, int) const {}
    __device__ __forceinline__ void epi(Acc& acc, const Unit& u, int wr, int wc, int fr, int fq) const {
        const int row0 = u.pm * BM + wr * 64 + fr, col0 = u.pn * BM + wc * 32 + 4 * fq;
        const float* g1 = modl + (size_t)(u.pm >> 4) * 6144 + 2 * D;
        f32x4 gv[2][2];
#pragma unroll
        for (int bj = 0; bj < 2; ++bj)
#pragma unroll
            for (int n = 0; n < 2; ++n) gv[bj][n] = *(const f32x4*)(g1 + col0 + bj * HALF + n * 16);
#pragma unroll
        for (int ai = 0; ai < 2; ++ai)
#pragma unroll
            for (int m = 0; m < 4; ++m) { float* rowp = X + (size_t)(row0 + ai * HALF + m * 16) * D + col0;
#pragma unroll
                for (int bj = 0; bj < 2; ++bj)
#pragma unroll
                    for (int n = 0; n < 2; ++n) { f32x4 x = *(const f32x4*)(rowp + bj * HALF + n * 16); x += gv[bj][n] * acc[ai][bj][m][n]; *(f32x4*)(rowp + bj * HALF + n * 16) = x; }
                asm volatile("" ::: "memory"); }
    }
};

struct GBranch {
    static constexpr bool PERM = true, MID = true, GATHER = false;
    TileOrder ord; const bf16_t* A; const bf16_t* Bt; const bf16_t* PROJ; bf16_t* MERGED; int dry;
    __device__ __forceinline__ bool next(int i, Unit& u) const { return ord.next(i, u); }
    __device__ __forceinline__ int lda() const { return D; }
    __device__ __forceinline__ void gather_offs(int, const int (&)[2], const unsigned (&)[2], unsigned (&)[2][2]) const {}
    __device__ __forceinline__ const char* a_tile(const Unit& u) const { return (const char*)(A + (size_t)u.pm * BM * D); }
    __device__ __forceinline__ const char* b_tile(const Unit& u) const { return (const char*)(Bt + (size_t)u.pn * BM * KK); }
    __device__ __forceinline__ void mid(Acc& acc, const Unit& u, int t, int wr, int wc, int fr, int fq) const {
        const int num = (t == 4) ? GA : GB, den = (t == 4) ? GB : GC;
        const int row0 = u.pm * BM + wr * 64 + fr, col0 = u.pn * BM + wc * 32 + 8 * fq;
#pragma unroll
        for (int ai = 0; ai < 2; ++ai)
#pragma unroll
            for (int m = 0; m < 4; ++m) { const bf16_t* pr = PROJ + (size_t)(row0 + ai * HALF + m * 16) * PW + col0;
#pragma unroll
                for (int bj = 0; bj < 2; ++bj) { const u32x4 gn = *(const u32x4*)(pr + num + bj * HALF), gd = *(const u32x4*)(pr + den + bj * HALF);
#pragma unroll
                    for (int i = 0; i < 4; ++i) {
                        const float r0 = bf2f(gn[i] & 0xffffu) * __builtin_amdgcn_rcpf(fmaxf(bf2f(gd[i] & 0xffffu), 1e-30f));
                        const float r1 = bf2f(gn[i] >> 16) * __builtin_amdgcn_rcpf(fmaxf(bf2f(gd[i] >> 16), 1e-30f));
                        acc[ai][bj][m][i >> 1][(i & 1) * 2] *= r0; acc[ai][bj][m][i >> 1][(i & 1) * 2 + 1] *= r1; } }
                asm volatile("" ::: "memory"); }
    }
    __device__ __forceinline__ void epi(Acc& acc, const Unit& u, int wr, int wc, int fr, int fq) const {
        const int row0 = u.pm * BM + wr * 64 + fr, col0 = u.pn * BM + wc * 32 + 8 * fq;
#pragma unroll
        for (int ai = 0; ai < 2; ++ai)
#pragma unroll
            for (int m = 0; m < 4; ++m) { const size_t row = (size_t)(row0 + ai * HALF + m * 16);
#pragma unroll
                for (int bj = 0; bj < 2; ++bj) { const u32x4 gc = *(const u32x4*)(PROJ + row * PW + GC + col0 + bj * HALF);
                    const f32x4 v0 = acc[ai][bj][m][0], v1 = acc[ai][bj][m][1];
                    u32x4 w; w.x = cvt_pk_bf16(v0[0] * bf2f(gc.x & 0xffffu), v0[1] * bf2f(gc.x >> 16)); w.y = cvt_pk_bf16(v0[2] * bf2f(gc.y & 0xffffu), v0[3] * bf2f(gc.y >> 16));
                    w.z = cvt_pk_bf16(v1[0] * bf2f(gc.z & 0xffffu), v1[1] * bf2f(gc.z >> 16)); w.w = cvt_pk_bf16(v1[2] * bf2f(gc.w & 0xffffu), v1[3] * bf2f(gc.w >> 16));
                    *(u32x4*)(MERGED + row * D + col0 + bj * HALF) = w; }
                asm volatile("" ::: "memory"); }
    }
};

struct GIn {
    static constexpr bool PERM = true, MID = false, GATHER = false;
    TileOrder ord; const bf16_t* A; const bf16_t* Bt; bf16_t* PROJ; const float* qkg; float* kmean; int dry;
    __device__ __forceinline__ bool next(int i, Unit& u) const { return ord.next(i, u); }
    __device__ __forceinline__ int lda() const { return D; }
    __device__ __forceinline__ void gather_offs(int, const int (&)[2], const unsigned (&)[2], unsigned (&)[2][2]) const {}
    __device__ __forceinline__ const char* a_tile(const Unit& u) const { return (const char*)(A + (size_t)u.pm * BM * D); }
    __device__ __forceinline__ const char* b_tile(const Unit& u) const { return (const char*)(Bt + (size_t)u.pn * BM * KK); }
    __device__ __forceinline__ void mid(Acc&, const Unit&, int, int, int, int, int) const {}
    __device__ __forceinline__ void epi(Acc& acc, const Unit& u, int wr, int wc, int fr, int fq) const {
        const int c0 = u.pn * BM + wc * 64;
        int kind, gi = 0;
        if (c0 < 256) { kind = 1; gi = 0; } else if (c0 < 512) { kind = 2; gi = 1; } else if (c0 < 768) kind = 0;
        else if (c0 < 1280) { kind = 1; gi = 2; } else if (c0 < 1408) { kind = 2; gi = 3; } else if (c0 < 1536) kind = 0;
        else if (c0 < 1792) { kind = 1; gi = 4; } else if (c0 < 2048) { kind = 2; gi = 5; } else if (c0 < 2304) kind = 0; else kind = 3;
        const bool mk = (c0 >= MK && c0 < MV);
        const int row0 = u.pm * BM + wr * 64 + fr;
        bf16_t* pbase = PROJ + (size_t)row0 * PW + c0 + 8 * fq;
        if (kind == 1 || kind == 2) {
            f32x4 gq[2][2]; f32x4 ks[2][2];
#pragma unroll
            for (int bj = 0; bj < 2; ++bj)
#pragma unroll
                for (int n = 0; n < 2; ++n) { gq[bj][n] = *(const f32x4*)(qkg + gi * 64 + 32 * bj + 8 * fq + 4 * n); ks[bj][n] = (f32x4){0.f, 0.f, 0.f, 0.f}; }
            const float post = (kind == 1) ? C2 : 1.0f;
#pragma unroll
            for (int ai = 0; ai < 2; ++ai)
#pragma unroll
                for (int m = 0; m < 4; ++m) {
                    float ss = 0.f;
#pragma unroll
                    for (int bj = 0; bj < 2; ++bj)
#pragma unroll
                        for (int n = 0; n < 2; ++n) { const f32x4 x = acc[ai][bj][m][n]; ss += (x[0] * x[0] + x[1] * x[1]) + (x[2] * x[2] + x[3] * x[3]); }
                    ss += __shfl_xor(ss, 16); ss += __shfl_xor(ss, 32);
                    const float r = rsqrtf(ss * (1.0f / 64.0f) + EPS) * post;
                    bf16_t* rowp = pbase + (size_t)(ai * HALF + m * 16) * PW;
#pragma unroll
                    for (int bj = 0; bj < 2; ++bj) { const f32x4 v0 = acc[ai][bj][m][0] * r * gq[bj][0], v1 = acc[ai][bj][m][1] * r * gq[bj][1];
                        u32x4 w; w.x = cvt_pk_bf16(v0[0], v0[1]); w.y = cvt_pk_bf16(v0[2], v0[3]); w.z = cvt_pk_bf16(v1[0], v1[1]); w.w = cvt_pk_bf16(v1[2], v1[3]);
                        *(u32x4*)(rowp + 32 * bj) = w;
                        if (mk) { ks[bj][0][0] += bf2f(w.x & 0xffffu); ks[bj][0][1] += bf2f(w.x >> 16); ks[bj][0][2] += bf2f(w.y & 0xffffu); ks[bj][0][3] += bf2f(w.y >> 16);
                                  ks[bj][1][0] += bf2f(w.z & 0xffffu); ks[bj][1][1] += bf2f(w.z >> 16); ks[bj][1][2] += bf2f(w.w & 0xffffu); ks[bj][1][3] += bf2f(w.w >> 16); } }
                    asm volatile("" ::: "memory");
                }
            if (mk) {
                float* km = kmean + (size_t)u.pm * 256 + wc * 64 + 8 * fq;
#pragma unroll
                for (int bj = 0; bj < 2; ++bj)
#pragma unroll
                    for (int n = 0; n < 2; ++n)
#pragma unroll
                        for (int i = 0; i < 4; ++i) { float v = ks[bj][n][i]; v += __shfl_xor(v, 1); v += __shfl_xor(v, 2); v += __shfl_xor(v, 4); v += __shfl_xor(v, 8);
                            if (fr == 0) atomicAdd(km + 32 * bj + 4 * n + i, v); }
            }
        } else {
#pragma unroll
            for (int ai = 0; ai < 2; ++ai)
#pragma unroll
                for (int m = 0; m < 4; ++m) { bf16_t* rowp = pbase + (size_t)(ai * HALF + m * 16) * PW;
#pragma unroll
                    for (int bj = 0; bj < 2; ++bj) { f32x4 v0 = acc[ai][bj][m][0], v1 = acc[ai][bj][m][1];
                        if (kind == 3) {
#pragma unroll
                            for (int i = 0; i < 4; ++i) { v0[i] = __builtin_amdgcn_rcpf(1.0f + __expf(-v0[i])); v1[i] = __builtin_amdgcn_rcpf(1.0f + __expf(-v1[i])); } }
                        u32x4 w; w.x = cvt_pk_bf16(v0[0], v0[1]); w.y = cvt_pk_bf16(v0[2], v0[3]); w.z = cvt_pk_bf16(v1[0], v1[1]); w.w = cvt_pk_bf16(v1[2], v1[3]);
                        *(u32x4*)(rowp + 32 * bj) = w; }
                    asm volatile("" ::: "memory"); }
        }
    }
};

constexpr int LDS_GTAB = LDS_CTL + 2048, GTAB_UNITS = 24;
__device__ __forceinline__ int moe_find(const volatile LAS unsigned* LC, int mg) { int e = 0;
#pragma unroll 1
    for (int i = 1; i < NE; ++i) e = ((int)LC[LC_TPF + i] <= mg) ? i : e;
    return __builtin_amdgcn_readfirstlane(e); }
struct GMoe1 {
    static constexpr bool PERM = true, MID = false, GATHER = true;
    const volatile LAS unsigned* LC; const LAS unsigned short* gtab; const bf16_t* A; const bf16_t* Bt; const float* b1; bf16_t* A2; int c; int dry;
    __device__ __forceinline__ bool next(int i, Unit& u) const {
        const int x = c & 7, j = c >> 3, mg = 32 * i + 8 * (j >> 3) + x;
        if (mg >= (int)LC[LC_TPF + NE]) return false;
        u.pm = mg; u.pn = j & 7; u.e = moe_find(LC, mg); u.rb = mg * BM; return true; }
    __device__ __forceinline__ int lda() const { return D; }
    __device__ __forceinline__ void gather_offs(int ui, const int (&R)[2], const unsigned (&voffA)[2], unsigned (&go)[2][2]) const {
#pragma unroll
        for (int h = 0; h < 2; ++h)
#pragma unroll
            for (int i = 0; i < 2; ++i) go[h][i] = (unsigned)gtab[ui * 256 + h * HALF + R[i]] * (unsigned)(D * 2) + voffA[i]; }
    __device__ __forceinline__ const char* a_tile(const Unit&) const { return (const char*)A; }
    __device__ __forceinline__ const char* b_tile(const Unit& u) const { return (const char*)(Bt + ((size_t)u.e * 2048 + (size_t)u.pn * BM) * KK); }
    __device__ __forceinline__ void mid(Acc&, const Unit&, int, int, int, int, int) const {}
    __device__ __forceinline__ void epi(Acc& acc, const Unit& u, int wr, int wc, int fr, int fq) const {
        const int row0 = u.rb + wr * 64 + fr, col0 = u.pn * BM + wc * 32 + 8 * fq;
        const float* bp = b1 + (size_t)u.e * 2048 + col0;
#pragma unroll
        for (int bj = 0; bj < 2; ++bj) {
            const f32x4 bv0 = *(const f32x4*)(bp + bj * HALF), bv1 = *(const f32x4*)(bp + bj * HALF + 4);
#pragma unroll
            for (int ai = 0; ai < 2; ++ai)
#pragma unroll
                for (int m = 0; m < 4; ++m) { bf16_t* rowp = A2 + (size_t)(row0 + ai * HALF + m * 16) * D + (col0 >> 1);
                    const f32x4 v0 = acc[ai][bj][m][0] + bv0, v1 = acc[ai][bj][m][1] + bv1;
                    float o[4];
#pragma unroll
                    for (int q = 0; q < 4; ++q) { float gl = (q < 2) ? v0[2 * q] : v1[2 * q - 4], ln = (q < 2) ? v0[2 * q + 1] : v1[2 * q - 3];
                        gl = fminf(gl, 7.0f); ln = fminf(fmaxf(ln, -7.0f), 7.0f);
                        o[q] = gl * __builtin_amdgcn_rcpf(1.0f + __expf(-1.702f * gl)) * (ln + 1.0f); }
                    u32x2 w; w.x = cvt_pk_bf16(o[0], o[1]); w.y = cvt_pk_bf16(o[2], o[3]);
                    *(u32x2*)(rowp + bj * (HALF / 2)) = w;
                    asm volatile("" ::: "memory"); }
        }
    }
};
struct GMoe2 {
    static constexpr bool PERM = true, MID = false, GATHER = false;
    const volatile LAS unsigned* LC; const bf16_t* A; const bf16_t* Bt; const float* b2; const float* listw; bf16_t* Y; int c; int dry;
    __device__ __forceinline__ bool next(int i, Unit& u) const {
        const int x = c & 7, j = c >> 3, mg = 64 * i + 8 * (j >> 2) + x;
        if (mg >= (int)LC[LC_TPF + NE]) return false;
        u.pm = mg; u.pn = j & 3; u.e = moe_find(LC, mg); u.rb = mg * BM; return true; }
    __device__ __forceinline__ int lda() const { return D; }
    __device__ __forceinline__ void gather_offs(int, const int (&)[2], const unsigned (&)[2], unsigned (&)[2][2]) const {}
    __device__ __forceinline__ const char* a_tile(const Unit& u) const { return (const char*)(A + (size_t)u.rb * D); }
    __device__ __forceinline__ const char* b_tile(const Unit& u) const { return (const char*)(Bt + ((size_t)u.e * D + (size_t)u.pn * BM) * KK); }
    __device__ __forceinline__ void mid(Acc&, const Unit&, int, int, int, int, int) const {}
    __device__ __forceinline__ void epi(Acc& acc, const Unit& u, int wr, int wc, int fr, int fq) const {
        const int row0 = u.rb + wr * 64 + fr, col0 = u.pn * BM + wc * 32 + 8 * fq;
        const int p0 = row0 - (int)LC[LC_TPF + u.e] * BM, cn = (int)LC[LC_CNT + u.e];
        const float* bp = b2 + (size_t)u.e * D + col0;
        f32x4 bv[2][2];
#pragma unroll
        for (int bj = 0; bj < 2; ++bj)
#pragma unroll
            for (int n = 0; n < 2; ++n) bv[bj][n] = *(const f32x4*)(bp + bj * HALF + 4 * n);
#pragma unroll
        for (int ai = 0; ai < 2; ++ai)
#pragma unroll
            for (int m = 0; m < 4; ++m) { const int pos = p0 + ai * HALF + m * 16; const float gw = (pos < cn) ? listw[(size_t)u.e * CAP + pos] : 0.f;
                bf16_t* rowp = Y + (size_t)(row0 + ai * HALF + m * 16) * D + col0;
#pragma unroll
                for (int bj = 0; bj < 2; ++bj) { const f32x4 v0 = (acc[ai][bj][m][0] + bv[bj][0]) * gw, v1 = (acc[ai][bj][m][1] + bv[bj][1]) * gw;
                    u32x4 w; w.x = cvt_pk_bf16(v0[0], v0[1]); w.y = cvt_pk_bf16(v0[2], v0[3]); w.z = cvt_pk_bf16(v1[0], v1[1]); w.w = cvt_pk_bf16(v1[2], v1[3]);
                    *(u32x4*)(rowp + bj * HALF) = w; }
                asm volatile("" ::: "memory"); }
    }
};
}

namespace at {
constexpr int L_K = 0, L_V = 16384, L_BIAS = 32768, L_SEL = 49152, L_GATE = 50176, L_RED = 66560;
typedef short v4i16_t __attribute__((ext_vector_type(4)));
__device__ __forceinline__ int crow(int r, int hi) { return (r & 3) + 8 * (r >> 2) + 4 * hi; }
__device__ __forceinline__ float halves_max(float m) { auto rr = __builtin_amdgcn_permlane32_swap(__float_as_uint(m), __float_as_uint(m), false, false); return fmaxf(__uint_as_float(rr[0]), __uint_as_float(rr[1])); }
__device__ __forceinline__ float halves_sum(float m) { auto rr = __builtin_amdgcn_permlane32_swap(__float_as_uint(m), __float_as_uint(m), false, false); return __uint_as_float(rr[0]) + __uint_as_float(rr[1]); }
__device__ __forceinline__ unsigned cvtpk(float lo, float hi) { unsigned r; asm volatile("v_cvt_pk_bf16_f32 %0, %1, %2" : "=v"(r) : "v"(lo), "v"(hi)); return r; }

template <int VAR  >
__device__ __forceinline__ void attn_unit(LAS unsigned char* lds, int b, int h, int qb, const bf16_t* __restrict__ PROJ, const float* __restrict__ lf, const float* __restrict__ kmean, const float* __restrict__ sinks, bf16_t* __restrict__ OCAT, int wv) {
    const int w = wv, lane = opaque(lane_id()), tid = w * 64 + lane, r32 = lane & 31, hi = lane >> 5;
    const int q0 = qb * 256, n_keys = q0 + 256;
    int qoff, koff, voff, ooff; float slope2 = 0.f;
    if (VAR == 0) { qoff = FQ + h * 64; koff = FK + h * 64; voff = FV + h * 64; ooff = h * 64; }
    else if (VAR == 1) { qoff = SQ + h * 64; koff = SK + (h >> 2) * 64; voff = SV + (h >> 2) * 64; ooff = 256 + h * 64; slope2 = alibi_slope(h) * LOG2E; }
    else { qoff = MQ + h * 64; koff = MK + h * 64; voff = MV + h * 64; ooff = 768 + h * 64; slope2 = alibi_slope(8 + h) * LOG2E; }
    const bf16_t* base = PROJ + (size_t)b * S * PW;
    LAS float* biasT = (LAS float*)(lds + L_BIAS);
    LAS float* red = (LAS float*)(lds + L_RED);
    const int t_lo = (VAR == 1) ? (qb > 0 ? 4 * qb - 2 : 0) : 0, t_hi = 4 * qb + 4;
    if (VAR == 0) {
        float c8[8]; const int s0 = 8 * tid;
        if (s0 < n_keys) { const f32x4 a = *(const f32x4*)(lf + (size_t)(b * 4 + h) * S + s0), c = *(const f32x4*)(lf + (size_t)(b * 4 + h) * S + s0 + 4);
            c8[0] = a[0]; c8[1] = c8[0] + a[1]; c8[2] = c8[1] + a[2]; c8[3] = c8[2] + a[3]; c8[4] = c8[3] + c[0]; c8[5] = c8[4] + c[1]; c8[6] = c8[5] + c[2]; c8[7] = c8[6] + c[3]; }
        else {
#pragma unroll
            for (int i = 0; i < 8; ++i) c8[i] = 0.f; }
        float incl = c8[7];
#pragma unroll
        for (int o = 1; o < 64; o <<= 1) { const float v = __shfl_up(incl, o); if (lane >= o) incl += v; }
        if (lane == 63) red[w] = incl;
        __syncthreads();
        float wp = 0.f;
#pragma unroll
        for (int i = 0; i < 8; ++i) wp += (i < w) ? red[i] : 0.f;
        const float offs = wp + incl - c8[7];
#pragma unroll
        for (int i = 0; i < 8; ++i) c8[i] += offs;
        if (s0 == q0) red[15] = c8[0];
        __syncthreads();
        const float cref = red[15];
        if (s0 < n_keys) { *(LAS f32x4*)(biasT + s0) = (f32x4){(cref - c8[0]) * LOG2E, (cref - c8[1]) * LOG2E, (cref - c8[2]) * LOG2E, (cref - c8[3]) * LOG2E};
                           *(LAS f32x4*)(biasT + s0 + 4) = (f32x4){(cref - c8[4]) * LOG2E, (cref - c8[5]) * LOG2E, (cref - c8[6]) * LOG2E, (cref - c8[7]) * LOG2E}; }
    } else {
        for (int s = 64 * t_lo + tid; s < n_keys; s += NTHR) biasT[s] = slope2 * (float)(s - q0);
    }
    unsigned selmask = 0u;
    if (VAR == 2 && qb > 0) {
        LAS float* gate = (LAS float*)(lds + L_GATE);
        { const int q = tid & 255, half = tid >> 8;
          float qf[64];
          const u32x4* qp = (const u32x4*)(base + (size_t)(q0 + q) * PW + qoff);
#pragma unroll
          for (int c = 0; c < 8; ++c) { const u32x4 x = qp[c];
#pragma unroll
              for (int i = 0; i < 4; ++i) { qf[8 * c + 2 * i] = bf2f(x[i] & 0xffffu); qf[8 * c + 2 * i + 1] = bf2f(x[i] >> 16); } }
          for (int j = half; j < qb; j += 2) { const float* km = kmean + (size_t)(b * 16 + j) * 256 + h * 64; float a = 0.f;
#pragma unroll
              for (int d = 0; d < 64; ++d) a += qf[d] * km[d];
              gate[q * 16 + j] = a; } }
        __syncthreads();
        if (tid < 256) { const int nsel = qb < 3 ? qb : 3; unsigned mask = 0u;
            for (int kk = 0; kk < nsel; ++kk) { int bi = 0; float bv = -INFINITY;
                for (int j = 0; j < qb; ++j) { const float a = gate[tid * 16 + j]; if (!((mask >> j) & 1u) && a > bv) { bv = a; bi = j; } }
                mask |= 1u << bi; }
            ((LAS unsigned*)(lds + L_SEL))[tid] = mask; }
        __syncthreads();
        selmask = ((LAS unsigned*)(lds + L_SEL))[32 * w + r32];
    }
    const int qa = q0 + 32 * w + r32;
    bf16x8 qr[4];
#pragma unroll
    for (int d0 = 0; d0 < 4; ++d0) qr[d0] = *(const bf16x8*)(base + (size_t)qa * PW + qoff + 16 * d0 + 8 * hi);
    const bf16_t* kg = base + (size_t)lane * PW + koff + w * 8;
    const bf16_t* vg = base + (size_t)(16 * (w & 3) + (lane >> 2)) * PW + voff + (w >> 2) * 32 + (lane & 3) * 8;
    const int kdst = L_K + w * 1024 + lane * 16, vdst = L_V + (w >> 2) * 4096 + (16 * (w & 3) + (lane >> 2)) * 64 + (lane & 3) * 16;
    const int kfr = L_K + hi * 1024 + r32 * 16;
    const int vfr = L_V + ((lane >> 4) & 1) * 32 + (lane & 3) * 8 + (4 * hi + ((lane & 15) >> 2)) * 64;
    u32x4 kreg = *(const u32x4*)(kg + (size_t)(64 * t_lo) * PW), vreg = *(const u32x4*)(vg + (size_t)(64 * t_lo) * PW);
    *(LAS u32x4*)(lds + kdst) = kreg; *(LAS u32x4*)(lds + vdst) = vreg;
    __syncthreads();
    f32x16 o0 = {}, o1 = {};
    float m = -1e30f, l = 0.f;
    const int qlo = q0 + 32 * w, qhi = qlo + 31;
    for (int jt = t_lo; jt < t_hi; ++jt) {
        const int slot = ((jt - t_lo) & 1) * 8192, kv0 = 64 * jt;
        const bool more = jt + 1 < t_hi;
        if (more) { kreg = *(const u32x4*)(kg + (size_t)(kv0 + 64) * PW); vreg = *(const u32x4*)(vg + (size_t)(kv0 + 64) * PW); }
        int mode; bool sel = true;
        if (VAR == 0) mode = (kv0 > qhi) ? 0 : (kv0 + 63 <= qlo ? 1 : 2);
        else if (VAR == 1) mode = (kv0 > qhi || kv0 + 63 < qlo - 127) ? 0 : ((kv0 + 63 <= qlo && kv0 >= qhi - 127) ? 1 : 2);
        else { const int jb = kv0 >> 8;
            if (jb < qb) { sel = (selmask >> jb) & 1u; const unsigned long long bal = __ballot(sel); mode = (bal == 0ull) ? 0 : (bal == ~0ull ? 1 : 2); }
            else mode = (kv0 > qhi) ? 0 : (kv0 + 63 <= qlo ? 1 : 2); }
        if (mode != 0) {
            f32x16 p0, p1;
#pragma unroll
            for (int g = 0; g < 4; ++g) { const f32x4 x0 = *(const LAS f32x4*)(biasT + kv0 + 8 * g + 4 * hi), x1 = *(const LAS f32x4*)(biasT + kv0 + 32 + 8 * g + 4 * hi);
#pragma unroll
                for (int i = 0; i < 4; ++i) { p0[4 * g + i] = x0[i]; p1[4 * g + i] = x1[i]; } }
#pragma unroll
            for (int d0 = 0; d0 < 4; ++d0) {
                const bf16x8 k0 = *(const LAS bf16x8*)(lds + slot + kfr + d0 * 2048), k1 = *(const LAS bf16x8*)(lds + slot + kfr + d0 * 2048 + 512);
                p0 = __builtin_amdgcn_mfma_f32_32x32x16_bf16(k0, qr[d0], p0, 0, 0, 0);
                p1 = __builtin_amdgcn_mfma_f32_32x32x16_bf16(k1, qr[d0], p1, 0, 0, 0); }
            if (mode == 2) {
                if (VAR == 2 && (kv0 >> 8) < qb) {
                    if (!sel) {
#pragma unroll
                        for (int r = 0; r < 16; ++r) { p0[r] = -INFINITY; p1[r] = -INFINITY; } }
                } else {
#pragma unroll
                    for (int r = 0; r < 16; ++r) { const int kv = kv0 + crow(r, hi);
                        bool bad0 = kv > qa, bad1 = kv + 32 > qa;
                        if (VAR == 1) { bad0 = bad0 || kv < qa - 127; bad1 = bad1 || kv + 32 < qa - 127; }
                        p0[r] = bad0 ? -INFINITY : p0[r]; p1[r] = bad1 ? -INFINITY : p1[r]; }
                }
            }
            float mx = fmaxf(p0[0], p1[0]);
#pragma unroll
            for (int r = 1; r < 16; ++r) mx = fmaxf(mx, fmaxf(p0[r], p1[r]));
            mx = halves_max(mx);
            const float mn = fmaxf(m, mx), alpha = __builtin_amdgcn_exp2f(m - mn);
            m = mn;
            float rs = 0.f;
#pragma unroll
            for (int r = 0; r < 16; ++r) { p0[r] = __builtin_amdgcn_exp2f(p0[r] - mn); p1[r] = __builtin_amdgcn_exp2f(p1[r] - mn); rs += p0[r] + p1[r]; }
            l = l * alpha + rs;
            if (__any(alpha != 1.0f)) {
#pragma unroll
                for (int r = 0; r < 16; ++r) { o0[r] *= alpha; o1[r] *= alpha; } }
            u32x4 pw[4];
#pragma unroll
            for (int i = 0; i < 4; ++i) { pw[0][i] = cvtpk(p0[2 * i], p0[2 * i + 1]); pw[1][i] = cvtpk(p0[8 + 2 * i], p0[8 + 2 * i + 1]); pw[2][i] = cvtpk(p1[2 * i], p1[2 * i + 1]); pw[3][i] = cvtpk(p1[8 + 2 * i], p1[8 + 2 * i + 1]); }
#pragma unroll
            for (int ks = 0; ks < 4; ++ks) {
                const bf16x8 pb = __builtin_bit_cast(bf16x8, pw[ks]);
                const v4i16_t a0 = __builtin_amdgcn_ds_read_tr16_b64_v4i16((LAS v4i16_t*)(lds + slot + vfr + ks * 1024)), a1 = __builtin_amdgcn_ds_read_tr16_b64_v4i16((LAS v4i16_t*)(lds + slot + vfr + ks * 1024 + 512));
                const v4i16_t c0 = __builtin_amdgcn_ds_read_tr16_b64_v4i16((LAS v4i16_t*)(lds + slot + vfr + 4096 + ks * 1024)), c1 = __builtin_amdgcn_ds_read_tr16_b64_v4i16((LAS v4i16_t*)(lds + slot + vfr + 4096 + ks * 1024 + 512));
                const bf16x8 v0 = (bf16x8){a0[0], a0[1], a0[2], a0[3], a1[0], a1[1], a1[2], a1[3]}, v1 = (bf16x8){c0[0], c0[1], c0[2], c0[3], c1[0], c1[1], c1[2], c1[3]};
                o0 = __builtin_amdgcn_mfma_f32_32x32x16_bf16(v0, pb, o0, 0, 0, 0);
                o1 = __builtin_amdgcn_mfma_f32_32x32x16_bf16(v1, pb, o1, 0, 0, 0); }
        }
        if (more) { *(LAS u32x4*)(lds + (slot ^ 8192) + kdst) = kreg; *(LAS u32x4*)(lds + (slot ^ 8192) + vdst) = vreg; }
        __syncthreads();
    }
    float lt = halves_sum(l);
    if (VAR == 1) lt += __builtin_amdgcn_exp2f(sinks[h] * LOG2E - (m - slope2 * (float)(qa - q0)));
    const float inv = 1.0f / lt;
    bf16_t* op = OCAT + (size_t)(b * S + qa) * D + ooff + 4 * hi;
#pragma unroll
    for (int g = 0; g < 4; ++g) {
        u32x2 w0; w0.x = cvtpk(o0[4 * g] * inv, o0[4 * g + 1] * inv); w0.y = cvtpk(o0[4 * g + 2] * inv, o0[4 * g + 3] * inv); *(u32x2*)(op + 8 * g) = w0;
        u32x2 w1; w1.x = cvtpk(o1[4 * g] * inv, o1[4 * g + 1] * inv); w1.y = cvtpk(o1[4 * g + 2] * inv, o1[4 * g + 3] * inv); *(u32x2*)(op + 32 + 8 * g) = w1; }
}

__device__ __forceinline__ void attn_phase(LAS unsigned char* lds, int l, const bf16_t* PROJ, const float* lf, const float* kmean_l, const float* sinks_l, bf16_t* OCAT, int wv) {
    const int G = gridDim.x, bx = blockIdx.x;
    const int vcu = (G % 8 == 0) ? (bx % 8) * (G / 8) + bx / 8 : bx;
    for (int p = vcu; p < 256; p += G) { const int bh = p >> 3, s = p & 7;
        attn_unit<0>(lds, bh >> 2, bh & 3, 15 - s, PROJ, lf, nullptr, nullptr, OCAT, wv);
        attn_unit<0>(lds, bh >> 2, bh & 3, s, PROJ, lf, nullptr, nullptr, OCAT, wv); }
    for (int p = vcu; p < 256; p += G) { const int bh = p >> 3, s = p & 7;
        attn_unit<2>(lds, bh >> 2, bh & 3, 15 - s, PROJ, nullptr, kmean_l, nullptr, OCAT, wv);
        attn_unit<2>(lds, bh >> 2, bh & 3, s, PROJ, nullptr, kmean_l, nullptr, OCAT, wv); }
    for (int p = vcu; p < 256; p += G)
        for (int i = 0; i < 4; ++i) { const int idx = 4 * p + i; attn_unit<1>(lds, idx >> 7, (idx >> 4) & 7, idx & 15, PROJ, nullptr, nullptr, sinks_l, OCAT, wv); }
    (void)l;
}
}

__device__ __forceinline__ void router_prep(const float* __restrict__ modl, const float* __restrict__ gain2, const float* __restrict__ wr, const float* __restrict__ br, float* __restrict__ Wg, float* __restrict__ cb, int wv) {
    const int w = wv, lane = opaque(lane_id()), tid = w * 64 + lane;
    const int gt = blockIdx.x * NTHR + tid, NGT = gridDim.x * NTHR;
    for (int i = gt; i < NB * D * NE; i += NGT) { const int e = i & 31, k = (i >> 5) & 1023, b = i >> 15;
        Wg[i] = gain2[k] * (1.0f + modl[(size_t)b * 6144 + 4 * D + k]) * wr[k * NE + e]; }
    const int gw = blockIdx.x * NWAVES + w, NGW = gridDim.x * NWAVES;
    for (int i = gw; i < NB * NE; i += NGW) { const int e = i & 31, b = i >> 5; float a = 0.f;
        for (int k = lane; k < D; k += 64) a += modl[(size_t)b * 6144 + 3 * D + k] * wr[k * NE + e];
        a = wave_sum(a); if (lane == 0) cb[i] = a + br[e]; }
}
constexpr int RF_BUF = 0, RF_LG = 16384, RF_RS = 36864, RF_SS = 37376, RF_HIST = 37888, RF_BASE = 38016;
__device__ __forceinline__ void norm2_router(LAS unsigned char* lds, int vb, const float* __restrict__ X, bf16_t* __restrict__ H, const float* __restrict__ modl, const float* __restrict__ gain2,
                                             const float* __restrict__ Wg, const float* __restrict__ cb, int* __restrict__ cnt, int* __restrict__ toke, int* __restrict__ tokp, int* __restrict__ list, float* __restrict__ listw, int wv) {
    const int w = wv, lane = opaque(lane_id()), tid = w * 64 + lane, r32 = lane & 31, hi = lane >> 5;
    const int tile = w & 3, kh = w >> 2, t0 = 128 * vb + 32 * tile, b = (128 * vb) / S;
    LAS float* buf = (LAS float*)(lds + RF_BUF); LAS float* LG = (LAS float*)(lds + RF_LG); LAS float* RS = (LAS float*)(lds + RF_RS); LAS float* SS = (LAS float*)(lds + RF_SS);
    LAS int* hist = (LAS int*)(lds + RF_HIST); LAS int* basep = (LAS int*)(lds + RF_BASE);
    if (tid < 32) hist[tid] = 0;
    f32x16 acc = {}; float ss = 0.f;
    { const float* xrow = X + (size_t)(t0 + r32) * D + kh * 512 + 4 * hi;
      const float* wg = Wg + (size_t)b * D * NE + (size_t)(kh * 512 + 4 * hi) * NE + r32;
#pragma unroll 4
      for (int j = 0; j < 64; ++j) {
          const f32x4 a = *(const f32x4*)(xrow + 8 * j);
          const float b0 = wg[(8 * j + 0) * NE], b1 = wg[(8 * j + 1) * NE], b2 = wg[(8 * j + 2) * NE], b3 = wg[(8 * j + 3) * NE];
          ss += (a[0] * a[0] + a[1] * a[1]) + (a[2] * a[2] + a[3] * a[3]);
          acc = __builtin_amdgcn_mfma_f32_32x32x2f32(a[0], b0, acc, 0, 0, 0);
          acc = __builtin_amdgcn_mfma_f32_32x32x2f32(a[1], b1, acc, 0, 0, 0);
          acc = __builtin_amdgcn_mfma_f32_32x32x2f32(a[2], b2, acc, 0, 0, 0);
          acc = __builtin_amdgcn_mfma_f32_32x32x2f32(a[3], b3, acc, 0, 0, 0); } }
    ss = at::halves_sum(ss);
    if (kh == 1) {
#pragma unroll
        for (int r = 0; r < 16; ++r) buf[(tile * 16 + r) * 64 + lane] = acc[r];
        if (hi == 0) SS[tile * 32 + r32] = ss; }
    __syncthreads();
    int se[4] = {0, 0, 0, 0}, sr[4] = {0, 0, 0, 0}; float sw[4] = {0.f, 0.f, 0.f, 0.f};
    if (kh == 0) {
#pragma unroll
        for (int r = 0; r < 16; ++r) acc[r] += buf[(tile * 16 + r) * 64 + lane];
        ss += SS[tile * 32 + r32];
        const float rstd = rsqrtf(ss * (1.0f / D) + EPS);
        if (hi == 0) RS[tile * 32 + r32] = rstd;
        asm volatile("s_waitcnt lgkmcnt(0)" ::: "memory");
        const float cbe = cb[b * NE + r32];
#pragma unroll
        for (int r = 0; r < 16; ++r) { const int tk = at::crow(r, hi); LG[(tile * 32 + tk) * 33 + r32] = RS[tile * 32 + tk] * acc[r] + cbe; }
        asm volatile("s_waitcnt lgkmcnt(0)" ::: "memory");
        if (lane < 32) {
            float lg[32];
#pragma unroll
            for (int e = 0; e < 32; ++e) lg[e] = LG[(tile * 32 + lane) * 33 + e];
            float tv[4];
#pragma unroll
            for (int kk = 0; kk < 4; ++kk) { float bv = -INFINITY; int bi = 0;
#pragma unroll
                for (int e = 0; e < 32; ++e) { const bool tk = lg[e] > bv; bv = tk ? lg[e] : bv; bi = tk ? e : bi; }
                tv[kk] = bv; se[kk] = bi;
#pragma unroll
                for (int e = 0; e < 32; ++e) lg[e] = (e == bi) ? -INFINITY : lg[e]; }
            float sum = 0.f;
#pragma unroll
            for (int kk = 0; kk < 4; ++kk) { sw[kk] = __expf(tv[kk] - tv[0]); sum += sw[kk]; }
            const float inv = 1.0f / sum;
#pragma unroll
            for (int kk = 0; kk < 4; ++kk) { sw[kk] *= inv; sr[kk] = atomicAdd((int*)(hist + se[kk]), 1); }
        }
    }
    __syncthreads();
    if (tid < 32) basep[tid] = atomicAdd(cnt + tid, hist[tid]);
    __syncthreads();
    if (kh == 0 && lane < 32) { const int t = t0 + lane;
#pragma unroll
        for (int kk = 0; kk < 4; ++kk) { const int e = se[kk], pos = basep[e] + sr[kk];
            toke[t * 4 + kk] = e; tokp[t * 4 + kk] = pos; list[(size_t)e * CAP + pos] = t; listw[(size_t)e * CAP + pos] = sw[kk]; } }
    { f32x4 gm[4], shv[4];
#pragma unroll
      for (int j = 0; j < 4; ++j) { const f32x4 g = *((const f32x4*)gain2 + lane + 64 * j), c1 = *((const f32x4*)(modl + (size_t)b * 6144 + 4 * D) + lane + 64 * j);
          gm[j] = g * (1.0f + c1); shv[j] = *((const f32x4*)(modl + (size_t)b * 6144 + 3 * D) + lane + 64 * j); }
      for (int i = 0; i < 16; ++i) { const int rr = 16 * w + i, t = 128 * vb + rr; const float rs = RS[rr];
          const f32x4* xr = (const f32x4*)(X + (size_t)t * D) + lane; u32x2* ho = (u32x2*)(H + (size_t)t * D) + lane;
#pragma unroll
          for (int j = 0; j < 4; ++j) { const f32x4 v = (xr[64 * j] * rs) * gm[j] + shv[j]; u32x2 o; o.x = pk2(v[0], v[1]); o.y = pk2(v[2], v[3]); ho[64 * j] = o; } } }
    __syncthreads();
}

template <int MPR  , bool GATHER>
__device__ __forceinline__ void moe_tables(volatile LAS unsigned* LC, LAS unsigned short* gtab, const int* cnt, const int* list, int wv) {
    const int tid = tid_of(wv);
    if (tid == 0) { int a = 0; for (int e = 0; e < NE; ++e) { const int cv = cnt[e]; LC[LC_CNT + e] = (unsigned)cv; LC[LC_TPF + e] = (unsigned)a; a += (cv + 255) >> 8; } LC[LC_TPF + NE] = (unsigned)a; }
    __syncthreads();
    if (GATHER) {
        const int c = blockIdx.x, x = c & 7, j = c >> 3, total = (int)LC[LC_TPF + NE];
        for (int i = 0; i < pg::GTAB_UNITS; ++i) { const int mg = MPR * i + 8 * (j >> 3) + x; if (mg >= total) break;
            const int e = pg::moe_find(LC, mg);
            if (tid < 256) { int pos = (mg - (int)LC[LC_TPF + e]) * 256 + tid; const int cn = (int)LC[LC_CNT + e]; pos = pos < cn ? pos : cn - 1; gtab[i * 256 + tid] = (unsigned short)list[(size_t)e * CAP + pos]; } }
        __syncthreads();
    }
}

constexpr int PH_END = 34;
typedef const __attribute__((address_space(4))) MArgs* KArgs;
__device__ __forceinline__ KArgs kargs() { auto p = __builtin_amdgcn_kernarg_segment_ptr(); asm volatile("" : "+s"(p)); return (KArgs)p; }
__global__ void __launch_bounds__(NTHR, 2) mega(MArgs args_unused) {
    extern __shared__ __attribute__((aligned(16))) unsigned char lds_raw[];
    LAS unsigned char* lds = (LAS unsigned char*)lds_raw;
    volatile LAS unsigned* LC = (volatile LAS unsigned*)(lds + LDS_CTL);
    const int wv = __builtin_amdgcn_readfirstlane((int)threadIdx.x >> 6);
#define TID() opaque(tid_of(wv))
#define GW() ((int)blockIdx.x * NWAVES + wv)
    for (int u = TID(); u < (LDS_BYTES - LDS_CTL) / 4; u += NTHR) LC[u] = 0u;
    __syncthreads();
    XcdBarrier bar;
    { KArgs ka = kargs(); bar = xcd_barrier_post((unsigned*)ka->ws + CW_BAR + ka->li * XCD_BAR_WORDS, LC + LC_BAR, wv); }
#define SEAM() xcd_barrier(bar)
    {
        KArgs ka = kargs(); unsigned char* ws = ka->ws;
        const float* inl[19];
#pragma unroll
        for (int i = 0; i < 19; ++i) inl[i] = ka->in[i];
        for (int rep = 0; rep < 1 + (PROBE_KIND == 8 ? PROBE_REPS : 0); ++rep) { p0_mod(inl[I_C], inl[I_WADA], inl[I_BADA], (float*)(ws + WS_MOD), (LAS float*)lds, wv); p0_convert(inl, (bf16_t*)(ws + WS_WT), (LAS float*)lds, wv); __syncthreads(); }
    }
    SEAM();
#pragma unroll 1
    for (int l = 0; l < NL; ++l) {
        {
            const int lq = opaque_s(l); KArgs ka = kargs(); unsigned char* ws = ka->ws; const int G = gridDim.x;
            const float* modl = (const float*)(ws + WS_MOD) + (size_t)lq * NB * 6144; float* X = ka->out; int* cnt = (int*)(ws + CTL_CNT);
            NormP p{};
            p.xin = (lq == 0) ? ka->in[I_X] : X; p.X = X; p.H = (bf16_t*)(ws + WS_H); p.mod = modl; p.modprev = (lq == 0) ? nullptr : modl - (size_t)NB * 6144;
            p.gain = ka->in[I_NGAIN] + (size_t)(lq * 2 + 0) * D; p.Y = (const bf16_t*)(ws + WS_Y); p.toke = (const int*)(ws + WS_TOKE); p.tokp = (const int*)(ws + WS_TOKP); p.cntprev = cnt + (lq > 0 ? (lq - 1) * NE : 0);
            p.wf = ka->in[I_WIN] + (size_t)lq * D * DIN + 768; p.bf = ka->in[I_BF] + lq * 4; p.lf = (float*)(ws + WS_LF);
            if (lq > 0) { if (TID() == 0) seg_build(p.cntprev, (int*)(lds_raw + LDS_CTL) + LC_SEG); __syncthreads(); }
            { const int ln = TID() & 63, NGW = G * NWAVES; for (int t = GW(); t < T; t += NGW) norm_row<0>(p, t, ln, (const int*)(lds_raw + LDS_CTL) + LC_SEG); }
            router_prep(modl, ka->in[I_NGAIN] + (size_t)(lq * 2 + 1) * D, ka->in[I_WR] + (size_t)lq * D * NE, ka->in[I_BR] + lq * NE, (float*)(ws + WS_WG), (float*)(ws + WS_CB), wv);
        }
        SEAM();
        {
            const int lq = opaque_s(l); KArgs ka = kargs(); unsigned char* ws = ka->ws;
            pg::GIn g; g.ord.init(T / 256, PW / 256, (int)gridDim.x, (int)blockIdx.x); g.A = (const bf16_t*)(ws + WS_H); g.Bt = (const bf16_t*)(ws + WS_WT) + (size_t)lq * WT_LAYER + WT_IN; g.PROJ = (bf16_t*)(ws + WS_PROJ);
            g.qkg = ka->in[I_QKG] + lq * 6 * 64; g.kmean = (float*)(ws + CTL_KMEAN) + (size_t)lq * NB * 16 * 256;
            for (int rep = 0; rep < 1 + (PROBE_KIND == 1 ? PROBE_REPS : 0); ++rep) { g.dry = rep; pg::gemm_phase(lds, g, wv); }
        }
        SEAM();
        {
            const int lq = opaque_s(l); KArgs ka = kargs(); unsigned char* ws = ka->ws;
            at::attn_phase(lds, lq, (const bf16_t*)(ws + WS_PROJ), (const float*)(ws + WS_LF), (const float*)(ws + CTL_KMEAN) + (size_t)lq * NB * 16 * 256, ka->in[I_SINK] + lq * 8, (bf16_t*)(ws + WS_OCAT), wv);
            if (PROBE_KIND == 2 && PROBE_REPS > 0) at::attn_phase(lds, lq, (const bf16_t*)(ws + WS_PROJ), (const float*)(ws + WS_LF), (const float*)(ws + CTL_KMEAN) + (size_t)lq * NB * 16 * 256, ka->in[I_SINK] + lq * 8, (bf16_t*)(ws + WS_OCAT), wv);
        }
        SEAM();
        {
            const int lq = opaque_s(l); KArgs ka = kargs(); unsigned char* ws = ka->ws;
            pg::GBranch g; g.ord.init(T / 256, D / 256, (int)gridDim.x, (int)blockIdx.x); g.A = (const bf16_t*)(ws + WS_OCAT); g.Bt = (const bf16_t*)(ws + WS_WT) + (size_t)lq * WT_LAYER + WT_BR; g.PROJ = (const bf16_t*)(ws + WS_PROJ); g.MERGED = (bf16_t*)(ws + WS_MERGED);
            for (int rep = 0; rep < 1 + (PROBE_KIND == 3 ? PROBE_REPS : 0); ++rep) { g.dry = rep; pg::gemm_phase(lds, g, wv); }
        }
        SEAM();
        {
            const int lq = opaque_s(l); KArgs ka = kargs(); unsigned char* ws = ka->ws;
            pg::GOut g; g.ord.init(T / 256, D / 256, (int)gridDim.x, (int)blockIdx.x); g.A = (const bf16_t*)(ws + WS_MERGED); g.Bt = (const bf16_t*)(ws + WS_WT) + (size_t)lq * WT_LAYER + WT_OUT; g.X = ka->out; g.modl = (const float*)(ws + WS_MOD) + (size_t)lq * NB * 6144;
            for (int rep = 0; rep < 1 + (PROBE_KIND == 4 ? PROBE_REPS : 0); ++rep) { g.dry = rep; pg::gemm_phase(lds, g, wv); }
        }
        SEAM();
        {
            const int lq = opaque_s(l); KArgs ka = kargs(); unsigned char* ws = ka->ws; const int G = gridDim.x;
            for (int vb = blockIdx.x; vb < T / 128; vb += G) norm2_router(lds, vb, ka->out, (bf16_t*)(ws + WS_H), (const float*)(ws + WS_MOD) + (size_t)lq * NB * 6144, ka->in[I_NGAIN] + (size_t)(lq * 2 + 1) * D, (const float*)(ws + WS_WG), (const float*)(ws + WS_CB),
                                                                         (int*)(ws + CTL_CNT) + lq * NE, (int*)(ws + WS_TOKE), (int*)(ws + WS_TOKP), (int*)(ws + WS_LIST), (float*)(ws + WS_LISTW), wv);
        }
        SEAM();
        {
            const int lq = opaque_s(l); KArgs ka = kargs(); unsigned char* ws = ka->ws;
            moe_tables<32, true>(LC, (LAS unsigned short*)(lds + pg::LDS_GTAB), (const int*)(ws + CTL_CNT) + lq * NE, (const int*)(ws + WS_LIST), wv);
            pg::GMoe1 g; g.LC = LC; g.gtab = (const LAS unsigned short*)(lds + pg::LDS_GTAB); g.A = (const bf16_t*)(ws + WS_H); g.Bt = (const bf16_t*)(ws + WS_WT) + (size_t)lq * WT_LAYER + WT_W1; g.b1 = ka->in[I_B1] + (size_t)lq * NE * 2048; g.A2 = (bf16_t*)(ws + WS_A2); g.c = (int)blockIdx.x;
            for (int rep = 0; rep < 1 + (PROBE_KIND == 6 ? PROBE_REPS : 0); ++rep) { g.dry = rep; pg::gemm_phase(lds, g, wv); }
        }
        SEAM();
        {
            const int lq = opaque_s(l); KArgs ka = kargs(); unsigned char* ws = ka->ws;
            moe_tables<64, false>(LC, nullptr, (const int*)(ws + CTL_CNT) + lq * NE, (const int*)(ws + WS_LIST), wv);
            pg::GMoe2 g; g.LC = LC; g.A = (const bf16_t*)(ws + WS_A2); g.Bt = (const bf16_t*)(ws + WS_WT) + (size_t)lq * WT_LAYER + WT_W2; g.b2 = ka->in[I_B2] + (size_t)lq * NE * D; g.listw = (const float*)(ws + WS_LISTW); g.Y = (bf16_t*)(ws + WS_Y); g.c = (int)blockIdx.x;
            for (int rep = 0; rep < 1 + (PROBE_KIND == 7 ? PROBE_REPS : 0); ++rep) { g.dry = rep; pg::gemm_phase(lds, g, wv); }
        }
        SEAM();
    }
    {
        KArgs ka = kargs(); unsigned char* ws = ka->ws; const int G = gridDim.x;
        NormP p{}; p.xin = ka->out; p.X = ka->out; p.modprev = (const float*)(ws + WS_MOD) + (size_t)(NL - 1) * NB * 6144; p.Y = (const bf16_t*)(ws + WS_Y); p.toke = (const int*)(ws + WS_TOKE); p.tokp = (const int*)(ws + WS_TOKP); p.cntprev = (const int*)(ws + CTL_CNT) + (NL - 1) * NE;
        if (TID() == 0) seg_build(p.cntprev, (int*)(lds_raw + LDS_CTL) + LC_SEG); __syncthreads();
        { const int ln = TID() & 63, NGW = G * NWAVES; for (int t = GW(); t < T; t += NGW) norm_row<2>(p, t, ln, (const int*)(lds_raw + LDS_CTL) + LC_SEG); }
    }
#undef SEAM
#undef GW
#undef TID
}

static int g_grid = 0;
static void launch_mega(const float* const* in, float* out, unsigned char* ws, int lo, int hi, int li, hipStream_t stream) {
    MArgs a; memset(&a, 0, sizeof(a));
    for (int i = 0; i < 19; ++i) a.in[i] = in[i];
    a.out = out; a.ws = ws; a.ph_lo = lo; a.ph_hi = hi; a.li = li; a.pad = 0;
    hipLaunchKernelGGL(mega, dim3(g_grid), dim3(NTHR), LDS_BYTES, stream, a);
    const hipError_t le = hipPeekAtLastError();
    if (le != hipSuccess) fprintf(stderr, "kernel_launch: mega launch [%d,%d) failed: %s\n", lo, hi, hipGetErrorName(le));
}
extern "C" void kernel_launch(void* const* d_in, const int* in_sizes, int n_in, void* d_out, int out_size, void* d_ws, size_t ws_size, hipStream_t stream) {
    if (n_in != 19 || out_size != T * D || ws_size < WS_END) { fprintf(stderr, "kernel_launch: unexpected shapes (n_in %d out %d ws %zu need %zu)\n", n_in, out_size, ws_size, (size_t)WS_END); return; }
    if (g_grid == 0) {
        int dev = 0, cus = 0, per_cu = 0;
        if (hipGetDevice(&dev) != hipSuccess || hipDeviceGetAttribute(&cus, hipDeviceAttributeMultiprocessorCount, dev) != hipSuccess) { g_grid = -1; return; }
        if (hipFuncSetAttribute((const void*)mega, hipFuncAttributeMaxDynamicSharedMemorySize, LDS_BYTES) != hipSuccess) { fprintf(stderr, "kernel_launch: hipFuncSetAttribute failed\n"); g_grid = -1; return; }
        if (hipOccupancyMaxActiveBlocksPerMultiprocessor(&per_cu, (const void*)mega, NTHR, LDS_BYTES) != hipSuccess || per_cu < 1) { fprintf(stderr, "kernel_launch: occupancy query says %d\n", per_cu); }
        (void)hipGetLastError();
        g_grid = cus;
    }
    if (g_grid < 0) return;
    const float* const* in = (const float* const*)d_in;
    unsigned char* ws = (unsigned char*)d_ws;
    float* X = (float*)d_out;
    float* mod = (float*)(ws + WS_MOD); float* lf = (float*)(ws + WS_LF); float* cum = (float*)(ws + WS_CUM);
    int* cnt = (int*)(ws + CTL_CNT); float* kmean = (float*)(ws + CTL_KMEAN);
    int* toke = (int*)(ws + WS_TOKE); int* tokp = (int*)(ws + WS_TOKP); int* list = (int*)(ws + WS_LIST); float* listw = (float*)(ws + WS_LISTW);
    bf16_t* H = (bf16_t*)(ws + WS_H); bf16_t* OCAT = (bf16_t*)(ws + WS_OCAT); bf16_t* MERGED = (bf16_t*)(ws + WS_MERGED); bf16_t* PROJ = (bf16_t*)(ws + WS_PROJ);
    bf16_t* A2 = (bf16_t*)(ws + WS_A2); bf16_t* Y = (bf16_t*)(ws + WS_Y);
    float* NV = (float*)(ws + WS_NAIVE);
    (void)mod; (void)toke; (void)tokp; (void)X; (void)cnt; (void)list; (void)listw; (void)H; (void)MERGED; (void)A2; (void)Y; (void)NV; (void)lf; (void)cum; (void)kmean; (void)OCAT; (void)PROJ;
    (void)hipMemsetAsync(ws + WS_CTL, 0, CTL_BYTES, stream);
    launch_mega(in, X, ws, 0, PH_END, 0, stream);
}
```

```cpp
#include <hip/hip_runtime.h>
#include <stdint.h>
#include <stdio.h>
#include <string.h>
#ifndef PROBE_KIND
#define PROBE_KIND -1
#define PROBE_REPS 0
#endif
#ifndef PROBE_DRY
#define PROBE_DRY 1
#endif

typedef unsigned short bf16_t;
typedef short bf16x8 __attribute__((ext_vector_type(8)));
typedef float f32x4 __attribute__((ext_vector_type(4)));
typedef float f32x16 __attribute__((ext_vector_type(16)));
typedef unsigned u32x4 __attribute__((ext_vector_type(4)));
typedef unsigned u32x2 __attribute__((ext_vector_type(2)));

constexpr int NB = 8, S = 4096, T = NB * S, D = 1024, NL = 4, DIN = 5380, PW = 5376, NE = 32, CAP = 32768;
constexpr int ROWS_MAX = T * 4 + NE * 256;
constexpr float EPS = 1e-6f;
constexpr float LOG2E = 1.4426950408889634f;
constexpr float C2 = 0.125f * LOG2E;
constexpr int FQ = 0, FK = 256, FV = 512, SQ = 768, SK = 1280, SV = 1408, MQ = 1536, MK = 1792, MV = 2048, GA = 2304, GB = 3328, GC = 4352;
enum { I_X = 0, I_C, I_WADA, I_BADA, I_NGAIN, I_WIN, I_BF, I_QKG, I_SINK, I_WBF, I_WBS, I_WBM, I_WOUT, I_WR, I_BR, I_W1, I_B1, I_W2, I_B2 };

constexpr size_t MiB = 1ull << 20;
constexpr size_t WS_CTL = 0, CTL_BYTES = 2 * MiB;
constexpr size_t CTL_CNT = 512 * 1024;
constexpr int CNT_STRIDE = 32;
constexpr size_t CTL_KMEAN = 1 * MiB;
constexpr size_t WS_MOD = 2 * MiB;
constexpr size_t WS_LF = 3 * MiB;
constexpr size_t WS_CUM = 4 * MiB;
constexpr size_t WS_WG = 7 * MiB;
constexpr size_t WS_CB = 6 * MiB + 512 * 1024;
constexpr size_t WS_TOKE = 5 * MiB;
constexpr size_t WS_TOKP = 6 * MiB;
constexpr size_t WS_LIST = 8 * MiB;
constexpr size_t WS_LISTW = 12 * MiB;
constexpr size_t WS_H = 16 * MiB;
constexpr size_t WS_OCAT = 80 * MiB;
constexpr size_t WS_MERGED = 144 * MiB;
constexpr size_t WS_PROJ = 208 * MiB;
constexpr size_t WS_A2 = 544 * MiB;
constexpr size_t WS_Y = 816 * MiB;
constexpr size_t WS_NAIVE = 1088 * MiB;
constexpr size_t CTL_MCNT = 768 * 1024;
constexpr size_t WS_MSEL = 1160 * MiB;
constexpr size_t WS_MLIST = 1161 * MiB;
constexpr size_t WS_MPO = 1168 * MiB;
constexpr size_t WS_MPML = 1220 * MiB;
constexpr int MLCAP = 3840;
constexpr size_t WS_WGT = 1152 * MiB;
constexpr size_t WS_XB = 1088 * MiB;
constexpr size_t WS_WT = 2304 * MiB;
constexpr size_t WS_END = WS_WT + 4 * 216 * MiB;

__device__ __forceinline__ unsigned f2bf(float f) { unsigned u = __float_as_uint(f); return (u + 0x7fffu + ((u >> 16) & 1u)) >> 16; }
__device__ __forceinline__ float bf2f(unsigned b) { return __uint_as_float(b << 16); }
__device__ __forceinline__ unsigned pk2(float lo, float hi) { return f2bf(lo) | (f2bf(hi) << 16); }
__device__ __forceinline__ float wave_sum(float v) {
#pragma unroll
    for (int o = 1; o < 64; o <<= 1) v += __shfl_xor(v, o);
    return v;
}
__device__ __forceinline__ float wave_max(float v) {
#pragma unroll
    for (int o = 1; o < 64; o <<= 1) v = fmaxf(v, __shfl_xor(v, o));
    return v;
}
template <int CTRL> __device__ __forceinline__ float dpp_f(float v) { return __int_as_float(__builtin_amdgcn_update_dpp(0, __float_as_int(v), CTRL, 0xf, 0xf, true)); }
__device__ __forceinline__ float sum_x16(float v) { auto rr = __builtin_amdgcn_permlane16_swap(__float_as_uint(v), __float_as_uint(v), false, false); return __uint_as_float(rr[0]) + __uint_as_float(rr[1]); }
__device__ __forceinline__ float sum_x32(float v) { auto rr = __builtin_amdgcn_permlane32_swap(__float_as_uint(v), __float_as_uint(v), false, false); return __uint_as_float(rr[0]) + __uint_as_float(rr[1]); }
__device__ __forceinline__ float sum_row16(float v) {
    v += dpp_f<0xB1>(v);
    v += dpp_f<0x4E>(v);
    v += dpp_f<0x141>(v);
    v += dpp_f<0x140>(v);
    return v; }
__device__ __forceinline__ float wsum(float v) { return sum_x32(sum_x16(sum_row16(v))); }
__device__ __forceinline__ float alibi_slope(int i) { return exp2f(-8.0f * (float)(i + 1) / 12.0f); }
__device__ __forceinline__ float sigmoidf_(float x) { return 1.0f / (1.0f + __expf(-x)); }

__device__ __forceinline__ void seg_build(const int* cnt, int* seg) {
    int a = 0;
    for (int e = 0; e < NE; ++e) { seg[e] = a; a += (cnt[e] + 255) & ~255; }
    seg[NE] = a;
}
__device__ __forceinline__ int tile_prefix(const volatile __attribute__((address_space(3))) unsigned* cntL, int e) {
    int a = 0;
#pragma unroll
    for (int j = 0; j < NE; ++j) { const int t = ((int)cntL[j] + 255) >> 8; a += (j < e) ? t : 0; }
    return a;
}

struct NormP {
    const float* xin;
    const bf16_t* xinb;
    float* X;
    bf16_t* Xb;
    bf16_t* H;
    const float* mod;
    const float* modprev;
    const float* gain;
    const bf16_t* Y; const int* toke; const int* tokp; const int* cntprev;
    const float* wf;
    const float* bf;
    float* lf;
    const float* wr; const float* br;
    int* cnt; int* toke_o; int* tokp_o; int* list; float* listw;
};

#define LAS __attribute__((address_space(3)))
#define GAS __attribute__((address_space(1)))
constexpr int NWAVES = 8, NTHR = 512;
constexpr int LDS_BYTES = 163840;
constexpr int LDS_CTL = 131072;
constexpr int LC_BAR = 0, LC_SEG = 16, LC_TPF = 64, LC_CNT = 128, LC_UT = 192;
constexpr int CW_BAR = 1024;
constexpr size_t WT_IN = 0, WT_BR = (size_t)PW * D, WT_OUT = WT_BR + (size_t)D * D, WT_W1 = WT_OUT + (size_t)D * D, WT_W2 = WT_W1 + (size_t)NE * 2048 * D, WT_LAYER = 216ull * MiB / 2;
static_assert(WT_W2 + (size_t)NE * D * D <= WT_LAYER, "weights per layer");

#define XB_TMO      128
#define XB_XCNT(j)  (256  + 64 * (j))
#define XB_XSUB(j)  (1280 + 64 * (j))
#define XB_XGEN(j)  (2304 + 64 * (j))
#define XB_TOP      3328
#define XB_TOPGEN   3392
#define XCD_BAR_WORDS 3456
#define XB_SPIN_CAP (1u << 18)
__device__ __forceinline__ unsigned xb_ld(unsigned* p)              { return __hip_atomic_load(p, __ATOMIC_RELAXED, __HIP_MEMORY_SCOPE_AGENT); }
__device__ __forceinline__ unsigned xb_add(unsigned* p, unsigned v) { return __hip_atomic_fetch_add(p, v, __ATOMIC_RELAXED, __HIP_MEMORY_SCOPE_AGENT); }
__device__ __forceinline__ int xb_lane() { unsigned z = 0u; asm volatile("" : "+v"(z)); return (int)__builtin_amdgcn_mbcnt_hi(~0u, __builtin_amdgcn_mbcnt_lo(~0u, z)); }
__device__ __forceinline__ unsigned xb_xcc_id() { return (unsigned)__builtin_amdgcn_s_getreg((3 << 11) | 20) & 0xFu; }
#define XB_SPIN(cond, bar) do { unsigned _sp = 0; while (cond) { __builtin_amdgcn_s_sleep(1); \
    if ((++_sp & 255u) == 0u) { if (xb_ld(&(bar)[XB_TMO])) break; if (_sp > XB_SPIN_CAP) { atomicAdd(&(bar)[XB_TMO], 1u); break; } } } } while (0)
struct XcdBarrier { unsigned* bar; unsigned x; volatile LAS unsigned* st; int wv; };
__device__ __forceinline__ XcdBarrier xcd_barrier_post(unsigned* bar, volatile LAS unsigned* st, int wv) {
    XcdBarrier b; b.bar = bar; b.x = xb_xcc_id(); b.st = st; b.wv = wv;
    if (wv == 0 && xb_lane() == 0) (void)xb_add(&bar[XB_XCNT(b.x)], 1u);
    return b;
}
__device__ __forceinline__ void xcd_barrier_complete(unsigned* bar, unsigned x, unsigned& nloc, unsigned& nx) {
    const unsigned G = gridDim.x * gridDim.y * gridDim.z;
    unsigned sum, cnt, mine, sp = 0u;
    for (;;) {
        sum = 0u; cnt = 0u; mine = 0u;
#pragma unroll
        for (unsigned j = 0; j < 16; ++j) { const unsigned c = xb_ld(&bar[XB_XCNT(j)]); sum += c; cnt += (c > 0u) ? 1u : 0u; mine = (j == x) ? c : mine; }
        if (sum == G) break;
        __builtin_amdgcn_s_sleep(1);
        if ((++sp & 255u) == 0u) { if (xb_ld(&bar[XB_TMO])) break; if (sp > XB_SPIN_CAP) { atomicAdd(&bar[XB_TMO], 1u); break; } }
    }
    nloc = mine > 0u ? mine : 1u; nx = cnt > 0u ? cnt : 1u;
}
__device__ __forceinline__ void xcd_barrier(const XcdBarrier& b) {
    asm volatile("s_waitcnt vmcnt(0)" ::: "memory");
    __syncthreads();
    if (b.wv == 0 && xb_lane() == 0) {
        unsigned* bar = b.bar; unsigned bx = b.x;
        asm volatile("" : "+s"(bar), "+s"(bx));
        __builtin_amdgcn_s_waitcnt(0);
        unsigned nloc = b.st[0], nx = b.st[1];
        if (nloc == 0u) { xcd_barrier_complete(bar, bx, nloc, nx); b.st[0] = nloc; b.st[1] = nx; }
        const unsigned old = xb_add(&bar[XB_XSUB(bx)], 1u);
        const unsigned gen = old / nloc;
        if (old + 1u == (gen + 1u) * nloc) {
            __builtin_amdgcn_fence(__ATOMIC_RELEASE, "agent");
            asm volatile("s_waitcnt vmcnt(0)" ::: "memory");
            const unsigned og = xb_add(&bar[XB_TOP], 1u);
            const unsigned tg = og / nx;
            if (og + 1u == (tg + 1u) * nx) xb_add(&bar[XB_TOPGEN], 1u);
            else XB_SPIN(xb_ld(&bar[XB_TOPGEN]) == tg, bar);
            __builtin_amdgcn_fence(__ATOMIC_ACQUIRE, "agent");
            xb_add(&bar[XB_XGEN(bx)], 1u);
            asm volatile("s_waitcnt vmcnt(0)" ::: "memory");
        } else {
            XB_SPIN(xb_ld(&bar[XB_XGEN(bx)]) == gen, bar);
            __builtin_amdgcn_fence(__ATOMIC_ACQUIRE, "agent");
            asm volatile("s_waitcnt vmcnt(0)" ::: "memory");
        }
    }
    __syncthreads();
}

__device__ __forceinline__ int lane_id() { unsigned z = 0u; asm volatile("" : "+v"(z)); return (int)__builtin_amdgcn_mbcnt_hi(~0u, __builtin_amdgcn_mbcnt_lo(~0u, z)); }
__device__ __forceinline__ int tid_of(int wv) { return wv * 64 + lane_id(); }
__device__ __forceinline__ int opaque_s(int v) { asm volatile("" : "+s"(v)); return v; }
__device__ __forceinline__ int opaque(int v) { asm volatile("" : "+v"(v)); return v; }
struct MArgs { const float* in[19]; float* out; unsigned char* ws; int ph_lo, ph_hi, li, pad; };
static_assert(sizeof(MArgs) == 19 * 8 + 8 + 8 + 16, "MArgs has no padding");

__device__ __forceinline__ void p0_mod(const float* __restrict__ c, const float* __restrict__ w_ada, const float* __restrict__ b_ada, float* __restrict__ mod, LAS float* lds, int wv) {
    LAS float* sc = lds;
    LAS float* red = lds + NB * D;
    const int lane = lane_id(), w = wv, tid = w * 64 + lane;
    for (int i = tid; i < NB * D; i += NTHR) { const float v = c[i]; sc[i] = v / (1.0f + __expf(-v)); }
    __syncthreads();
    const int cl = lane & 31, kp = lane >> 5;
    for (int u = blockIdx.x; u < NL * 6144 / 32; u += gridDim.x) {
        const int col = u * 32 + cl, l = col / 6144, j = col % 6144;
        const float* wp = w_ada + (size_t)l * D * 6144 + j + (size_t)(w * 128 + kp) * 6144;
        float acc[NB];
#pragma unroll
        for (int b = 0; b < NB; ++b) acc[b] = 0.f;
#pragma unroll 1
        for (int i0 = 0; i0 < 64; i0 += 32) { float wv[32];
#pragma unroll
            for (int i = 0; i < 32; ++i) wv[i] = __builtin_nontemporal_load(wp + (size_t)(2 * (i0 + i)) * 6144);
#pragma unroll
            for (int i = 0; i < 32; ++i) { const int k = w * 128 + 2 * (i0 + i) + kp;
#pragma unroll
                for (int b = 0; b < NB; ++b) acc[b] += sc[b * D + k] * wv[i]; } }
#pragma unroll
        for (int b = 0; b < NB; ++b) { acc[b] = sum_x32(acc[b]); if (lane < 32) red[(w * NB + b) * 32 + lane] = acc[b]; }
        __syncthreads();
        if (tid < 256) { const int b = tid >> 5, c = tid & 31; float a = 0.f;
#pragma unroll
          for (int ww = 0; ww < 8; ++ww) a += red[(ww * NB + b) * 32 + c];
          const int oc = u * 32 + c, ol = oc / 6144, oj = oc % 6144;
          mod[(size_t)(ol * NB + b) * 6144 + oj] = a + b_ada[ol * 6144 + oj]; }
        __syncthreads();
    }
}
__device__ __forceinline__ int inproj_slot(int n) {
    if (n >= 768 && n < 772) return -1;
    const int c = n < 768 ? n : n - 4; const int pn = c >> 8, cc = c & 255;
    return pn * 256 + ((cc >> 5) & 1) * 128 + (cc >> 6) * 32 + (cc & 31);
}
__device__ __forceinline__ int w1_slot(int n) { const int pn = n >> 8, cc = n & 255, o = cc >> 1, r = cc & 1; return pn * 256 + ((o >> 2) & 1) * 128 + (o >> 5) * 32 + ((o >> 3) & 3) * 8 + (o & 3) * 2 + r; }
constexpr int CV_IN = 16 * 169, CV_BF = 4 * 32, CV_BS = 8 * 32, CV_BM = 4 * 32, CV_O = 16 * 32, CV_1 = NE * 16 * 64, CV_2 = NE * 16 * 32;
constexpr int CV_S1 = CV_IN + CV_BF + CV_BS + CV_BM + CV_O, CV_PER_L = CV_S1 + CV_1 + CV_2, CV_N = NL * CV_PER_L;
constexpr int CW_CONVQ = 6016;
#ifndef CV_QUOTA
#define CV_QUOTA 8
#endif
typedef const __attribute__((address_space(4))) MArgs* KArgs;
__device__ __forceinline__ void conv_block(const float* __restrict__ W, int ldn, int k0, int n0, int nvalid, bf16_t* __restrict__ WT, int kdst0, int map, LAS float* scr, int lane) {
    const int nl = lane & 31;
    const float wsc = (map == 1 && n0 + nl >= GA + 4) ? -LOG2E : 1.0f;
    const bool inr = nl < nvalid;
    const float* wp = W + (size_t)(k0 + (lane >> 5)) * ldn + n0 + (inr ? nl : 0);
    const float wsz = inr ? wsc : 0.f;
    LAS float* sp = scr + (lane >> 5) * 33 + nl;
#pragma unroll
    for (int i0 = 0; i0 < 32; i0 += 16) { float v[16];
#pragma unroll
        for (int i = 0; i < 16; ++i) v[i] = __builtin_nontemporal_load(wp + (size_t)(2 * (i0 + i)) * ldn);
#pragma unroll
        for (int i = 0; i < 16; ++i) sp[(2 * (i0 + i)) * 33] = v[i] * wsz; }
    asm volatile("s_waitcnt lgkmcnt(0)" ::: "memory");
    const int c = lane & 7;
#pragma unroll
    for (int j = 0; j < 4; ++j) { const int n = (lane >> 3) + 8 * j; const LAS float* s = scr + (8 * c) * 33 + n;
        u32x4 o; o.x = pk2(s[0 * 33], s[1 * 33]); o.y = pk2(s[2 * 33], s[3 * 33]); o.z = pk2(s[4 * 33], s[5 * 33]); o.w = pk2(s[6 * 33], s[7 * 33]);
        int row = n0 + n; bool ok = n < nvalid;
        if (map == 1) { row = inproj_slot(ok ? row : 0); ok = ok && row >= 0; }
        else if (map == 2) row = w1_slot(row);
        if (ok) *(u32x4*)(WT + (size_t)row * D + kdst0 + k0 + 8 * c) = o; }
    asm volatile("s_waitcnt lgkmcnt(0)" ::: "memory");
}
__device__ __forceinline__ void conv_item(KArgs ka, bf16_t* __restrict__ wt, int it, LAS float* scr, int lane) {
    const int l = it / CV_PER_L; int r = it - l * CV_PER_L;
    bf16_t* wl = wt + (size_t)l * WT_LAYER;
    const float* W; bf16_t* WT; int ldn = D, kb, nb, nv = 32, kd = 0, map = 0;
    if (r < CV_IN) { kb = r / 169; nb = r - kb * 169; nv = (nb == 168) ? 4 : 32; W = ka->in[I_WIN] + (size_t)l * D * DIN; ldn = DIN; WT = wl + WT_IN; map = 1; }
    else if (r < CV_IN + CV_BF) { r -= CV_IN; kb = r >> 5; nb = r & 31; W = ka->in[I_WBF] + (size_t)l * 256 * D; WT = wl + WT_BR; }
    else if (r < CV_IN + CV_BF + CV_BS) { r -= CV_IN + CV_BF; kb = r >> 5; nb = r & 31; W = ka->in[I_WBS] + (size_t)l * 512 * D; WT = wl + WT_BR; kd = 256; }
    else if (r < CV_IN + CV_BF + CV_BS + CV_BM) { r -= CV_IN + CV_BF + CV_BS; kb = r >> 5; nb = r & 31; W = ka->in[I_WBM] + (size_t)l * 256 * D; WT = wl + WT_BR; kd = 768; }
    else if (r < CV_S1) { r -= CV_S1 - CV_O; kb = r >> 5; nb = r & 31; W = ka->in[I_WOUT] + (size_t)l * D * D; WT = wl + WT_OUT; }
    else if (r < CV_S1 + CV_2) { r -= CV_S1; const int e = r >> 9, q = r & 511; kb = q >> 5; nb = q & 31; W = ka->in[I_W2] + ((size_t)l * NE + e) * D * D; WT = wl + WT_W2 + (size_t)e * D * D; }
    else { r -= CV_S1 + CV_2; const int e = r >> 10, q = r & 1023; kb = q >> 6; nb = q & 63; W = ka->in[I_W1] + ((size_t)l * NE + e) * D * 2048; ldn = 2048; WT = wl + WT_W1 + (size_t)e * 2048 * D; map = 2; }
    conv_block(W, ldn, kb * 64, nb * 32, nv, WT, kd, map, scr, lane);
}
constexpr int LC_CVQ = 8;
__device__ __forceinline__ void conv_flush(KArgs ka, unsigned char* ws, LAS unsigned char* lds, int wv_, int need) {
    const int wv = opaque_s(wv_);
    unsigned* q = (unsigned*)ws + CW_CONVQ;
    const int lane = opaque(lane_id());
    LAS float* scr = (LAS float*)lds + wv * (64 * 33 + 16);
    bf16_t* wt = (bf16_t*)(ws + WS_WT);
    const int head = __builtin_amdgcn_readfirstlane((int)__hip_atomic_load(q, __ATOMIC_RELAXED, __HIP_MEMORY_SCOPE_AGENT));
    const int gw = opaque_s((int)blockIdx.x) * NWAVES + wv, NGW = opaque_s((int)gridDim.x * NWAVES);
#pragma unroll 1
    for (int it = head + gw; it < need; it += NGW) conv_item(ka, wt, it, scr, lane);
}
__device__ __forceinline__ void conv_raise(unsigned char* ws, int wv_, int need) {
    const int wv = opaque_s(wv_);
    if (blockIdx.x == 0 && wv == 0 && lane_id() == 0) (void)__hip_atomic_fetch_max((unsigned*)ws + CW_CONVQ, (unsigned)need, __ATOMIC_RELAXED, __HIP_MEMORY_SCOPE_AGENT);
}
__device__ __forceinline__ void conv_tail(KArgs ka, unsigned char* ws, LAS unsigned char* lds, volatile LAS unsigned* LC, int wv_, int npw) {
    const int wv = opaque_s(wv_);
    unsigned* q = (unsigned*)ws + CW_CONVQ;
    const int lane = opaque(lane_id());
    if (wv == 0 && lane == 0) LC[LC_CVQ] = __hip_atomic_fetch_add(q, (unsigned)(NWAVES * npw), __ATOMIC_RELAXED, __HIP_MEMORY_SCOPE_AGENT);
    __syncthreads();
    const int base = __builtin_amdgcn_readfirstlane((int)LC[LC_CVQ]);
    LAS float* scr = (LAS float*)lds + wv * (64 * 33 + 16);
    bf16_t* wt = (bf16_t*)(ws + WS_WT);
#pragma unroll 1
    for (int k = 0; k < npw; ++k) { const int it = base + k * NWAVES + wv; if (it < CV_N) conv_item(ka, wt, it, scr, lane); }
}

namespace pg {
constexpr int BM = 256, BK = 64, HALF = 128, HTB = HALF * BK * 2, STAGE_BYTES = 8 * HTB, KK = 1024, NT = KK / BK;
__device__ __forceinline__ int lds_byte(int r, int c) { const int st = (r >> 4) * 2 + (c >> 5), rr = r & 15, cc = c & 31, ob = rr * 64 + cc * 2; return st * 1024 + (ob ^ (((ob >> 9) & 1) << 5)); }
__device__ __forceinline__ void stage_rc(int b, int& R, int& C) { const int st = b / 1024, sb = b % 1024, swz = sb ^ (((sb >> 9) & 1) << 5); R = (st >> 1) * 16 + swz / 64; C = (st & 1) * 32 + (swz % 64) / 2; }
__device__ __forceinline__ int perm32(int rho) { const int n = rho >> 4, i = rho & 15; return 8 * (i >> 2) + 4 * n + (i & 3); }
struct Unit { int pm, pn, e, rb; };
__device__ __forceinline__ unsigned cvt_pk_bf16(float lo, float hi) { unsigned r; asm volatile("v_cvt_pk_bf16_f32 %0, %1, %2" : "=v"(r) : "v"(lo), "v"(hi)); return r; }
typedef f32x4 Acc[2][2][4][2];
template <class G>
__device__ __forceinline__ void gemm_phase(LAS unsigned char* lds, const G& g, int wv) {
    const int wid = wv, lane = opaque(lane_id()), tid = wid * 64 + lane, wr = wid >> 2, wc = wid & 3, fr = lane & 15, fq = lane >> 4;
    unsigned voffA[2], voffB[2];
    int Rr[2];
#pragma unroll
    for (int i = 0; i < 2; ++i) { int R, C; stage_rc(tid * 16 + i * 8192, R, C); Rr[i] = R; const int Rb = G::PERM ? ((R & ~31) + perm32(R & 31)) : R;
        voffA[i] = G::GATHER ? (unsigned)C * 2u : (unsigned)(R * g.lda() + C) * 2u; voffB[i] = (unsigned)(Rb * KK + C) * 2u; }
    const size_t kstep = (size_t)(BK * 2), hstep = (size_t)HALF * KK * 2;
    const size_t hstepA = G::GATHER ? 0 : (size_t)HALF * g.lda() * 2;
    const unsigned ldsw = (unsigned)wid * 1024u;
    const int aoff = lds_byte(wr * 64 + fr, fq * 8), boff = lds_byte(wc * 32 + fr, fq * 8);
#define PG_SA(b, h) (((b) * 2 + (h)) * HTB)
#define PG_SB(b, h) ((4 + (b) * 2 + (h)) * HTB)
#define PG_STAGE(bufoff, gbase, voff) do { _Pragma("unroll") for (int _i = 0; _i < 2; ++_i) \
        __builtin_amdgcn_global_load_lds((const unsigned*)((const char*)(gbase) + (voff)[_i]), (LAS unsigned*)(lds + (bufoff) + ldsw + _i * 8192), 16, 0, 0); } while (0)
#define PG_STAGE_A(bufoff, ab, h, go) do { if constexpr (G::GATHER) { PG_STAGE(bufoff, ab, (go)[h]); } else { PG_STAGE(bufoff, (ab) + (h) * hstepA, voffA); } } while (0)
#define PG_LDA(dst, b, h) do { _Pragma("unroll") for (int m = 0; m < 4; ++m) _Pragma("unroll") for (int k = 0; k < 2; ++k) dst[m][k] = *(const LAS bf16x8*)(lds + PG_SA(b, h) + aoff + m * 2048 + k * 1024); } while (0)
#define PG_LDB(dst, b, h) do { _Pragma("unroll") for (int n = 0; n < 2; ++n) _Pragma("unroll") for (int k = 0; k < 2; ++k) dst[n][k] = *(const LAS bf16x8*)(lds + PG_SB(b, h) + boff + n * 2048 + k * 1024); } while (0)
#define PG_MMA(ai, bj, At, Bt) do { __builtin_amdgcn_s_setprio(1); _Pragma("unroll") for (int m = 0; m < 4; ++m) _Pragma("unroll") for (int n = 0; n < 2; ++n) _Pragma("unroll") for (int k = 0; k < 2; ++k) \
        acc[ai][bj][m][n] = __builtin_amdgcn_mfma_f32_16x16x32_bf16(Bt[n][k], At[m][k], acc[ai][bj][m][n], 0, 0, 0); __builtin_amdgcn_s_setprio(0); } while (0)
#define PG_WAIT_V(n) asm volatile("s_waitcnt vmcnt(" #n ")" ::: "memory")
#define PG_WAIT_L(n) asm volatile("s_waitcnt lgkmcnt(" #n ")" ::: "memory")
#define PG_BAR __builtin_amdgcn_s_barrier()
#define PG_SCHED __builtin_amdgcn_sched_barrier(0)
    Unit cur, nxt; int ui = 0;
    if (!g.next(0, cur)) return;
    if constexpr (G::STAGGER > 0) {
        const unsigned long long t0 = __builtin_amdgcn_s_memrealtime(); const unsigned long long dl = (unsigned long long)(((int)blockIdx.x >> 3) & 31) * (G::STAGGER / 32);
        while (__builtin_amdgcn_s_memrealtime() - t0 < dl) __builtin_amdgcn_s_sleep(8);
    }
    Acc acc;
#pragma unroll
    for (int a = 0; a < 2; ++a)
#pragma unroll
        for (int b = 0; b < 2; ++b)
#pragma unroll
            for (int m = 0; m < 4; ++m)
#pragma unroll
                for (int n = 0; n < 2; ++n) acc[a][b][m][n] = (f32x4){0.f, 0.f, 0.f, 0.f};
    bf16x8 At[4][2], B0[2][2], B1[2][2];
    unsigned goC[2][2];
    if constexpr (G::GATHER) g.gather_offs(0, Rr, voffA, goC);
    const char* cA = g.a_tile(cur); const char* cB = g.b_tile(cur);
    PG_STAGE(PG_SB(0, 0), cB, voffB); PG_STAGE(PG_SB(0, 1), cB + hstep, voffB); PG_STAGE_A(PG_SA(0, 0), cA, 0, goC); PG_STAGE_A(PG_SA(0, 1), cA, 1, goC);
    if (wr == 1) PG_BAR;
    PG_WAIT_V(2); PG_BAR;
    PG_STAGE(PG_SB(1, 0), cB + kstep, voffB); PG_STAGE_A(PG_SA(1, 0), cA + kstep, 0, goC); PG_STAGE(PG_SB(1, 1), cB + hstep + kstep, voffB);
    PG_WAIT_V(6); PG_BAR;
    for (;;) {
        const bool has_next = g.next(ui + 1, nxt);
        const char* nA = has_next ? g.a_tile(nxt) : cA; const char* nB = has_next ? g.b_tile(nxt) : cB;
        for (int t = 0; t < NT; t += 2) {
            const bool last = (t == NT - 2);
            if constexpr (G::MID) { if (t == 4 || t == 12) { g.mid(acc, cur, t, wr, wc, opaque(fr), opaque(fq)); PG_SCHED; } }
            const char* a1 = cA + (size_t)(t + 1) * kstep;
            const char* a2 = last ? nA : cA + (size_t)(t + 2) * kstep; const char* b2 = last ? nB : cB + (size_t)(t + 2) * kstep;
            const char* a3 = a2 + kstep; const char* b3 = b2 + kstep;
            unsigned go2[2][2];
            if constexpr (G::GATHER) {
                if (last && has_next) g.gather_offs(ui + 1, Rr, voffA, go2);
                else {
#pragma unroll
                    for (int h = 0; h < 2; ++h)
#pragma unroll
                        for (int i = 0; i < 2; ++i) go2[h][i] = goC[h][i]; } }
            PG_LDB(B0, 0, 0); PG_LDB(B1, 0, 1); PG_SCHED; PG_LDA(At, 0, 0); PG_STAGE_A(PG_SA(1, 1), a1, 1, goC);
            PG_WAIT_V(8); PG_WAIT_L(0); PG_BAR; PG_MMA(0, 0, At, B0); PG_MMA(0, 1, At, B1); PG_BAR; PG_SCHED;
            PG_LDA(At, 0, 1); PG_STAGE(PG_SB(0, 0), b2, voffB); PG_STAGE(PG_SB(0, 1), b2 + hstep, voffB); PG_STAGE_A(PG_SA(0, 0), a2, 0, go2);
            PG_WAIT_V(8); PG_WAIT_L(0); PG_BAR; PG_MMA(1, 0, At, B0); PG_MMA(1, 1, At, B1); PG_BAR; PG_SCHED;
            PG_LDB(B0, 1, 0); PG_LDB(B1, 1, 1); PG_SCHED; PG_LDA(At, 1, 0); PG_STAGE_A(PG_SA(0, 1), a2, 1, go2);
            PG_WAIT_V(8); PG_WAIT_L(0); PG_BAR; PG_MMA(0, 0, At, B0); PG_MMA(0, 1, At, B1); PG_BAR; PG_SCHED;
            PG_LDA(At, 1, 1); PG_STAGE(PG_SB(1, 0), b3, voffB); PG_STAGE(PG_SB(1, 1), b3 + hstep, voffB); PG_STAGE_A(PG_SA(1, 0), a3, 0, go2);
            PG_WAIT_V(8); PG_WAIT_L(0); PG_BAR; PG_MMA(1, 0, At, B0); PG_MMA(1, 1, At, B1); PG_BAR; PG_SCHED;
        }
        if (wr == 0) PG_BAR;
        if (!(g.dry && PROBE_DRY)) g.epi(acc, cur, wr, wc, opaque(fr), opaque(fq));
        if (!has_next) break;
#pragma unroll
        for (int a = 0; a < 2; ++a)
#pragma unroll
            for (int b = 0; b < 2; ++b)
#pragma unroll
                for (int m = 0; m < 4; ++m)
#pragma unroll
                    for (int n = 0; n < 2; ++n) acc[a][b][m][n] = (f32x4){0.f, 0.f, 0.f, 0.f};
        cur = nxt; cA = nA; cB = nB; ++ui;
        if constexpr (G::GATHER) g.gather_offs(ui, Rr, voffA, goC);
        if (wr == 1) PG_BAR;
    }
    PG_WAIT_V(0);
    PG_BAR;
#undef PG_SA
#undef PG_SB
#undef PG_STAGE
#undef PG_STAGE_A
#undef PG_LDA
#undef PG_LDB
#undef PG_MMA
#undef PG_WAIT_V
#undef PG_WAIT_L
#undef PG_BAR
#undef PG_SCHED
}

struct TileOrder {
    int nM, nN, nwg, G, c;
    __device__ __forceinline__ void init(int nM_, int nN_, int G_, int c_) { nM = nM_; nN = nN_; nwg = nM * nN; G = G_; c = c_; }
    __device__ __forceinline__ bool next(int i, Unit& u) const {
        const long L = (long)i * G + c; if (L >= nwg) return false;
        int wgid = (int)L; { const int q = nwg / 8, r = nwg % 8, xcd = wgid % 8, off = wgid / 8; wgid = (xcd < r ? xcd * (q + 1) : r * (q + 1) + (xcd - r) * q) + off; }
        const int nig = 8 * nN, gid = wgid / nig, fm = gid * 8, gsz = (nM - fm) < 8 ? (nM - fm) : 8;
        u.pm = fm + ((wgid % nig) % gsz); u.pn = (wgid % nig) / gsz; u.e = 0; u.rb = u.pm * BM; return true;
    }
};
struct GOut {
    static constexpr bool PERM = true, MID = false, GATHER = false; static constexpr int STAGGER = 0;
    TileOrder ord; const bf16_t* A; const bf16_t* Bt; bf16_t* X; const float* modl; int dry;
    __device__ __forceinline__ bool next(int i, Unit& u) const { return ord.next(i, u); }
    __device__ __forceinline__ int lda() const { return D; }
    __device__ __forceinline__ void gather_offs(int, const int (&)[2], const unsigned (&)[2], unsigned (&)[2][2]) const {}
    __device__ __forceinline__ const char* a_tile(const Unit& u) const { return (const char*)(A + (size_t)u.pm * BM * D); }
    __device__ __forceinline__ const char* b_tile(const Unit& u) const { return (const char*)(Bt + (size_t)u.pn * BM * KK); }
    __device__ __forceinline__ void mid(Acc&, const Unit&, int, int, int, int, int) const {}
    __device__ __forceinline__ void epi(Acc& acc, const Unit& u, int wr, int wc, int fr, int fq) const {
        const int row0 = u.pm * BM + wr * 64 + fr, col0 = u.pn * BM + wc * 32 + 8 * fq;
        const float* g1 = modl + (size_t)(u.pm >> 4) * 6144 + 2 * D;
        f32x4 gv[2][2];
#pragma unroll
        for (int bj = 0; bj < 2; ++bj)
#pragma unroll
            for (int n = 0; n < 2; ++n) gv[bj][n] = *(const f32x4*)(g1 + col0 + bj * HALF + 4 * n);
#pragma unroll
        for (int ai = 0; ai < 2; ++ai) {
            u32x4 x[4][2];
#pragma unroll
            for (int m = 0; m < 4; ++m)
#pragma unroll
                for (int bj = 0; bj < 2; ++bj) x[m][bj] = *(const u32x4*)(X + (size_t)(row0 + ai * HALF + m * 16) * D + col0 + bj * HALF);
#pragma unroll
            for (int m = 0; m < 4; ++m)
#pragma unroll
                for (int bj = 0; bj < 2; ++bj) { const u32x4 xo = x[m][bj]; const f32x4 a0 = acc[ai][bj][m][0] * gv[bj][0], a1 = acc[ai][bj][m][1] * gv[bj][1];
                    u32x4 w; w.x = cvt_pk_bf16(bf2f(xo.x & 0xffffu) + a0[0], bf2f(xo.x >> 16) + a0[1]); w.y = cvt_pk_bf16(bf2f(xo.y & 0xffffu) + a0[2], bf2f(xo.y >> 16) + a0[3]);
                    w.z = cvt_pk_bf16(bf2f(xo.z & 0xffffu) + a1[0], bf2f(xo.z >> 16) + a1[1]); w.w = cvt_pk_bf16(bf2f(xo.w & 0xffffu) + a1[2], bf2f(xo.w >> 16) + a1[3]);
                    *(u32x4*)(X + (size_t)(row0 + ai * HALF + m * 16) * D + col0 + bj * HALF) = w; }
            asm volatile("" ::: "memory"); }
    }
};

struct GBranch {
    static constexpr bool PERM = true, MID = true, GATHER = false; static constexpr int STAGGER = 0;
    TileOrder ord; const bf16_t* A; const bf16_t* Bt; const bf16_t* PROJ; bf16_t* MERGED; int dry;
    __device__ __forceinline__ bool next(int i, Unit& u) const { return ord.next(i, u); }
    __device__ __forceinline__ int lda() const { return D; }
    __device__ __forceinline__ void gather_offs(int, const int (&)[2], const unsigned (&)[2], unsigned (&)[2][2]) const {}
    __device__ __forceinline__ const char* a_tile(const Unit& u) const { return (const char*)(A + (size_t)u.pm * BM * D); }
    __device__ __forceinline__ const char* b_tile(const Unit& u) const { return (const char*)(Bt + (size_t)u.pn * BM * KK); }
    __device__ __forceinline__ void mid(Acc& acc, const Unit& u, int t, int wr, int wc, int fr, int fq) const {
        const int num = (t == 4) ? GA : GB, den = (t == 4) ? GB : GC;
        const int row0 = u.pm * BM + wr * 64 + fr, col0 = u.pn * BM + wc * 32 + 8 * fq;
#pragma unroll
        for (int ai = 0; ai < 2; ++ai) {
            u32x4 gn[4][2], gd[4][2];
#pragma unroll
            for (int m = 0; m < 4; ++m) { const bf16_t* pr = PROJ + (size_t)(row0 + ai * HALF + m * 16) * PW + col0;
#pragma unroll
                for (int bj = 0; bj < 2; ++bj) { gn[m][bj] = *(const u32x4*)(pr + num + bj * HALF); gd[m][bj] = *(const u32x4*)(pr + den + bj * HALF); } }
#pragma unroll
            for (int m = 0; m < 4; ++m)
#pragma unroll
                for (int bj = 0; bj < 2; ++bj)
#pragma unroll
                    for (int i = 0; i < 4; ++i) {
                        const float r0 = bf2f(gn[m][bj][i] & 0xffffu) * __builtin_amdgcn_rcpf(fmaxf(bf2f(gd[m][bj][i] & 0xffffu), 1e-30f));
                        const float r1 = bf2f(gn[m][bj][i] >> 16) * __builtin_amdgcn_rcpf(fmaxf(bf2f(gd[m][bj][i] >> 16), 1e-30f));
                        acc[ai][bj][m][i >> 1][(i & 1) * 2] *= r0; acc[ai][bj][m][i >> 1][(i & 1) * 2 + 1] *= r1; }
            asm volatile("" ::: "memory"); }
    }
    __device__ __forceinline__ void epi(Acc& acc, const Unit& u, int wr, int wc, int fr, int fq) const {
        const int row0 = u.pm * BM + wr * 64 + fr, col0 = u.pn * BM + wc * 32 + 8 * fq;
#pragma unroll
        for (int ai = 0; ai < 2; ++ai) {
            u32x4 gcv[4][2];
#pragma unroll
            for (int m = 0; m < 4; ++m)
#pragma unroll
                for (int bj = 0; bj < 2; ++bj) gcv[m][bj] = *(const u32x4*)(PROJ + (size_t)(row0 + ai * HALF + m * 16) * PW + GC + col0 + bj * HALF);
#pragma unroll
            for (int m = 0; m < 4; ++m) { const size_t row = (size_t)(row0 + ai * HALF + m * 16);
#pragma unroll
                for (int bj = 0; bj < 2; ++bj) { const u32x4 gc = gcv[m][bj];
                    const f32x4 v0 = acc[ai][bj][m][0], v1 = acc[ai][bj][m][1];
                    u32x4 w; w.x = cvt_pk_bf16(v0[0] * bf2f(gc.x & 0xffffu), v0[1] * bf2f(gc.x >> 16)); w.y = cvt_pk_bf16(v0[2] * bf2f(gc.y & 0xffffu), v0[3] * bf2f(gc.y >> 16));
                    w.z = cvt_pk_bf16(v1[0] * bf2f(gc.z & 0xffffu), v1[1] * bf2f(gc.z >> 16)); w.w = cvt_pk_bf16(v1[2] * bf2f(gc.w & 0xffffu), v1[3] * bf2f(gc.w >> 16));
                    *(u32x4*)(MERGED + row * D + col0 + bj * HALF) = w; } }
            asm volatile("" ::: "memory"); }
    }
};

struct GIn {
    static constexpr bool PERM = true, MID = false, GATHER = false; static constexpr int STAGGER = 0;
    TileOrder ord; const bf16_t* A; const bf16_t* Bt; bf16_t* PROJ; const float* qkg; float* kmean; int dry;
    __device__ __forceinline__ bool next(int i, Unit& u) const { return ord.next(i, u); }
    __device__ __forceinline__ int lda() const { return D; }
    __device__ __forceinline__ void gather_offs(int, const int (&)[2], const unsigned (&)[2], unsigned (&)[2][2]) const {}
    __device__ __forceinline__ const char* a_tile(const Unit& u) const { return (const char*)(A + (size_t)u.pm * BM * D); }
    __device__ __forceinline__ const char* b_tile(const Unit& u) const { return (const char*)(Bt + (size_t)u.pn * BM * KK); }
    __device__ __forceinline__ void mid(Acc&, const Unit&, int, int, int, int, int) const {}
    __device__ __forceinline__ void epi(Acc& acc, const Unit& u, int wr, int wc, int fr, int fq) const {
        const int c0 = u.pn * BM + wc * 64;
        int kind, gi = 0;
        if (c0 < 256) { kind = 1; gi = 0; } else if (c0 < 512) { kind = 2; gi = 1; } else if (c0 < 768) kind = 0;
        else if (c0 < 1280) { kind = 1; gi = 2; } else if (c0 < 1408) { kind = 2; gi = 3; } else if (c0 < 1536) kind = 0;
        else if (c0 < 1792) { kind = 1; gi = 4; } else if (c0 < 2048) { kind = 2; gi = 5; } else if (c0 < 2304) kind = 0; else kind = 3;
        const bool mk = (c0 >= MK && c0 < MV) && !dry;
        const int row0 = u.pm * BM + wr * 64 + fr;
        bf16_t* pbase = PROJ + (size_t)row0 * PW + c0 + 8 * fq;
        if (kind == 1 || kind == 2) {
            f32x4 gq[2][2]; f32x4 ks[2][2];
#pragma unroll
            for (int bj = 0; bj < 2; ++bj)
#pragma unroll
                for (int n = 0; n < 2; ++n) { gq[bj][n] = *(const f32x4*)(qkg + gi * 64 + 32 * bj + 8 * fq + 4 * n); ks[bj][n] = (f32x4){0.f, 0.f, 0.f, 0.f}; }
            const float post = (kind == 1) ? C2 : 1.0f;
#pragma unroll
            for (int ai = 0; ai < 2; ++ai)
#pragma unroll
                for (int m = 0; m < 4; ++m) {
                    float ss = 0.f;
#pragma unroll
                    for (int bj = 0; bj < 2; ++bj)
#pragma unroll
                        for (int n = 0; n < 2; ++n) { const f32x4 x = acc[ai][bj][m][n]; ss += (x[0] * x[0] + x[1] * x[1]) + (x[2] * x[2] + x[3] * x[3]); }
                    ss = sum_x32(sum_x16(ss));
                    const float r = rsqrtf(ss * (1.0f / 64.0f) + EPS) * post;
                    bf16_t* rowp = pbase + (size_t)(ai * HALF + m * 16) * PW;
#pragma unroll
                    for (int bj = 0; bj < 2; ++bj) { const f32x4 v0 = acc[ai][bj][m][0] * r * gq[bj][0], v1 = acc[ai][bj][m][1] * r * gq[bj][1];
                        u32x4 w; w.x = cvt_pk_bf16(v0[0], v0[1]); w.y = cvt_pk_bf16(v0[2], v0[3]); w.z = cvt_pk_bf16(v1[0], v1[1]); w.w = cvt_pk_bf16(v1[2], v1[3]);
                        *(u32x4*)(rowp + 32 * bj) = w;
                        if (mk) { ks[bj][0][0] += bf2f(w.x & 0xffffu); ks[bj][0][1] += bf2f(w.x >> 16); ks[bj][0][2] += bf2f(w.y & 0xffffu); ks[bj][0][3] += bf2f(w.y >> 16);
                                  ks[bj][1][0] += bf2f(w.z & 0xffffu); ks[bj][1][1] += bf2f(w.z >> 16); ks[bj][1][2] += bf2f(w.w & 0xffffu); ks[bj][1][3] += bf2f(w.w >> 16); } }
                    asm volatile("" ::: "memory");
                }
            if (mk) {
                float* km = kmean + (size_t)u.pm * 256 + wc * 64 + 8 * fq;
#pragma unroll
                for (int bj = 0; bj < 2; ++bj)
#pragma unroll
                    for (int n = 0; n < 2; ++n)
#pragma unroll
                        for (int i = 0; i < 4; ++i) { float v = ks[bj][n][i]; v = sum_row16(v);
                            if (fr == 0) atomicAdd(km + 32 * bj + 4 * n + i, v); }
            }
        } else if (kind == 3) {
#pragma unroll
            for (int ai = 0; ai < 2; ++ai)
#pragma unroll
                for (int m = 0; m < 4; ++m) { bf16_t* rowp = pbase + (size_t)(ai * HALF + m * 16) * PW;
#pragma unroll
                    for (int bj = 0; bj < 2; ++bj) { f32x4 v0, v1;
#pragma unroll
                        for (int i = 0; i < 4; ++i) { v0[i] = __builtin_amdgcn_rcpf(1.0f + __builtin_amdgcn_exp2f(acc[ai][bj][m][0][i])); v1[i] = __builtin_amdgcn_rcpf(1.0f + __builtin_amdgcn_exp2f(acc[ai][bj][m][1][i])); }
                        u32x4 w; w.x = cvt_pk_bf16(v0[0], v0[1]); w.y = cvt_pk_bf16(v0[2], v0[3]); w.z = cvt_pk_bf16(v1[0], v1[1]); w.w = cvt_pk_bf16(v1[2], v1[3]);
                        __builtin_nontemporal_store(w, (u32x4*)(rowp + 32 * bj)); }
                    asm volatile("" ::: "memory"); }
        } else {
#pragma unroll
            for (int ai = 0; ai < 2; ++ai)
#pragma unroll
                for (int m = 0; m < 4; ++m) { bf16_t* rowp = pbase + (size_t)(ai * HALF + m * 16) * PW;
#pragma unroll
                    for (int bj = 0; bj < 2; ++bj) { const f32x4 v0 = acc[ai][bj][m][0], v1 = acc[ai][bj][m][1];
                        u32x4 w; w.x = cvt_pk_bf16(v0[0], v0[1]); w.y = cvt_pk_bf16(v0[2], v0[3]); w.z = cvt_pk_bf16(v1[0], v1[1]); w.w = cvt_pk_bf16(v1[2], v1[3]);
                        *(u32x4*)(rowp + 32 * bj) = w; }
                    asm volatile("" ::: "memory"); }
        }
    }
};

constexpr int LDS_GTAB = LDS_CTL + 2048, GTAB_UNITS = 24;
__device__ __forceinline__ int moe_find(const LAS unsigned* LCn, int mg) { int e = 0;
#pragma unroll
    for (int st = 16; st >= 1; st >>= 1) e = ((int)LCn[LC_TPF + e + st] <= mg) ? e + st : e;
    return e; }
template <int NN>
__device__ __forceinline__ bool moe_unit(const volatile LAS unsigned* LCv, int c, int G, int i, Unit& u) {
    const LAS unsigned* LC = (const LAS unsigned*)LCv;
    const int W = G >> 3, x = c & 7, j = c >> 3;
    const int U = (int)LC[LC_TPF + NE] * NN, q = U >> 3, r = U & 7;
    const int start = (x < r) ? x * (q + 1) : r * (q + 1) + (x - r) * q, len = q + (x < r ? 1 : 0);
    const int li = i * W + j; if (li >= len) return false;
    const int L = (NN == 4) ? start + len - 1 - li : start + li, mgl = L / NN;
    const int e = moe_find(LC, mgl);
    const int t0 = (int)LC[LC_TPF + e], mte = (int)LC[LC_TPF + e + 1] - t0, idx = L - t0 * NN;
    const int nig = 8 * NN, gid = idx / nig, fm = gid * 8, gsz = (mte - fm) < 8 ? (mte - fm) : 8, rem = idx - gid * nig;
    u.pm = t0 + fm + rem % gsz; u.pn = rem / gsz; u.e = e; u.rb = u.pm * BM; return true;
}
struct GMoe1 {
    static constexpr bool PERM = true, MID = false, GATHER = true; static constexpr int STAGGER = 0;
    const volatile LAS unsigned* LC; const LAS unsigned short* gtab; const bf16_t* A; const bf16_t* Bt; const float* b1; bf16_t* A2; int c; int dry;
    __device__ __forceinline__ bool next(int i, Unit& u) const { if (i >= GTAB_UNITS) return false;
        const unsigned w = (unsigned)__builtin_amdgcn_readfirstlane((int)((const LAS unsigned*)LC)[LC_UT + i]); if (!(w >> 31)) return false;
        u.pm = (int)(w & 1023u); u.pn = (int)((w >> 10) & 7u); u.e = (int)((w >> 13) & 31u); u.rb = u.pm * BM; return true; }
    __device__ __forceinline__ int lda() const { return D; }
    __device__ __forceinline__ void gather_offs(int ui, const int (&R)[2], const unsigned (&voffA)[2], unsigned (&go)[2][2]) const {
#pragma unroll
        for (int h = 0; h < 2; ++h)
#pragma unroll
            for (int i = 0; i < 2; ++i) go[h][i] = (unsigned)gtab[ui * 256 + h * HALF + R[i]] * (unsigned)(D * 2) + voffA[i]; }
    __device__ __forceinline__ const char* a_tile(const Unit&) const { return (const char*)A; }
    __device__ __forceinline__ const char* b_tile(const Unit& u) const { return (const char*)(Bt + ((size_t)u.e * 2048 + (size_t)u.pn * BM) * KK); }
    __device__ __forceinline__ void mid(Acc&, const Unit&, int, int, int, int, int) const {}
    __device__ __forceinline__ void epi(Acc& acc, const Unit& u, int wr, int wc, int fr, int fq) const {
        const int row0 = u.rb + wr * 64 + fr, ucol = u.pn * BM + wc * 64 + 16 * fq, ocol = u.pn * (BM / 2) + wc * 32 + 8 * fq;
        const float* bp = b1 + (size_t)u.e * 2048 + ucol;
        const f32x4 bv00 = *(const f32x4*)(bp), bv01 = *(const f32x4*)(bp + 4), bv10 = *(const f32x4*)(bp + 8), bv11 = *(const f32x4*)(bp + 12);
#pragma unroll
        for (int ai = 0; ai < 2; ++ai)
#pragma unroll
            for (int m = 0; m < 4; ++m) { bf16_t* rowp = A2 + (size_t)(row0 + ai * HALF + m * 16) * D + ocol;
                u32x4 w;
#pragma unroll
                for (int bj = 0; bj < 2; ++bj) { const f32x4 v0 = acc[ai][bj][m][0] + (bj ? bv10 : bv00), v1 = acc[ai][bj][m][1] + (bj ? bv11 : bv01);
                    float o[4];
#pragma unroll
                    for (int q = 0; q < 4; ++q) { float gl = (q < 2) ? v0[2 * q] : v1[2 * q - 4], ln = (q < 2) ? v0[2 * q + 1] : v1[2 * q - 3];
                        gl = fminf(gl, 7.0f); ln = fminf(fmaxf(ln, -7.0f), 7.0f);
                        o[q] = gl * __builtin_amdgcn_rcpf(1.0f + __builtin_amdgcn_exp2f(gl * (-1.702f * LOG2E))) * (ln + 1.0f); }
                    if (bj == 0) { w.x = cvt_pk_bf16(o[0], o[1]); w.y = cvt_pk_bf16(o[2], o[3]); } else { w.z = cvt_pk_bf16(o[0], o[1]); w.w = cvt_pk_bf16(o[2], o[3]); } }
                *(u32x4*)rowp = w;
                asm volatile("" ::: "memory"); }
    }
};
struct GMoe2 {
    static constexpr bool PERM = true, MID = false, GATHER = false; static constexpr int STAGGER = 0;
    const volatile LAS unsigned* LC; const bf16_t* A; const bf16_t* Bt; const float* b2; const float* listw; bf16_t* Y; int c; int dry;
    __device__ __forceinline__ bool next(int i, Unit& u) const { if (i >= GTAB_UNITS) return false;
        const unsigned w = (unsigned)__builtin_amdgcn_readfirstlane((int)((const LAS unsigned*)LC)[LC_UT + i]); if (!(w >> 31)) return false;
        u.pm = (int)(w & 1023u); u.pn = (int)((w >> 10) & 7u); u.e = (int)((w >> 13) & 31u); u.rb = u.pm * BM; return true; }
    __device__ __forceinline__ int lda() const { return D; }
    __device__ __forceinline__ void gather_offs(int, const int (&)[2], const unsigned (&)[2], unsigned (&)[2][2]) const {}
    __device__ __forceinline__ const char* a_tile(const Unit& u) const { return (const char*)(A + (size_t)u.rb * D); }
    __device__ __forceinline__ const char* b_tile(const Unit& u) const { return (const char*)(Bt + ((size_t)u.e * D + (size_t)u.pn * BM) * KK); }
    __device__ __forceinline__ void mid(Acc&, const Unit&, int, int, int, int, int) const {}
    __device__ __forceinline__ void epi(Acc& acc, const Unit& u, int wr, int wc, int fr, int fq) const {
        const int row0 = u.rb + wr * 64 + fr, col0 = u.pn * BM + wc * 32 + 8 * fq;
        const int p0 = row0 - (int)LC[LC_TPF + u.e] * BM, cn = (int)LC[LC_CNT + u.e];
        const float* bp = b2 + (size_t)u.e * D + col0;
        float gw[2][4];
#pragma unroll
        for (int ai = 0; ai < 2; ++ai)
#pragma unroll
            for (int m = 0; m < 4; ++m) { const int pos = p0 + ai * HALF + m * 16; gw[ai][m] = (pos < cn) ? listw[(size_t)u.e * CAP + pos] : 0.f; }
        f32x4 bv[2][2];
#pragma unroll
        for (int bj = 0; bj < 2; ++bj)
#pragma unroll
            for (int n = 0; n < 2; ++n) bv[bj][n] = *(const f32x4*)(bp + bj * HALF + 4 * n);
#pragma unroll
        for (int ai = 0; ai < 2; ++ai)
#pragma unroll
            for (int m = 0; m < 4; ++m) { const float g = gw[ai][m];
                bf16_t* rowp = Y + (size_t)(row0 + ai * HALF + m * 16) * D + col0;
#pragma unroll
                for (int bj = 0; bj < 2; ++bj) { const f32x4 v0 = (acc[ai][bj][m][0] + bv[bj][0]) * g, v1 = (acc[ai][bj][m][1] + bv[bj][1]) * g;
                    u32x4 w; w.x = cvt_pk_bf16(v0[0], v0[1]); w.y = cvt_pk_bf16(v0[2], v0[3]); w.z = cvt_pk_bf16(v1[0], v1[1]); w.w = cvt_pk_bf16(v1[2], v1[3]);
                    *(u32x4*)(rowp + bj * HALF) = w; } }
    }
};
}

namespace at {
constexpr int L_K = 0, L_V = 24576, L_BIAS = 49152, L_SEL = 65536, L_GATE = 66560, L_RED = 84992, L_KM = 86016;
typedef short v4i16_t __attribute__((ext_vector_type(4)));
__device__ __forceinline__ int crow(int r, int hi) { return (r & 3) + 8 * (r >> 2) + 4 * hi; }
__device__ __forceinline__ float halves_max(float m) { auto rr = __builtin_amdgcn_permlane32_swap(__float_as_uint(m), __float_as_uint(m), false, false); return fmaxf(__uint_as_float(rr[0]), __uint_as_float(rr[1])); }
__device__ __forceinline__ float halves_sum(float m) { auto rr = __builtin_amdgcn_permlane32_swap(__float_as_uint(m), __float_as_uint(m), false, false); return __uint_as_float(rr[0]) + __uint_as_float(rr[1]); }
__device__ __forceinline__ unsigned cvtpk(float lo, float hi) { unsigned r; asm volatile("v_cvt_pk_bf16_f32 %0, %1, %2" : "=v"(r) : "v"(lo), "v"(hi)); return r; }

template <int VAR  >
__device__ __forceinline__ void attn_unit(LAS unsigned char* lds, int b, int h, int qb, const bf16_t* __restrict__ PROJ, const float* __restrict__ lf, const float* __restrict__ kmean, const float* __restrict__ sinks, bf16_t* __restrict__ OCAT, int wv, const float* __restrict__ qkg = nullptr) {
    const int w = wv, lane = opaque(lane_id()), tid = w * 64 + lane, r32 = lane & 31, hi = lane >> 5;
    const int q0 = qb * 256, n_keys = q0 + 256;
    int qoff, koff, voff, ooff; float slope2 = 0.f;
    if (VAR == 0) { qoff = FQ + h * 64; koff = FK + h * 64; voff = FV + h * 64; ooff = h * 64; }
    else if (VAR == 1) { qoff = SQ + h * 64; koff = SK + (h >> 2) * 64; voff = SV + (h >> 2) * 64; ooff = 256 + h * 64; slope2 = alibi_slope(h) * LOG2E; }
    else { qoff = MQ + h * 64; koff = MK + h * 64; voff = MV + h * 64; ooff = 768 + h * 64; slope2 = alibi_slope(8 + h) * LOG2E; }
    const bf16_t* base = PROJ + (size_t)b * S * PW;
    LAS float* biasT = (LAS float*)(lds + L_BIAS);
    LAS float* red = (LAS float*)(lds + L_RED);
    int t_lo = (VAR == 1) ? (qb > 0 ? 4 * qb - 2 : 0) : 0; const int t_hi = 4 * qb + 4;
    if (VAR == 0) {
        float c8[8]; const int s0 = 8 * tid;
        if (s0 < n_keys) { const f32x4 a = *(const f32x4*)(lf + (size_t)(b * 4 + h) * S + s0), c = *(const f32x4*)(lf + (size_t)(b * 4 + h) * S + s0 + 4);
            c8[0] = a[0]; c8[1] = c8[0] + a[1]; c8[2] = c8[1] + a[2]; c8[3] = c8[2] + a[3]; c8[4] = c8[3] + c[0]; c8[5] = c8[4] + c[1]; c8[6] = c8[5] + c[2]; c8[7] = c8[6] + c[3]; }
        else {
#pragma unroll
            for (int i = 0; i < 8; ++i) c8[i] = 0.f; }
        float incl = c8[7];
#pragma unroll
        for (int o = 1; o < 64; o <<= 1) { const float v = __int_as_float(__builtin_amdgcn_ds_bpermute((lane - o) << 2, __float_as_int(incl))); if (lane >= o) incl += v; }
        if (lane == 63) red[w] = incl;
        __syncthreads();
        float wp = 0.f;
#pragma unroll
        for (int i = 0; i < 8; ++i) wp += (i < w) ? red[i] : 0.f;
        const float offs = wp + incl - c8[7];
#pragma unroll
        for (int i = 0; i < 8; ++i) c8[i] += offs;
        if (s0 == q0) red[15] = c8[0];
        if (tid == 0) ((LAS int*)red)[14] = 1 << 20;
        __syncthreads();
        const float cref = red[15];
        if (s0 < n_keys) { *(LAS f32x4*)(biasT + s0) = (f32x4){(cref - c8[0]) * LOG2E, (cref - c8[1]) * LOG2E, (cref - c8[2]) * LOG2E, (cref - c8[3]) * LOG2E};
                           *(LAS f32x4*)(biasT + s0 + 4) = (f32x4){(cref - c8[4]) * LOG2E, (cref - c8[5]) * LOG2E, (cref - c8[6]) * LOG2E, (cref - c8[7]) * LOG2E}; }
        { float gq = fabsf(qkg[lane]), gk = fabsf(qkg[64 + lane]);
#pragma unroll
          for (int o = 0; o < 6; ++o) { gq = fmaxf(gq, __int_as_float(__builtin_amdgcn_ds_bpermute((lane ^ (1 << o)) << 2, __float_as_int(gq)))); gk = fmaxf(gk, __int_as_float(__builtin_amdgcn_ds_bpermute((lane ^ (1 << o)) << 2, __float_as_int(gk)))); }
          const float thr = 2.0f * (64.0f * C2 * 1.02f) * gq * gk + 64.0f;
          if ((tid & 7) == 7 && s0 < n_keys && (cref - c8[7]) * LOG2E >= -thr) atomicMin((int*)((LAS int*)red + 14), tid >> 3); }
        __syncthreads();
        t_lo = ((LAS int*)red)[14] & ~1;
    } else {
        for (int s = 64 * t_lo + tid; s < n_keys; s += NTHR) biasT[s] = slope2 * (float)(s - q0);
    }
    unsigned selmask = 0u;
    if (VAR == 2 && qb > 0) {
        LAS float* gate = (LAS float*)(lds + L_GATE);
        LAS float* kmL = (LAS float*)(lds + L_KM);
        if (tid < qb * 16) *(LAS f32x4*)(kmL + 4 * tid) = *(const f32x4*)(kmean + (size_t)(b * 16 + (tid >> 4)) * 256 + h * 64 + 4 * (tid & 15));
        { const int q = (w & 3) * 64 + lane, half = w >> 2;
          float qf[64];
          const u32x4* qp = (const u32x4*)(base + (size_t)(q0 + q) * PW + qoff);
#pragma unroll
          for (int c = 0; c < 8; ++c) { const u32x4 x = qp[c];
#pragma unroll
              for (int i = 0; i < 4; ++i) { qf[8 * c + 2 * i] = bf2f(x[i] & 0xffffu); qf[8 * c + 2 * i + 1] = bf2f(x[i] >> 16); } }
          __syncthreads();
          for (int j = half; j < qb; j += 2) { const LAS f32x4* km = (const LAS f32x4*)(kmL + j * 64); float a = 0.f;
#pragma unroll
              for (int d4 = 0; d4 < 16; ++d4) { const f32x4 kv = km[d4]; a += qf[4 * d4] * kv[0]; a += qf[4 * d4 + 1] * kv[1]; a += qf[4 * d4 + 2] * kv[2]; a += qf[4 * d4 + 3] * kv[3]; }
              gate[q * 17 + j] = a; } }
        __syncthreads();
        if (tid < 256) { const int nsel = qb < 3 ? qb : 3; unsigned mask = 0u;
            for (int kk = 0; kk < nsel; ++kk) { int bi = 0; float bv = -INFINITY;
                for (int j = 0; j < qb; ++j) { const float a = gate[tid * 17 + j]; if (!((mask >> j) & 1u) && a > bv) { bv = a; bi = j; } }
                mask |= 1u << bi; }
            ((LAS unsigned*)(lds + L_SEL))[tid] = mask; }
        __syncthreads();
        selmask = ((LAS unsigned*)(lds + L_SEL))[32 * w + r32];
    }
    const int qa = q0 + 32 * w + r32;
    bf16x8 qr[4];
#pragma unroll
    for (int d0 = 0; d0 < 4; ++d0) qr[d0] = *(const bf16x8*)(base + (size_t)qa * PW + qoff + 16 * d0 + 8 * hi);
    const bf16_t* kg = base + (size_t)lane * PW + koff + w * 8;
    const bf16_t* vg = base + (size_t)(16 * (w & 3) + (lane >> 2)) * PW + voff + (w >> 2) * 32 + (lane & 3) * 8;
    const int kdst = L_K + w * 1024 + lane * 16, vdst = L_V + (w >> 2) * 4096 + (16 * (w & 3) + (lane >> 2)) * 64 + (lane & 3) * 16;
    const int kfr = L_K + hi * 1024 + r32 * 16;
    const int vfr = L_V + ((lane >> 4) & 1) * 32 + (lane & 3) * 8 + (4 * hi + ((lane & 15) >> 2)) * 64;
    const int qlo = q0 + 32 * w, qhi = qlo + 31;
    u32x4 kreg, vreg;
    kreg = *(const u32x4*)(kg + (size_t)(64 * t_lo) * PW); vreg = *(const u32x4*)(vg + (size_t)(64 * t_lo) * PW);
    *(LAS u32x4*)(lds + kdst) = kreg; *(LAS u32x4*)(lds + vdst) = vreg;
    kreg = *(const u32x4*)(kg + (size_t)(64 * t_lo + 64) * PW); vreg = *(const u32x4*)(vg + (size_t)(64 * t_lo + 64) * PW);
    *(LAS u32x4*)(lds + 8192 + kdst) = kreg; *(LAS u32x4*)(lds + 8192 + vdst) = vreg;
    __syncthreads();
    f32x16 o0 = {}, o1 = {};
    float m = -1e30f, l = 0.f;
#define AT_MODE(MD, JT) do { const int kv0_ = 64 * (JT); \
        if (VAR == 0) MD = (kv0_ > qhi) ? 0 : (kv0_ + 63 <= qlo ? 1 : 2); \
        else if (VAR == 1) MD = (kv0_ > qhi || kv0_ + 63 < qlo - 127) ? 0 : ((kv0_ + 63 <= qlo && kv0_ >= qhi - 127) ? 1 : 2); \
        else { const int jb_ = kv0_ >> 8; \
            if (jb_ < qb) { const unsigned long long bal_ = __ballot((selmask >> jb_) & 1u); MD = (bal_ == 0ull) ? 0 : (bal_ == ~0ull ? 1 : 2); } \
            else MD = (kv0_ > qhi) ? 0 : (kv0_ + 63 <= qlo ? 1 : 2); } } while (0)
#define AT_QK_LOAD(P0, P1, KF, JT, SL) do { const int kv0_ = 64 * (JT); \
        _Pragma("unroll") for (int g = 0; g < 4; ++g) { const f32x4 x0 = *(const LAS f32x4*)(biasT + kv0_ + 8 * g + 4 * hi), x1 = *(const LAS f32x4*)(biasT + kv0_ + 32 + 8 * g + 4 * hi); \
            _Pragma("unroll") for (int i = 0; i < 4; ++i) { P0[4 * g + i] = x0[i]; P1[4 * g + i] = x1[i]; } } \
        _Pragma("unroll") for (int d0 = 0; d0 < 4; ++d0) { KF[2 * d0] = *(const LAS bf16x8*)(lds + (SL) + kfr + d0 * 2048); KF[2 * d0 + 1] = *(const LAS bf16x8*)(lds + (SL) + kfr + d0 * 2048 + 512); } } while (0)
#define AT_QK_MMA(P0, P1, KF) do { \
        _Pragma("unroll") for (int d0 = 0; d0 < 4; ++d0) { P0 = __builtin_amdgcn_mfma_f32_32x32x16_bf16(KF[2 * d0], qr[d0], P0, 0, 0, 0); P1 = __builtin_amdgcn_mfma_f32_32x32x16_bf16(KF[2 * d0 + 1], qr[d0], P1, 0, 0, 0); } } while (0)
#define AT_STEP(PC0, PC1, MC, PN0, PN1, MN, JT, SC, SN, SNN) do { \
        const int kv0 = 64 * (JT); const bool more2 = (JT) + 2 < t_hi; \
        if (more2) { kreg = *(const u32x4*)(kg + (size_t)(kv0 + 128) * PW); vreg = *(const u32x4*)(vg + (size_t)(kv0 + 128) * PW); } \
        MN = 0; if ((JT) + 1 < t_hi) AT_MODE(MN, (JT) + 1); \
        float alpha = 1.0f, mn = m; \
        if (MC != 0) { \
            if (MC == 2) { \
                if (VAR == 2 && (kv0 >> 8) < qb) { if (!((selmask >> (kv0 >> 8)) & 1u)) { _Pragma("unroll") for (int r = 0; r < 16; ++r) { PC0[r] = -INFINITY; PC1[r] = -INFINITY; } } } \
                else { _Pragma("unroll") for (int r = 0; r < 16; ++r) { const int kv = kv0 + crow(r, hi); bool bad0 = kv > qa, bad1 = kv + 32 > qa; \
                        if (VAR == 1) { bad0 = bad0 || kv < qa - 127; bad1 = bad1 || kv + 32 < qa - 127; } \
                        PC0[r] = bad0 ? -INFINITY : PC0[r]; PC1[r] = bad1 ? -INFINITY : PC1[r]; } } } \
            float mxa = __builtin_fmaxf(__builtin_fmaxf(PC0[0], PC0[1]), PC0[2]), mxb = __builtin_fmaxf(__builtin_fmaxf(PC1[0], PC1[1]), PC1[2]);     \
            mxa = __builtin_fmaxf(__builtin_fmaxf(mxa, PC0[3]), PC1[3]); \
            _Pragma("unroll") for (int r = 4; r < 16; r += 2) { mxa = __builtin_fmaxf(__builtin_fmaxf(mxa, PC0[r]), PC0[r + 1]); mxb = __builtin_fmaxf(__builtin_fmaxf(mxb, PC1[r]), PC1[r + 1]); } \
            float mx = halves_max(__builtin_fmaxf(mxa, mxb)); \
            mn = (mx > m + 8.0f) ? mx : m;        \
            if (__any(mn != m)) alpha = __builtin_amdgcn_exp2f(m - mn); \
            m = mn; } \
        __builtin_amdgcn_sched_barrier(0); \
        if ((JT) + 1 < t_hi) { bf16x8 kf[8]; AT_QK_LOAD(PN0, PN1, kf, (JT) + 1, SN); AT_QK_MMA(PN0, PN1, kf); }     \
        __builtin_amdgcn_sched_barrier(0); \
        if (MC != 0) { \
            float rs = 0.f; \
            _Pragma("unroll") for (int r = 0; r < 16; ++r) { PC0[r] = __builtin_amdgcn_exp2f(PC0[r] - mn); PC1[r] = __builtin_amdgcn_exp2f(PC1[r] - mn); rs += PC0[r] + PC1[r]; } \
            l = l * alpha + rs; \
            if (__any(alpha != 1.0f)) { _Pragma("unroll") for (int r = 0; r < 16; ++r) { o0[r] *= alpha; o1[r] *= alpha; } } \
            u32x4 pw[4]; \
            _Pragma("unroll") for (int i = 0; i < 4; ++i) { pw[0][i] = cvtpk(PC0[2 * i], PC0[2 * i + 1]); pw[1][i] = cvtpk(PC0[8 + 2 * i], PC0[8 + 2 * i + 1]); pw[2][i] = cvtpk(PC1[2 * i], PC1[2 * i + 1]); pw[3][i] = cvtpk(PC1[8 + 2 * i], PC1[8 + 2 * i + 1]); } \
            _Pragma("unroll") for (int ks = 0; ks < 4; ++ks) { \
                const bf16x8 pb = __builtin_bit_cast(bf16x8, pw[ks]); \
                const v4i16_t a0 = __builtin_amdgcn_ds_read_tr16_b64_v4i16((LAS v4i16_t*)(lds + (SC) + vfr + ks * 1024)), a1 = __builtin_amdgcn_ds_read_tr16_b64_v4i16((LAS v4i16_t*)(lds + (SC) + vfr + ks * 1024 + 512)); \
                const v4i16_t c0 = __builtin_amdgcn_ds_read_tr16_b64_v4i16((LAS v4i16_t*)(lds + (SC) + vfr + 4096 + ks * 1024)), c1 = __builtin_amdgcn_ds_read_tr16_b64_v4i16((LAS v4i16_t*)(lds + (SC) + vfr + 4096 + ks * 1024 + 512)); \
                const bf16x8 v0 = (bf16x8){a0[0], a0[1], a0[2], a0[3], a1[0], a1[1], a1[2], a1[3]}, v1 = (bf16x8){c0[0], c0[1], c0[2], c0[3], c1[0], c1[1], c1[2], c1[3]}; \
                o0 = __builtin_amdgcn_mfma_f32_32x32x16_bf16(v0, pb, o0, 0, 0, 0); \
                o1 = __builtin_amdgcn_mfma_f32_32x32x16_bf16(v1, pb, o1, 0, 0, 0); } } \
        if (more2) { *(LAS u32x4*)(lds + (SNN) + kdst) = kreg; *(LAS u32x4*)(lds + (SNN) + vdst) = vreg; } \
        __syncthreads(); } while (0)
    f32x16 pA0, pA1, pB0, pB1; int mA = 0, mB = 0;
    AT_MODE(mA, t_lo);
    { bf16x8 kf0[8]; AT_QK_LOAD(pA0, pA1, kf0, t_lo, 0); AT_QK_MMA(pA0, pA1, kf0); }
    int s0 = 0, s1 = 8192, s2 = 16384;
#pragma unroll 1
    for (int jt = t_lo; jt < t_hi; jt += 2) {
        AT_STEP(pA0, pA1, mA, pB0, pB1, mB, jt, s0, s1, s2);
        AT_STEP(pB0, pB1, mB, pA0, pA1, mA, jt + 1, s1, s2, s0);
        { const int t_ = s0; s0 = s2; s2 = s1; s1 = t_; }
    }
#undef AT_MODE
#undef AT_QK_LOAD
#undef AT_QK_MMA
#undef AT_STEP
    float lt = halves_sum(l);
    if (VAR == 1) lt += __builtin_amdgcn_exp2f(sinks[h] * LOG2E - (m - slope2 * (float)(qa - q0)));
    const float inv = 1.0f / lt;
    bf16_t* op = OCAT + (size_t)(b * S + qa) * D + ooff + 4 * hi;
#pragma unroll
    for (int g = 0; g < 4; ++g) {
        u32x2 w0; w0.x = cvtpk(o0[4 * g] * inv, o0[4 * g + 1] * inv); w0.y = cvtpk(o0[4 * g + 2] * inv, o0[4 * g + 3] * inv); *(u32x2*)(op + 8 * g) = w0;
        u32x2 w1; w1.x = cvtpk(o1[4 * g] * inv, o1[4 * g + 1] * inv); w1.y = cvtpk(o1[4 * g + 2] * inv, o1[4 * g + 3] * inv); *(u32x2*)(op + 32 + 8 * g) = w1; }
}

__device__ __forceinline__ void swa_unit(LAS unsigned char* lds, int b, int hkv, int qb, const bf16_t* __restrict__ PROJ, const float* __restrict__ sinks, bf16_t* __restrict__ OCAT, int wv) {
    const int w = wv, lane = opaque(lane_id()), r32 = lane & 31, hi = lane >> 5;
    const int q0 = qb * 256, tb = (qb > 0) ? 4 * qb - 2 : 0, nt = 4 * qb + 4 - tb;
    constexpr int SW_K = 0, SW_V = 49152;
    const bf16_t* base = PROJ + (size_t)b * S * PW;
    { const bf16_t* kg = base + (size_t)lane * PW + SK + hkv * 64 + w * 8;
      const bf16_t* vg = base + (size_t)(16 * (w & 3) + (lane >> 2)) * PW + SV + hkv * 64 + (w >> 2) * 32 + (lane & 3) * 8;
      const int kdst = SW_K + w * 1024 + lane * 16, vdst = SW_V + (w >> 2) * 4096 + (16 * (w & 3) + (lane >> 2)) * 64 + (lane & 3) * 16;
#pragma unroll
      for (int i0 = 0; i0 < 6; i0 += 3) { u32x4 kr[3], vr[3];
#pragma unroll
          for (int i = 0; i < 3; ++i) if (i0 + i < nt) { kr[i] = *(const u32x4*)(kg + (size_t)(64 * (tb + i0 + i)) * PW); vr[i] = *(const u32x4*)(vg + (size_t)(64 * (tb + i0 + i)) * PW); }
#pragma unroll
          for (int i = 0; i < 3; ++i) if (i0 + i < nt) { *(LAS u32x4*)(lds + (i0 + i) * 8192 + kdst) = kr[i]; *(LAS u32x4*)(lds + (i0 + i) * 8192 + vdst) = vr[i]; } } }
    __syncthreads();
    const int h = hkv * 4 + (w >> 1);
    const float slope2 = alibi_slope(h) * LOG2E, sink2 = sinks[h] * LOG2E;
    const int kfr = SW_K + hi * 1024 + r32 * 16;
    const int vfr = SW_V + ((lane >> 4) & 1) * 32 + (lane & 3) * 8 + (4 * hi + ((lane & 15) >> 2)) * 64;
#pragma unroll 1
    for (int st = 0; st < 4; ++st) {
        const int r0 = q0 + (w & 1) * 128 + st * 32, qa = r0 + r32;
        bf16x8 qr[4];
#pragma unroll
        for (int d0 = 0; d0 < 4; ++d0) qr[d0] = *(const bf16x8*)(base + (size_t)qa * PW + SQ + h * 64 + 16 * d0 + 8 * hi);
        f32x16 o0 = {}, o1 = {}; float m = -1e30f, l = 0.f;
        const int t0 = (r0 - 127) >> 6;
#pragma unroll 1
        for (int jt = (t0 > tb ? t0 : tb); jt <= (r0 >> 6); ++jt) {
            const int kv0 = 64 * jt, slot = (jt - tb) * 8192;
            f32x16 p0, p1;
#pragma unroll
            for (int r = 0; r < 16; ++r) { const float bb = slope2 * (float)(kv0 + crow(r, hi) - q0); p0[r] = bb; p1[r] = bb + 32.0f * slope2; }
#pragma unroll
            for (int d0 = 0; d0 < 4; ++d0) {
                const bf16x8 k0 = *(const LAS bf16x8*)(lds + slot + kfr + d0 * 2048), k1 = *(const LAS bf16x8*)(lds + slot + kfr + d0 * 2048 + 512);
                p0 = __builtin_amdgcn_mfma_f32_32x32x16_bf16(k0, qr[d0], p0, 0, 0, 0);
                p1 = __builtin_amdgcn_mfma_f32_32x32x16_bf16(k1, qr[d0], p1, 0, 0, 0); }
            if (!(kv0 + 63 <= r0 && kv0 >= r0 + 31 - 127)) {
#pragma unroll
                for (int r = 0; r < 16; ++r) { const int kv = kv0 + crow(r, hi);
                    p0[r] = (kv > qa || kv < qa - 127) ? -INFINITY : p0[r]; p1[r] = (kv + 32 > qa || kv + 32 < qa - 127) ? -INFINITY : p1[r]; } }
            float mx = fmaxf(p0[0], p1[0]);
#pragma unroll
            for (int r = 1; r < 16; ++r) mx = fmaxf(mx, fmaxf(p0[r], p1[r]));
            mx = halves_max(mx);
            const float mn = (mx > m + 8.0f) ? mx : m; float alpha = 1.0f;
            if (__any(mn != m)) alpha = __builtin_amdgcn_exp2f(m - mn);
            m = mn;
            float rs = 0.f;
#pragma unroll
            for (int r = 0; r < 16; ++r) { p0[r] = __builtin_amdgcn_exp2f(p0[r] - mn); p1[r] = __builtin_amdgcn_exp2f(p1[r] - mn); rs += p0[r] + p1[r]; }
            l = l * alpha + rs;
            if (__any(alpha != 1.0f)) {
#pragma unroll
                for (int r = 0; r < 16; ++r) { o0[r] *= alpha; o1[r] *= alpha; } }
            u32x4 pw[4];
#pragma unroll
            for (int i = 0; i < 4; ++i) { pw[0][i] = cvtpk(p0[2 * i], p0[2 * i + 1]); pw[1][i] = cvtpk(p0[8 + 2 * i], p0[8 + 2 * i + 1]); pw[2][i] = cvtpk(p1[2 * i], p1[2 * i + 1]); pw[3][i] = cvtpk(p1[8 + 2 * i], p1[8 + 2 * i + 1]); }
#pragma unroll
            for (int ks = 0; ks < 4; ++ks) {
                const bf16x8 pb = __builtin_bit_cast(bf16x8, pw[ks]);
                const v4i16_t a0 = __builtin_amdgcn_ds_read_tr16_b64_v4i16((LAS v4i16_t*)(lds + slot + vfr + ks * 1024)), a1 = __builtin_amdgcn_ds_read_tr16_b64_v4i16((LAS v4i16_t*)(lds + slot + vfr + ks * 1024 + 512));
                const v4i16_t c0 = __builtin_amdgcn_ds_read_tr16_b64_v4i16((LAS v4i16_t*)(lds + slot + vfr + 4096 + ks * 1024)), c1 = __builtin_amdgcn_ds_read_tr16_b64_v4i16((LAS v4i16_t*)(lds + slot + vfr + 4096 + ks * 1024 + 512));
                const bf16x8 v0 = (bf16x8){a0[0], a0[1], a0[2], a0[3], a1[0], a1[1], a1[2], a1[3]}, v1 = (bf16x8){c0[0], c0[1], c0[2], c0[3], c1[0], c1[1], c1[2], c1[3]};
                o0 = __builtin_amdgcn_mfma_f32_32x32x16_bf16(v0, pb, o0, 0, 0, 0);
                o1 = __builtin_amdgcn_mfma_f32_32x32x16_bf16(v1, pb, o1, 0, 0, 0); }
        }
        float lt = halves_sum(l);
        lt += __builtin_amdgcn_exp2f(sink2 - (m - slope2 * (float)(qa - q0)));
        const float inv = 1.0f / lt;
        bf16_t* op = OCAT + (size_t)(b * S + qa) * D + 256 + h * 64 + 4 * hi;
#pragma unroll
        for (int g = 0; g < 4; ++g) {
            u32x2 w0; w0.x = cvtpk(o0[4 * g] * inv, o0[4 * g + 1] * inv); w0.y = cvtpk(o0[4 * g + 2] * inv, o0[4 * g + 3] * inv); *(u32x2*)(op + 8 * g) = w0;
            u32x2 w1; w1.x = cvtpk(o1[4 * g] * inv, o1[4 * g + 1] * inv); w1.y = cvtpk(o1[4 * g + 2] * inv, o1[4 * g + 3] * inv); *(u32x2*)(op + 32 + 8 * g) = w1; }
    }
    __syncthreads();
}

constexpr int MB_CNT = 256, MB_TP = 320, MB_UT = 384;
constexpr int MS_CNT = 90112, MS_BASE = 90176;
__device__ __forceinline__ void moba_select(LAS unsigned char* lds, int b, int h, int qb, const bf16_t* __restrict__ PROJ, const float* __restrict__ kmean, unsigned short* __restrict__ msel, unsigned short* __restrict__ mlist, int* __restrict__ mcnt, int wv) {
    const int w = wv, lane = opaque(lane_id()), tid = w * 64 + lane, q0 = qb * 256, bh = b * 4 + h;
    if (qb == 0) { if (tid < 256) msel[(size_t)bh * S + tid] = 0; return; }
    const bf16_t* base = PROJ + (size_t)b * S * PW;
    LAS float* gate = (LAS float*)(lds + L_GATE); LAS float* kmL = (LAS float*)(lds + L_KM);
    LAS int* lcnt = (LAS int*)(lds + MS_CNT); LAS int* lbase = (LAS int*)(lds + MS_BASE);
    if (tid < qb * 16) *(LAS f32x4*)(kmL + 4 * tid) = *(const f32x4*)(kmean + (size_t)(b * 16 + (tid >> 4)) * 256 + h * 64 + 4 * (tid & 15));
    if (tid < 16) lcnt[tid] = 0;
    { const int q = (w & 3) * 64 + lane, half = w >> 2;
      float qf[64];
      const u32x4* qp = (const u32x4*)(base + (size_t)(q0 + q) * PW + MQ + h * 64);
#pragma unroll
      for (int c = 0; c < 8; ++c) { const u32x4 x = qp[c];
#pragma unroll
          for (int i = 0; i < 4; ++i) { qf[8 * c + 2 * i] = bf2f(x[i] & 0xffffu); qf[8 * c + 2 * i + 1] = bf2f(x[i] >> 16); } }
      __syncthreads();
      for (int j = half; j < qb; j += 2) { const LAS f32x4* km = (const LAS f32x4*)(kmL + j * 64); float a = 0.f;
#pragma unroll
          for (int d4 = 0; d4 < 16; ++d4) { const f32x4 kv = km[d4]; a += qf[4 * d4] * kv[0]; a += qf[4 * d4 + 1] * kv[1]; a += qf[4 * d4 + 2] * kv[2]; a += qf[4 * d4 + 3] * kv[3]; }
          gate[q * 17 + j] = a; } }
    __syncthreads();
    unsigned mask = 0u; int sj[3] = {0, 0, 0}, sp[3] = {0, 0, 0}; const int nsel = qb < 3 ? qb : 3;
    if (tid < 256) {
        for (int kk = 0; kk < nsel; ++kk) { int bi = 0; float bv = -INFINITY;
            for (int j = 0; j < qb; ++j) { const float a = gate[tid * 17 + j]; if (!((mask >> j) & 1u) && a > bv) { bv = a; bi = j; } }
            mask |= 1u << bi; sj[kk] = bi; sp[kk] = atomicAdd((int*)(lcnt + bi), 1); } }
    __syncthreads();
    if (tid < 16) { const int c = lcnt[tid]; lbase[tid] = (c > 0) ? atomicAdd(mcnt + bh * 16 + tid, c) : 0; }
    __syncthreads();
    if (tid < 256) { msel[(size_t)bh * S + q0 + tid] = (unsigned short)mask;
        for (int kk = 0; kk < nsel; ++kk) mlist[((size_t)bh * 16 + sj[kk]) * MLCAP + lbase[sj[kk]] + sp[kk]] = (unsigned short)(q0 + tid); }
    __syncthreads();
}
template <bool OWN>
__device__ __forceinline__ void moba_block(LAS unsigned char* lds_, int ldsoff, int grp, bool standalone, int b, int h, int jb, int chunk, int n, const bf16_t* __restrict__ PROJ, const unsigned short* __restrict__ msel, const unsigned short* __restrict__ mlist,
                                           bf16_t* __restrict__ mpo, float* __restrict__ mpml, bf16_t* __restrict__ OCAT, int wv) {
    LAS unsigned char* lds = lds_ + ldsoff;
    const int w = wv, lane = opaque(lane_id()), tid = w * 64 + lane, r32 = lane & 31, hi = lane >> 5, bh = b * 4 + h;
    constexpr int MK_K = 0, MK_V = 32768, MK_TOK = 65536;
    const bf16_t* base = PROJ + (size_t)b * S * PW;
    const int tb = 4 * jb;
    if (standalone) { const bf16_t* kg = base + (size_t)lane * PW + MK + h * 64 + w * 8;
      const bf16_t* vg = base + (size_t)(16 * (w & 3) + (lane >> 2)) * PW + MV + h * 64 + (w >> 2) * 32 + (lane & 3) * 8;
      const int kdst = MK_K + w * 1024 + lane * 16, vdst = MK_V + (w >> 2) * 4096 + (16 * (w & 3) + (lane >> 2)) * 64 + (lane & 3) * 16;
      u32x4 kr[4], vr[4];
#pragma unroll
      for (int i = 0; i < 4; ++i) { kr[i] = *(const u32x4*)(kg + (size_t)(64 * (tb + i)) * PW); vr[i] = *(const u32x4*)(vg + (size_t)(64 * (tb + i)) * PW); }
      if (!OWN && tid < 256) { int p = chunk * 256 + tid; p = p < n ? p : n - 1; ((LAS unsigned short*)(lds + MK_TOK))[tid] = mlist[((size_t)bh * 16 + jb) * MLCAP + p]; }
#pragma unroll
      for (int i = 0; i < 4; ++i) { *(LAS u32x4*)(lds + i * 8192 + kdst) = kr[i]; *(LAS u32x4*)(lds + i * 8192 + vdst) = vr[i]; }
      __syncthreads(); }
    const float slope2 = alibi_slope(8 + h) * LOG2E;
    const int kfr = MK_K + hi * 1024 + r32 * 16;
    const int vfr = MK_V + ((lane >> 4) & 1) * 32 + (lane & 3) * 8 + (4 * hi + ((lane & 15) >> 2)) * 64;
    const int r0 = jb * 256 + 32 * grp;
    const int qa = OWN ? r0 + r32 : (int)((const LAS unsigned short*)(lds + MK_TOK))[32 * grp + r32];
    const bool valid = OWN || (chunk * 256 + 32 * grp + r32 < n);
    bf16x8 qr[4];
#pragma unroll
    for (int d0 = 0; d0 < 4; ++d0) qr[d0] = *(const bf16x8*)(base + (size_t)qa * PW + MQ + h * 64 + 16 * d0 + 8 * hi);
    f32x16 o0 = {}, o1 = {}; float m = -1e30f, l = 0.f;
#pragma unroll 1
    for (int jt = 0; jt < 4; ++jt) {
        const int kv0 = 64 * (tb + jt), slot = jt * 8192;
        if (OWN && kv0 > r0 + 31) break;
        f32x16 p0, p1;
#pragma unroll
        for (int r = 0; r < 16; ++r) { const float bb = slope2 * (float)(kv0 + crow(r, hi)); p0[r] = bb; p1[r] = bb + 32.0f * slope2; }
#pragma unroll
        for (int d0 = 0; d0 < 4; ++d0) {
            const bf16x8 k0 = *(const LAS bf16x8*)(lds + slot + kfr + d0 * 2048), k1 = *(const LAS bf16x8*)(lds + slot + kfr + d0 * 2048 + 512);
            p0 = __builtin_amdgcn_mfma_f32_32x32x16_bf16(k0, qr[d0], p0, 0, 0, 0);
            p1 = __builtin_amdgcn_mfma_f32_32x32x16_bf16(k1, qr[d0], p1, 0, 0, 0); }
        if (OWN && !(kv0 + 63 <= r0)) {
#pragma unroll
            for (int r = 0; r < 16; ++r) { const int kv = kv0 + crow(r, hi); p0[r] = (kv > qa) ? -INFINITY : p0[r]; p1[r] = (kv + 32 > qa) ? -INFINITY : p1[r]; } }
        float mx = fmaxf(p0[0], p1[0]);
#pragma unroll
        for (int r = 1; r < 16; ++r) mx = fmaxf(mx, fmaxf(p0[r], p1[r]));
        mx = halves_max(mx);
        const float mn = (mx > m + 8.0f) ? mx : m; float alpha = 1.0f;
        if (__any(mn != m)) alpha = __builtin_amdgcn_exp2f(m - mn);
        m = mn;
        float rs = 0.f;
#pragma unroll
        for (int r = 0; r < 16; ++r) { p0[r] = __builtin_amdgcn_exp2f(p0[r] - mn); p1[r] = __builtin_amdgcn_exp2f(p1[r] - mn); rs += p0[r] + p1[r]; }
        l = l * alpha + rs;
        if (__any(alpha != 1.0f)) {
#pragma unroll
            for (int r = 0; r < 16; ++r) { o0[r] *= alpha; o1[r] *= alpha; } }
        u32x4 pw[4];
#pragma unroll
        for (int i = 0; i < 4; ++i) { pw[0][i] = cvtpk(p0[2 * i], p0[2 * i + 1]); pw[1][i] = cvtpk(p0[8 + 2 * i], p0[8 + 2 * i + 1]); pw[2][i] = cvtpk(p1[2 * i], p1[2 * i + 1]); pw[3][i] = cvtpk(p1[8 + 2 * i], p1[8 + 2 * i + 1]); }
#pragma unroll
        for (int ks = 0; ks < 4; ++ks) {
            const bf16x8 pb = __builtin_bit_cast(bf16x8, pw[ks]);
            const v4i16_t a0 = __builtin_amdgcn_ds_read_tr16_b64_v4i16((LAS v4i16_t*)(lds + slot + vfr + ks * 1024)), a1 = __builtin_amdgcn_ds_read_tr16_b64_v4i16((LAS v4i16_t*)(lds + slot + vfr + ks * 1024 + 512));
            const v4i16_t c0 = __builtin_amdgcn_ds_read_tr16_b64_v4i16((LAS v4i16_t*)(lds + slot + vfr + 4096 + ks * 1024)), c1 = __builtin_amdgcn_ds_read_tr16_b64_v4i16((LAS v4i16_t*)(lds + slot + vfr + 4096 + ks * 1024 + 512));
            const bf16x8 v0 = (bf16x8){a0[0], a0[1], a0[2], a0[3], a1[0], a1[1], a1[2], a1[3]}, v1 = (bf16x8){c0[0], c0[1], c0[2], c0[3], c1[0], c1[1], c1[2], c1[3]};
            o0 = __builtin_amdgcn_mfma_f32_32x32x16_bf16(v0, pb, o0, 0, 0, 0);
            o1 = __builtin_amdgcn_mfma_f32_32x32x16_bf16(v1, pb, o1, 0, 0, 0); }
    }
    const float lt = halves_sum(l);
    const unsigned mask = (unsigned)msel[(size_t)bh * S + qa];
    const size_t prow = (size_t)bh * S + qa;
    if (!OWN) {
        const int slot = __builtin_popcount(mask & ((1u << jb) - 1u));
        const float inv = 1.0f / lt;
        if (valid) {
            u32x4* po = (u32x4*)(mpo + ((prow * 3 + slot) * 2 + hi) * 32);
#pragma unroll
            for (int g = 0; g < 2; ++g) {
                po[g] = (u32x4){cvtpk(o0[8 * g] * inv, o0[8 * g + 1] * inv), cvtpk(o0[8 * g + 2] * inv, o0[8 * g + 3] * inv), cvtpk(o0[8 * g + 4] * inv, o0[8 * g + 5] * inv), cvtpk(o0[8 * g + 6] * inv, o0[8 * g + 7] * inv)};
                po[2 + g] = (u32x4){cvtpk(o1[8 * g] * inv, o1[8 * g + 1] * inv), cvtpk(o1[8 * g + 2] * inv, o1[8 * g + 3] * inv), cvtpk(o1[8 * g + 4] * inv, o1[8 * g + 5] * inv), cvtpk(o1[8 * g + 6] * inv, o1[8 * g + 7] * inv)}; }
            if (hi == 0) { float* pm = mpml + (prow * 3 + slot) * 2; pm[0] = m; pm[1] = lt; } }
    } else {
        const int cnt = __builtin_popcount(mask);
        float ms[3], ls[3]; u32x4 ps[3][4];
#pragma unroll
        for (int s3 = 0; s3 < 3; ++s3) { const bool on = s3 < cnt; const size_t ix = on ? prow * 3 + s3 : prow * 3;
            const float* pm = mpml + ix * 2; const float mv = pm[0], lv = pm[1]; ms[s3] = on ? mv : -1e30f; ls[s3] = on ? lv : 0.f;
            const u32x4* po = (const u32x4*)(mpo + (ix * 2 + hi) * 32);
#pragma unroll
            for (int g = 0; g < 4; ++g) { const u32x4 pv = po[g]; ps[s3][g] = on ? pv : (u32x4){0u, 0u, 0u, 0u}; } }
        const float M = fmaxf(fmaxf(m, ms[0]), fmaxf(ms[1], ms[2]));
        const float aown = __builtin_amdgcn_exp2f(m - M);
        float wsl[3], L = lt * aown;
#pragma unroll
        for (int s3 = 0; s3 < 3; ++s3) { wsl[s3] = ls[s3] * __builtin_amdgcn_exp2f(ms[s3] - M); L += wsl[s3]; }
        const float inv = 1.0f / L;
#pragma unroll
        for (int r = 0; r < 16; ++r) { o0[r] *= aown; o1[r] *= aown; }
#pragma unroll
        for (int s3 = 0; s3 < 3; ++s3)
#pragma unroll
            for (int g = 0; g < 2; ++g)
#pragma unroll
                for (int i = 0; i < 4; ++i) { const unsigned a = ps[s3][g][i], c = ps[s3][2 + g][i];
                    o0[8 * g + 2 * i] += wsl[s3] * bf2f(a & 0xffffu); o0[8 * g + 2 * i + 1] += wsl[s3] * bf2f(a >> 16);
                    o1[8 * g + 2 * i] += wsl[s3] * bf2f(c & 0xffffu); o1[8 * g + 2 * i + 1] += wsl[s3] * bf2f(c >> 16); }
        bf16_t* op = OCAT + (size_t)(b * S + qa) * D + 768 + h * 64 + 4 * hi;
#pragma unroll
        for (int g = 0; g < 4; ++g) {
            u32x2 w0; w0.x = cvtpk(o0[4 * g] * inv, o0[4 * g + 1] * inv); w0.y = cvtpk(o0[4 * g + 2] * inv, o0[4 * g + 3] * inv); *(u32x2*)(op + 8 * g) = w0;
            u32x2 w1; w1.x = cvtpk(o1[4 * g] * inv, o1[4 * g + 1] * inv); w1.y = cvtpk(o1[4 * g + 2] * inv, o1[4 * g + 3] * inv); *(u32x2*)(op + 32 + 8 * g) = w1; }
    }
    if (standalone) __syncthreads();
}
__device__ __forceinline__ void moba_gather_phase(LAS unsigned char* lds, volatile LAS unsigned* LC, const bf16_t* PROJ, const unsigned short* msel, const unsigned short* mlist, const int* mcnt, bf16_t* mpo, float* mpml, int wv) {
    const int tid = tid_of(wv), x = (int)blockIdx.x & 7, jcu = (int)blockIdx.x >> 3, W = (int)gridDim.x >> 3;
    if (tid < 60) LC[MB_CNT + tid] = (unsigned)mcnt[(x + 8 * (tid / 15)) * 16 + (tid % 15)];
    __syncthreads();
    if (tid <= 60) { int a = 0;
#pragma unroll 4
        for (int e = 0; e < 60; ++e) { const int t = ((int)LC[MB_CNT + e] + 255) >> 8; a += (e < tid) ? t : 0; }
        LC[MB_TP + tid] = (unsigned)a; }
    __syncthreads();
    if (tid < 16) { const int u = jcu + W * tid; unsigned word = 0u;
        if (u < (int)LC[MB_TP + 60]) { int e = 0;
            for (int t = 1; t < 60; ++t) e = ((int)LC[MB_TP + t] <= u) ? t : e;
            word = 0x80000000u | ((unsigned)e << 8) | (unsigned)(u - (int)LC[MB_TP + e]); }
        LC[MB_UT + tid] = word; }
    __syncthreads();
#pragma unroll 1
    for (int i = 0; i < 16; ++i) {
        const unsigned word = (unsigned)__builtin_amdgcn_readfirstlane((int)LC[MB_UT + i]); if (!(word >> 31)) break;
        const int e = (int)((word >> 8) & 63u), chunk = (int)(word & 255u), bh = x + 8 * (e / 15), jb = e % 15, n = (int)LC[MB_CNT + e];
        moba_block<false>(lds, 0, wv, true, bh >> 2, bh & 3, jb, chunk, n, PROJ, msel, mlist, mpo, mpml, nullptr, wv);
    }
}

__device__ __forceinline__ void attn_phase(LAS unsigned char* lds, int l, const bf16_t* PROJ, const float* lf, const float* kmean_l, const float* sinks_l, bf16_t* OCAT, int wv, const float* qkg_l,
                                           unsigned short* msel, unsigned short* mlist, int* mcnt_l) {
    const int G = gridDim.x, bx = blockIdx.x;
    const int vcu = (G % 8 == 0) ? (bx % 8) * (G / 8) + bx / 8 : bx;
    for (int p = vcu; p < 256; p += G) { const int bh = p >> 3, s8 = p & 7;
        moba_select(lds, bh >> 2, bh & 3, 15 - s8, PROJ, kmean_l, msel, mlist, mcnt_l, wv);
        moba_select(lds, bh >> 2, bh & 3, s8, PROJ, kmean_l, msel, mlist, mcnt_l, wv); }
    for (int p = vcu; p < 256; p += G) { const int bh = p >> 3, s = p & 7;
        attn_unit<0>(lds, bh >> 2, bh & 3, 15 - s, PROJ, lf, nullptr, nullptr, OCAT, wv, qkg_l);
        attn_unit<0>(lds, bh >> 2, bh & 3, s, PROJ, lf, nullptr, nullptr, OCAT, wv, qkg_l); }
    for (int p = vcu; p < 256; p += G) swa_unit(lds, p >> 5, (p >> 4) & 1, p & 15, PROJ, sinks_l, OCAT, wv);
    (void)l;
}
__device__ __forceinline__ void moba_own_phase(LAS unsigned char* lds, const bf16_t* PROJ, const unsigned short* msel, bf16_t* mpo, float* mpml, bf16_t* OCAT, int wv) {
    const int G = gridDim.x, bx = blockIdx.x;
    const int vcu = (G % 8 == 0) ? (bx % 8) * (G / 8) + bx / 8 : bx;
    const int w = wv, lane = opaque(lane_id());
    for (int p = vcu; p < 256; p += G) {
        const int pa = p, pb = p + 256;
        { u32x4 kr[2][4], vr[2][4];
          const int kdst = w * 1024 + lane * 16, vdst = 32768 + (w >> 2) * 4096 + (16 * (w & 3) + (lane >> 2)) * 64 + (lane & 3) * 16;
#pragma unroll
          for (int u = 0; u < 2; ++u) { const int pp = u ? pb : pa, b = pp >> 6, h = (pp >> 4) & 3, tb = 4 * (pp & 15);
              const bf16_t* base = PROJ + (size_t)b * S * PW;
              const bf16_t* kg = base + (size_t)lane * PW + MK + h * 64 + w * 8;
              const bf16_t* vg = base + (size_t)(16 * (w & 3) + (lane >> 2)) * PW + MV + h * 64 + (w >> 2) * 32 + (lane & 3) * 8;
#pragma unroll
              for (int i = 0; i < 4; ++i) { kr[u][i] = *(const u32x4*)(kg + (size_t)(64 * (tb + i)) * PW); vr[u][i] = *(const u32x4*)(vg + (size_t)(64 * (tb + i)) * PW); } }
#pragma unroll
          for (int u = 0; u < 2; ++u)
#pragma unroll
              for (int i = 0; i < 4; ++i) { *(LAS u32x4*)(lds + u * 65536 + i * 8192 + kdst) = kr[u][i]; *(LAS u32x4*)(lds + u * 65536 + i * 8192 + vdst) = vr[u][i]; } }
        __syncthreads();
        moba_block<true>(lds, 0, w, false, pa >> 6, (pa >> 4) & 3, pa & 15, 0, 0, PROJ, msel, nullptr, mpo, mpml, OCAT, wv);
        moba_block<true>(lds, 65536, 7 - w, false, pb >> 6, (pb >> 4) & 3, pb & 15, 0, 0, PROJ, msel, nullptr, mpo, mpml, OCAT, wv);
        __syncthreads();
    }
}
}

template <bool FINAL>
__device__ __forceinline__ void norm1_wave(const NormP& p, int gw, int NGW, int lane, const int* seg, LAS f32x4* wfL  ) {
    const bool comb = p.modprev != nullptr;
    for (int t0 = gw * 16; t0 < T; t0 += NGW * 16) {
        const int b = t0 / S;
        f32x4 gm[4], shv[4], g2[4];
#pragma unroll
        for (int j = 0; j < 4; ++j) {
            if (!FINAL) { const f32x4 g = *((const f32x4*)p.gain + lane + 64 * j), c1 = *((const f32x4*)(p.mod + (size_t)b * 6144 + D) + lane + 64 * j);
                gm[j] = g * (1.0f + c1); shv[j] = *((const f32x4*)(p.mod + (size_t)b * 6144) + lane + 64 * j); }
            if (comb) g2[j] = *((const f32x4*)(p.modprev + (size_t)b * 6144 + 5 * D) + lane + 64 * j); }
#pragma unroll 1
        for (int r2 = 0; r2 < 16; r2 += 2) {
            f32x4 v[2][4];
#pragma unroll
            for (int q = 0; q < 2; ++q) {
                if (p.xin) { const f32x4* xr = (const f32x4*)(p.xin + (size_t)(t0 + r2 + q) * D) + lane;
#pragma unroll
                    for (int j = 0; j < 4; ++j) v[q][j] = __builtin_nontemporal_load(xr + 64 * j); }
                else { const u32x2* xr = (const u32x2*)(p.xinb + (size_t)(t0 + r2 + q) * D) + lane;
#pragma unroll
                    for (int j = 0; j < 4; ++j) { const u32x2 w = xr[64 * j]; v[q][j] = (f32x4){bf2f(w.x & 0xffffu), bf2f(w.x >> 16), bf2f(w.y & 0xffffu), bf2f(w.y >> 16)}; } } }
            if (comb) {
                u32x2 yw[2][4][4];
#pragma unroll
                for (int q = 0; q < 2; ++q) { const int t = t0 + r2 + q;
                    const int4 e4 = *(const int4*)(p.toke + t * 4), p4 = *(const int4*)(p.tokp + t * 4);
                    const int ee[4] = {e4.x, e4.y, e4.z, e4.w}, pp[4] = {p4.x, p4.y, p4.z, p4.w};
#pragma unroll
                    for (int kk = 0; kk < 4; ++kk) { const u32x2* yr = (const u32x2*)(p.Y + (size_t)(seg[ee[kk]] + pp[kk]) * D) + lane;
#pragma unroll
                        for (int j = 0; j < 4; ++j) yw[q][kk][j] = __builtin_nontemporal_load(yr + 64 * j); } }
#pragma unroll
                for (int q = 0; q < 2; ++q)
#pragma unroll
                    for (int j = 0; j < 4; ++j) { f32x4 a = {0.f, 0.f, 0.f, 0.f};
#pragma unroll
                        for (int kk = 0; kk < 4; ++kk) { const u32x2 w = yw[q][kk][j]; a[0] += bf2f(w.x & 0xffffu); a[1] += bf2f(w.x >> 16); a[2] += bf2f(w.y & 0xffffu); a[3] += bf2f(w.y >> 16); }
                        v[q][j] += g2[j] * a; }
            }
#pragma unroll
            for (int q = 0; q < 2; ++q) {
                if (FINAL) { f32x4* xo = (f32x4*)(p.X + (size_t)(t0 + r2 + q) * D) + lane;
#pragma unroll
                    for (int j = 0; j < 4; ++j) __builtin_nontemporal_store(v[q][j], xo + 64 * j); }
                else { u32x2* xo = (u32x2*)(p.Xb + (size_t)(t0 + r2 + q) * D) + lane;
#pragma unroll
                    for (int j = 0; j < 4; ++j) { u32x2 w; w.x = pg::cvt_pk_bf16(v[q][j][0], v[q][j][1]); w.y = pg::cvt_pk_bf16(v[q][j][2], v[q][j][3]); xo[64 * j] = w; } } }
            if (FINAL) continue;
            float ss[2];
#pragma unroll
            for (int q = 0; q < 2; ++q) { ss[q] = 0.f;
#pragma unroll
                for (int j = 0; j < 4; ++j) ss[q] += (v[q][j][0] * v[q][j][0] + v[q][j][1] * v[q][j][1]) + (v[q][j][2] * v[q][j][2] + v[q][j][3] * v[q][j][3]); }
            ss[0] = wsum(ss[0]); ss[1] = wsum(ss[1]);
#pragma unroll
            for (int q = 0; q < 2; ++q) { const int t = t0 + r2 + q; const float r = rsqrtf(ss[q] * (1.0f / D) + EPS);
                u32x2* ho = (u32x2*)(p.H + (size_t)t * D) + lane;
                float f0 = 0.f, f1 = 0.f, f2 = 0.f, f3 = 0.f;
#pragma unroll
                for (int j = 0; j < 4; ++j) { const f32x4 h = (v[q][j] * r) * gm[j] + shv[j];
                    u32x2 w; w.x = pk2(h[0], h[1]); w.y = pk2(h[2], h[3]); ho[64 * j] = w;
#pragma unroll
                    for (int i = 0; i < 4; ++i) { const f32x4 wv4 = wfL[(j * 4 + i) * 64 + lane]; f0 += h[i] * wv4[0]; f1 += h[i] * wv4[1]; f2 += h[i] * wv4[2]; f3 += h[i] * wv4[3]; } }
                f0 = wsum(f0); f1 = wsum(f1); f2 = wsum(f2); f3 = wsum(f3);
                if (lane < 4) { const float z = (lane == 0 ? f0 : lane == 1 ? f1 : lane == 2 ? f2 : f3) + p.bf[lane];
                    p.lf[(size_t)(b * 4 + lane) * S + (t % S)] = fminf(z, 0.f) - log1pf(__expf(-fabsf(z))); } }
        }
    }
}

__device__ __forceinline__ void router_prep(const float* __restrict__ modl, const float* __restrict__ gain2, const float* __restrict__ wr, const float* __restrict__ br, bf16_t* __restrict__ WgT, float* __restrict__ cb, int wv) {
    const int w = opaque_s(wv), lane = opaque(lane_id()), tid = w * 64 + lane;
    const int per = (NB * NE * (D / 8) + (int)gridDim.x - 1) / (int)gridDim.x;
    for (int ii = tid; ii < per; ii += NTHR) { const int i = (int)blockIdx.x * per + ii; if (i >= NB * NE * (D / 8)) break;
        const int e = i & 31, k8 = (i >> 5) & 127, b = i >> 12;
        float g[8], m[8], wv8[8];
#pragma unroll
        for (int c = 0; c < 8; ++c) { const int k = 8 * k8 + c; g[c] = gain2[k]; m[c] = modl[(size_t)b * 6144 + 4 * D + k]; wv8[c] = wr[k * NE + e]; }
        unsigned hp[4], mp[4], lp[4];
#pragma unroll
        for (int c = 0; c < 8; ++c) {
            const float v = g[c] * (1.0f + m[c]) * wv8[c];
            const unsigned h = f2bf(v); const float r1 = v - bf2f(h); const unsigned mm = f2bf(r1); const float r2 = r1 - bf2f(mm); const unsigned lo = f2bf(r2);
            if (c & 1) { hp[c >> 1] |= h << 16; mp[c >> 1] |= mm << 16; lp[c >> 1] |= lo << 16; } else { hp[c >> 1] = h; mp[c >> 1] = mm; lp[c >> 1] = lo; } }
        bf16_t* o = WgT + (((size_t)(b * 3) * 128 + k8) * NE + e) * 8;
        *(u32x4*)(o) = (u32x4){hp[0], hp[1], hp[2], hp[3]}; *(u32x4*)(o + (size_t)NE * D) = (u32x4){mp[0], mp[1], mp[2], mp[3]}; *(u32x4*)(o + (size_t)2 * NE * D) = (u32x4){lp[0], lp[1], lp[2], lp[3]}; }
    if (w == 2) {
        for (int i = (int)blockIdx.x; i < NB * NE; i += (int)gridDim.x) { const int e = i & 31, b = i >> 5;
            float mv[16], wv16[16];
#pragma unroll
            for (int j = 0; j < 16; ++j) { const int k = lane + 64 * j; mv[j] = modl[(size_t)b * 6144 + 3 * D + k]; wv16[j] = wr[k * NE + e]; }
            float a = 0.f;
#pragma unroll
            for (int j = 0; j < 16; ++j) a += mv[j] * wv16[j];
            a = wsum(a); if (lane == 0) cb[i] = a + br[e]; } }
}
constexpr int RF_BUF = 0, RF_LG = 16384, RF_RS = 36864, RF_SS = 37376, RF_HIST = 37888, RF_BASE = 38016;
__device__ __forceinline__ void norm2_router(LAS unsigned char* lds, int vb, const bf16_t* __restrict__ X, bf16_t* __restrict__ H, const float* __restrict__ modl, const float* __restrict__ gain2,
                                             const bf16_t* __restrict__ WgT, const float* __restrict__ cb, int* __restrict__ cnt, int* __restrict__ toke, int* __restrict__ tokp, int* __restrict__ list, float* __restrict__ listw, int wv) {
    const int w = wv, lane = opaque(lane_id()), tid = w * 64 + lane, r32 = lane & 31, hi = lane >> 5;
    const int tile = w & 3, kh = w >> 2, t0 = 128 * vb + 32 * tile, b = (128 * vb) / S;
    LAS float* buf = (LAS float*)(lds + RF_BUF); LAS float* LG = (LAS float*)(lds + RF_LG); LAS float* RS = (LAS float*)(lds + RF_RS); LAS float* SS = (LAS float*)(lds + RF_SS);
    LAS int* hist = (LAS int*)(lds + RF_HIST); LAS int* basep = (LAS int*)(lds + RF_BASE);
    if (tid < 32) hist[tid] = 0;
    f32x16 acc = {}; float ss = 0.f;
    { const bf16_t* xrow = X + (size_t)(t0 + r32) * D + kh * 512 + 8 * hi;
      const bf16_t* wp = WgT + (((size_t)(b * 3) * 128 + kh * 64 + hi) * NE + r32) * 8;
#pragma unroll 1
      for (int j0 = 0; j0 < 32; j0 += 8) {
          u32x4 aw[8]; bf16x8 w0[8], w1[8], w2[8];
#pragma unroll
          for (int j = 0; j < 8; ++j) { aw[j] = *(const u32x4*)(xrow + 16 * (j0 + j)); w0[j] = *(const bf16x8*)(wp + 512 * (j0 + j));
              w1[j] = *(const bf16x8*)(wp + (size_t)NE * D + 512 * (j0 + j)); w2[j] = *(const bf16x8*)(wp + (size_t)2 * NE * D + 512 * (j0 + j)); }
          asm volatile("s_waitcnt vmcnt(0)" ::: "memory");
#pragma unroll
          for (int j = 0; j < 8; ++j) {
#pragma unroll
              for (int c = 0; c < 4; ++c) { const float lo = bf2f(aw[j][c] & 0xffffu), hv = __uint_as_float(aw[j][c] & 0xffff0000u); ss += lo * lo + hv * hv; }
              bf16x8 a; { union { u32x4 u; bf16x8 v; } cv; cv.u = aw[j]; a = cv.v; }
              acc = __builtin_amdgcn_mfma_f32_32x32x16_bf16(a, w2[j], acc, 0, 0, 0);
              acc = __builtin_amdgcn_mfma_f32_32x32x16_bf16(a, w1[j], acc, 0, 0, 0);
              acc = __builtin_amdgcn_mfma_f32_32x32x16_bf16(a, w0[j], acc, 0, 0, 0); } } }
    ss = at::halves_sum(ss);
    if (kh == 1) {
#pragma unroll
        for (int r = 0; r < 16; ++r) buf[(tile * 16 + r) * 64 + lane] = acc[r];
        if (hi == 0) SS[tile * 32 + r32] = ss; }
    __syncthreads();
    int se[4] = {0, 0, 0, 0}, sr[4] = {0, 0, 0, 0}; float sw[4] = {0.f, 0.f, 0.f, 0.f};
    if (kh == 0) {
#pragma unroll
        for (int r = 0; r < 16; ++r) acc[r] += buf[(tile * 16 + r) * 64 + lane];
        ss += SS[tile * 32 + r32];
        const float rstd = rsqrtf(ss * (1.0f / D) + EPS);
        if (hi == 0) RS[tile * 32 + r32] = rstd;
        asm volatile("s_waitcnt lgkmcnt(0)" ::: "memory");
        const float cbe = cb[b * NE + r32];
#pragma unroll
        for (int r = 0; r < 16; ++r) { const int tk = at::crow(r, hi); LG[(tile * 32 + tk) * 33 + r32] = RS[tile * 32 + tk] * acc[r] + cbe; }
        asm volatile("s_waitcnt lgkmcnt(0)" ::: "memory");
        if (lane < 32) {
            float lg[32];
#pragma unroll
            for (int e = 0; e < 32; ++e) lg[e] = LG[(tile * 32 + lane) * 33 + e];
            float tv[4];
#pragma unroll
            for (int kk = 0; kk < 4; ++kk) { float bv = -INFINITY; int bi = 0;
#pragma unroll
                for (int e = 0; e < 32; ++e) { const bool tk = lg[e] > bv; bv = tk ? lg[e] : bv; bi = tk ? e : bi; }
                tv[kk] = bv; se[kk] = bi;
#pragma unroll
                for (int e = 0; e < 32; ++e) lg[e] = (e == bi) ? -INFINITY : lg[e]; }
            float sum = 0.f;
#pragma unroll
            for (int kk = 0; kk < 4; ++kk) { sw[kk] = __expf(tv[kk] - tv[0]); sum += sw[kk]; }
            const float inv = 1.0f / sum;
#pragma unroll
            for (int kk = 0; kk < 4; ++kk) { sw[kk] *= inv; sr[kk] = atomicAdd((int*)(hist + se[kk]), 1); }
        }
    }
    __syncthreads();
    if (tid < 32) basep[tid] = atomicAdd(cnt + tid * CNT_STRIDE, hist[tid]);
    __syncthreads();
    if (kh == 0 && lane < 32) { const int t = t0 + lane;
#pragma unroll
        for (int kk = 0; kk < 4; ++kk) { const int e = se[kk], pos = basep[e] + sr[kk];
            toke[t * 4 + kk] = e; tokp[t * 4 + kk] = pos; list[(size_t)e * CAP + pos] = t; listw[(size_t)e * CAP + pos] = sw[kk]; } }
    { f32x4 gm[4], shv[4];
#pragma unroll
      for (int j = 0; j < 4; ++j) { const f32x4 g = *((const f32x4*)gain2 + lane + 64 * j), c1 = *((const f32x4*)(modl + (size_t)b * 6144 + 4 * D) + lane + 64 * j);
          gm[j] = g * (1.0f + c1); shv[j] = *((const f32x4*)(modl + (size_t)b * 6144 + 3 * D) + lane + 64 * j); }
#pragma unroll 1
      for (int i0 = 0; i0 < 16; i0 += 8) {
          u32x2 xw[8][4]; float rs[8];
#pragma unroll
          for (int q = 0; q < 8; ++q) { const int rr = 16 * w + i0 + q; rs[q] = RS[rr]; const u32x2* xr = (const u32x2*)(X + (size_t)(128 * vb + rr) * D) + lane;
#pragma unroll
              for (int j = 0; j < 4; ++j) xw[q][j] = xr[64 * j]; }
#pragma unroll
          for (int q = 0; q < 8; ++q) { u32x2* ho = (u32x2*)(H + (size_t)(128 * vb + 16 * w + i0 + q) * D) + lane;
#pragma unroll
              for (int j = 0; j < 4; ++j) { const u32x2 x2 = xw[q][j]; const f32x4 xv = {bf2f(x2.x & 0xffffu), bf2f(x2.x >> 16), bf2f(x2.y & 0xffffu), bf2f(x2.y >> 16)};
                  const f32x4 v = (xv * rs[q]) * gm[j] + shv[j]; u32x2 o; o.x = pg::cvt_pk_bf16(v[0], v[1]); o.y = pg::cvt_pk_bf16(v[2], v[3]); ho[64 * j] = o; } } } }
    __syncthreads();
}

template <int MPR  , bool GATHER>
__device__ __forceinline__ void moe_tables(volatile LAS unsigned* LC, LAS unsigned short* gtab, const int* cnt, const int* list, int wv) {
    const int tid = tid_of(wv);
    if (tid < NE) LC[LC_CNT + tid] = (unsigned)cnt[tid * CNT_STRIDE];
    __syncthreads();
    if (tid <= NE) LC[LC_TPF + tid] = (unsigned)tile_prefix(LC + LC_CNT, tid);
    __syncthreads();
    if (tid < pg::GTAB_UNITS) { pg::Unit u; const bool ok = pg::moe_unit<(GATHER ? 8 : 4)>(LC, (int)blockIdx.x, (int)gridDim.x, tid, u);
        LC[LC_UT + tid] = ok ? (0x80000000u | (unsigned)u.pm | ((unsigned)u.pn << 10) | ((unsigned)u.e << 13)) : 0u; }
    __syncthreads();
    if (GATHER) {
        const LAS unsigned* L = (const LAS unsigned*)LC;
        int tok[pg::GTAB_UNITS / 2];
#pragma unroll
        for (int k = 0; k < pg::GTAB_UNITS / 2; ++k) { const int i = 2 * k + (tid >> 8), r = tid & 255; const unsigned w = L[LC_UT + i]; tok[k] = 0;
            if (w >> 31) { const int e = (int)((w >> 13) & 31u), mg = (int)(w & 1023u); int pos = (mg - (int)L[LC_TPF + e]) * 256 + r; const int cn = (int)L[LC_CNT + e]; pos = pos < cn ? pos : cn - 1; tok[k] = list[(size_t)e * CAP + pos]; } }
#pragma unroll
        for (int k = 0; k < pg::GTAB_UNITS / 2; ++k) gtab[(2 * k + (tid >> 8)) * 256 + (tid & 255)] = (unsigned short)tok[k];
        __syncthreads();
    }
}

template <int NN>
__device__ __forceinline__ void moe_tail(KArgs ka, unsigned char* ws, LAS unsigned char* lds, volatile LAS unsigned* LCv, int wv) {
    const LAS unsigned* LC = (const LAS unsigned*)LCv;
    int mine = 0;
#pragma unroll 1
    for (int i = 0; i < pg::GTAB_UNITS; ++i) mine += (int)(LC[LC_UT + i] >> 31);
    mine = __builtin_amdgcn_readfirstlane(mine);
    const int U = (int)LC[LC_TPF + NE] * NN, W = opaque_s((int)gridDim.x) >> 3, mx = __builtin_amdgcn_readfirstlane((((U + 7) >> 3) + W - 1) / W);
    if (mine < mx) conv_tail(ka, ws, lds, (volatile LAS unsigned*)LCv, wv, CV_QUOTA * (mx - mine));
}

constexpr int PH_END = 34;
__device__ __forceinline__ KArgs kargs() { auto p = __builtin_amdgcn_kernarg_segment_ptr(); asm volatile("" : "+s"(p)); return (KArgs)p; }
__global__ void __launch_bounds__(NTHR, 2) mega(MArgs args_unused) {
    extern __shared__ __attribute__((aligned(16))) unsigned char lds_raw[];
    LAS unsigned char* lds = (LAS unsigned char*)lds_raw;
    volatile LAS unsigned* LC = (volatile LAS unsigned*)(lds + LDS_CTL);
    const int wv = __builtin_amdgcn_readfirstlane((int)threadIdx.x >> 6);
#define TID() opaque(tid_of(wv))
#define GW() opaque_s((int)blockIdx.x * NWAVES + wv)
    for (int u = TID(); u < (LDS_BYTES - LDS_CTL) / 4; u += NTHR) LC[u] = 0u;
    __syncthreads();
    XcdBarrier bar;
    { KArgs ka = kargs(); bar = xcd_barrier_post((unsigned*)ka->ws + CW_BAR + ka->li * XCD_BAR_WORDS, LC + LC_BAR, wv); }
#define SEAM() do { xcd_barrier(bar); if (PROBE_KIND == 9) for (int r_ = 0; r_ < PROBE_REPS; ++r_) xcd_barrier(bar); } while (0)
    {
        KArgs ka = kargs(); unsigned char* ws = ka->ws;
        p0_mod(ka->in[I_C], ka->in[I_WADA], ka->in[I_BADA], (float*)(ws + WS_MOD), (LAS float*)lds, wv);
        __syncthreads();
        conv_flush(ka, ws, lds, wv, CV_S1);
    }
    SEAM();
#pragma unroll 1
    for (int l = 0; l < NL; ++l) {
        {
            const int lq = opaque_s(l); KArgs ka = kargs(); unsigned char* ws = ka->ws; const int G = opaque_s((int)gridDim.x);
            const float* modl = (const float*)(ws + WS_MOD) + (size_t)lq * NB * 6144; bf16_t* XB = (bf16_t*)(ws + WS_XB); int* cnt = (int*)(ws + CTL_CNT);
            NormP p{};
            p.xin = (lq == 0) ? ka->in[I_X] : nullptr; p.xinb = XB; p.X = nullptr; p.Xb = XB; p.H = (bf16_t*)(ws + WS_H); p.mod = modl; p.modprev = (lq == 0) ? nullptr : modl - (size_t)NB * 6144;
            p.gain = ka->in[I_NGAIN] + (size_t)(lq * 2 + 0) * D; p.Y = (const bf16_t*)(ws + WS_Y); p.toke = (const int*)(ws + WS_TOKE); p.tokp = (const int*)(ws + WS_TOKP); p.cntprev = cnt + (lq > 0 ? (lq - 1) * NE * CNT_STRIDE : 0);
            p.wf = ka->in[I_WIN] + (size_t)lq * D * DIN + 768; p.bf = ka->in[I_BF] + lq * 4; p.lf = (float*)(ws + WS_LF);
            if (lq > 0) { const int tid = TID(); if (tid < NE) LC[LC_CNT + tid] = (unsigned)p.cntprev[tid * CNT_STRIDE]; __syncthreads();
                if (tid <= NE) LC[LC_SEG + tid] = (unsigned)(tile_prefix(LC + LC_CNT, tid) << 8); __syncthreads(); }
            { const int tid = TID(); LAS f32x4* wfL = (LAS f32x4*)lds;
              f32x4 wq[2];
#pragma unroll
              for (int h = 0; h < 2; ++h) { const int q = tid + h * NTHR, ln = q & 63, ji = q >> 6; wq[h] = *(const f32x4*)(p.wf + (size_t)(4 * ln + 256 * (ji >> 2) + (ji & 3)) * DIN); }
              wfL[tid] = wq[0]; wfL[tid + NTHR] = wq[1];
              __syncthreads(); }
            norm1_wave<false>(p, GW(), G * NWAVES, TID() & 63, (const int*)(lds_raw + LDS_CTL) + LC_SEG, (LAS f32x4*)lds);
            if (PROBE_KIND == 0 && PROBE_REPS > 0) { __syncthreads(); p.xin = nullptr; p.modprev = nullptr; norm1_wave<false>(p, GW(), G * NWAVES, TID() & 63, (const int*)(lds_raw + LDS_CTL) + LC_SEG, (LAS f32x4*)lds); }
            __syncthreads();
            router_prep(modl, ka->in[I_NGAIN] + (size_t)(lq * 2 + 1) * D, ka->in[I_WR] + (size_t)lq * D * NE, ka->in[I_BR] + lq * NE, (bf16_t*)(ws + WS_WGT), (float*)(ws + WS_CB), wv);
            if (lq > 0) conv_flush(ka, ws, lds, wv, lq * CV_PER_L + CV_S1);
        }
        SEAM();
        {
            const int lq = opaque_s(l); KArgs ka = kargs(); unsigned char* ws = ka->ws;
            conv_raise(ws, wv, lq * CV_PER_L + CV_S1);
            pg::GIn g; g.ord.init(T / 256, PW / 256, (int)gridDim.x, (int)blockIdx.x); g.A = (const bf16_t*)(ws + WS_H); g.Bt = (const bf16_t*)(ws + WS_WT) + (size_t)lq * WT_LAYER + WT_IN; g.PROJ = (bf16_t*)(ws + WS_PROJ);
            g.qkg = ka->in[I_QKG] + lq * 6 * 64; g.kmean = (float*)(ws + CTL_KMEAN) + (size_t)lq * NB * 16 * 256;
            for (int rep = 0; rep < 1 + (PROBE_KIND == 1 ? PROBE_REPS : 0); ++rep) { g.dry = rep; pg::gemm_phase(lds, g, wv); }
            { const int nwg = (T / 256) * (PW / 256), G = opaque_s((int)gridDim.x), mine = (nwg - opaque_s((int)blockIdx.x) + G - 1) / G, mx = (nwg + G - 1) / G;
              if (mine < mx) conv_tail(ka, ws, lds, LC, wv, CV_QUOTA * (mx - mine)); }
        }
        SEAM();
        {
            const int lq = opaque_s(l); KArgs ka = kargs(); unsigned char* ws = ka->ws;
            at::attn_phase(lds, lq, (const bf16_t*)(ws + WS_PROJ), (const float*)(ws + WS_LF), (const float*)(ws + CTL_KMEAN) + (size_t)lq * NB * 16 * 256, ka->in[I_SINK] + lq * 8, (bf16_t*)(ws + WS_OCAT), wv, ka->in[I_QKG] + lq * 6 * 64,
                           (unsigned short*)(ws + WS_MSEL), (unsigned short*)(ws + WS_MLIST), (int*)(ws + CTL_MCNT) + lq * NB * 4 * 16);
        }
        SEAM();
        {
            const int lq = opaque_s(l); KArgs ka = kargs(); unsigned char* ws = ka->ws;
            at::moba_gather_phase(lds, LC, (const bf16_t*)(ws + WS_PROJ), (const unsigned short*)(ws + WS_MSEL), (const unsigned short*)(ws + WS_MLIST), (const int*)(ws + CTL_MCNT) + lq * NB * 4 * 16, (bf16_t*)(ws + WS_MPO), (float*)(ws + WS_MPML), wv);
        }
        SEAM();
        {
            KArgs ka = kargs(); unsigned char* ws = ka->ws;
            at::moba_own_phase(lds, (const bf16_t*)(ws + WS_PROJ), (const unsigned short*)(ws + WS_MSEL), (bf16_t*)(ws + WS_MPO), (float*)(ws + WS_MPML), (bf16_t*)(ws + WS_OCAT), wv);
        }
        SEAM();
        {
            const int lq = opaque_s(l); KArgs ka = kargs(); unsigned char* ws = ka->ws;
            pg::GBranch g; g.ord.init(T / 256, D / 256, (int)gridDim.x, (int)blockIdx.x); g.A = (const bf16_t*)(ws + WS_OCAT); g.Bt = (const bf16_t*)(ws + WS_WT) + (size_t)lq * WT_LAYER + WT_BR; g.PROJ = (const bf16_t*)(ws + WS_PROJ); g.MERGED = (bf16_t*)(ws + WS_MERGED);
            for (int rep = 0; rep < 1 + (PROBE_KIND == 3 ? PROBE_REPS : 0); ++rep) { g.dry = rep; pg::gemm_phase(lds, g, wv); }
        }
        SEAM();
        {
            const int lq = opaque_s(l); KArgs ka = kargs(); unsigned char* ws = ka->ws;
            pg::GOut g; g.ord.init(T / 256, D / 256, (int)gridDim.x, (int)blockIdx.x); g.A = (const bf16_t*)(ws + WS_MERGED); g.Bt = (const bf16_t*)(ws + WS_WT) + (size_t)lq * WT_LAYER + WT_OUT; g.X = (bf16_t*)(ws + WS_XB); g.modl = (const float*)(ws + WS_MOD) + (size_t)lq * NB * 6144;
            for (int rep = 0; rep < 1 + (PROBE_KIND == 4 ? PROBE_REPS : 0); ++rep) { g.dry = rep; pg::gemm_phase(lds, g, wv); }
        }
        SEAM();
        {
            const int lq = opaque_s(l); KArgs ka = kargs(); unsigned char* ws = ka->ws; const int G = opaque_s((int)gridDim.x);
            for (int vb = blockIdx.x; vb < T / 128; vb += G) norm2_router(lds, vb, (const bf16_t*)(ws + WS_XB), (bf16_t*)(ws + WS_H), (const float*)(ws + WS_MOD) + (size_t)lq * NB * 6144, ka->in[I_NGAIN] + (size_t)(lq * 2 + 1) * D, (const bf16_t*)(ws + WS_WGT), (const float*)(ws + WS_CB),
                                                                         (int*)(ws + CTL_CNT) + lq * NE * CNT_STRIDE, (int*)(ws + WS_TOKE), (int*)(ws + WS_TOKP), (int*)(ws + WS_LIST), (float*)(ws + WS_LISTW), wv);
            conv_flush(ka, ws, lds, wv, (lq + 1) * CV_PER_L);
            if (PROBE_KIND == 5 && PROBE_REPS > 0) __syncthreads();
            if (PROBE_KIND == 5 && PROBE_REPS > 0)
                for (int vb = blockIdx.x; vb < T / 128; vb += G) norm2_router(lds, vb, (const bf16_t*)(ws + WS_XB), (bf16_t*)(ws + WS_H), (const float*)(ws + WS_MOD) + (size_t)lq * NB * 6144, ka->in[I_NGAIN] + (size_t)(lq * 2 + 1) * D, (const bf16_t*)(ws + WS_WGT), (const float*)(ws + WS_CB),
                                                                             (int*)(ws + CTL_CNT) + (NL + lq) * NE * CNT_STRIDE, (int*)(ws + 1160 * MiB), (int*)(ws + 1161 * MiB), (int*)(ws + 1162 * MiB), (float*)(ws + 1168 * MiB), wv);
        }
        SEAM();
        {
            const int lq = opaque_s(l); KArgs ka = kargs(); unsigned char* ws = ka->ws;
            conv_raise(ws, wv, (lq + 1) * CV_PER_L);
            moe_tables<32, true>(LC, (LAS unsigned short*)(lds + pg::LDS_GTAB), (const int*)(ws + CTL_CNT) + lq * NE * CNT_STRIDE, (const int*)(ws + WS_LIST), wv);
            pg::GMoe1 g; g.LC = LC; g.gtab = (const LAS unsigned short*)(lds + pg::LDS_GTAB); g.A = (const bf16_t*)(ws + WS_H); g.Bt = (const bf16_t*)(ws + WS_WT) + (size_t)lq * WT_LAYER + WT_W1; g.b1 = ka->in[I_B1] + (size_t)lq * NE * 2048; g.A2 = (bf16_t*)(ws + WS_A2); g.c = (int)blockIdx.x;
            for (int rep = 0; rep < 1 + (PROBE_KIND == 6 ? PROBE_REPS : 0); ++rep) { g.dry = rep; pg::gemm_phase(lds, g, wv); }
            moe_tail<8>(ka, ws, lds, LC, wv);
        }
        SEAM();
        {
            const int lq = opaque_s(l); KArgs ka = kargs(); unsigned char* ws = ka->ws;
            moe_tables<64, false>(LC, nullptr, (const int*)(ws + CTL_CNT) + lq * NE * CNT_STRIDE, (const int*)(ws + WS_LIST), wv);
            pg::GMoe2 g; g.LC = LC; g.A = (const bf16_t*)(ws + WS_A2); g.Bt = (const bf16_t*)(ws + WS_WT) + (size_t)lq * WT_LAYER + WT_W2; g.b2 = ka->in[I_B2] + (size_t)lq * NE * D; g.listw = (const float*)(ws + WS_LISTW); g.Y = (bf16_t*)(ws + WS_Y); g.c = (int)blockIdx.x;
            for (int rep = 0; rep < 1 + (PROBE_KIND == 7 ? PROBE_REPS : 0); ++rep) { g.dry = rep; pg::gemm_phase(lds, g, wv); }
            moe_tail<4>(ka, ws, lds, LC, wv);
        }
        SEAM();
    }
    {
        KArgs ka = kargs(); unsigned char* ws = ka->ws; const int G = opaque_s((int)gridDim.x);
        NormP p{}; p.xin = nullptr; p.xinb = (const bf16_t*)(ws + WS_XB); p.X = ka->out; p.Xb = nullptr; p.modprev = (const float*)(ws + WS_MOD) + (size_t)(NL - 1) * NB * 6144; p.Y = (const bf16_t*)(ws + WS_Y); p.toke = (const int*)(ws + WS_TOKE); p.tokp = (const int*)(ws + WS_TOKP); p.cntprev = (const int*)(ws + CTL_CNT) + (NL - 1) * NE * CNT_STRIDE;
        { const int tid = TID(); if (tid < NE) LC[LC_CNT + tid] = (unsigned)p.cntprev[tid * CNT_STRIDE]; __syncthreads();
          if (tid <= NE) LC[LC_SEG + tid] = (unsigned)(tile_prefix(LC + LC_CNT, tid) << 8); __syncthreads(); }
        norm1_wave<true>(p, GW(), G * NWAVES, TID() & 63, (const int*)(lds_raw + LDS_CTL) + LC_SEG, (LAS f32x4*)lds);
    }
#undef SEAM
#undef GW
#undef TID
}

static int g_grid = 0;
static void launch_mega(const float* const* in, float* out, unsigned char* ws, int lo, int hi, int li, hipStream_t stream) {
    MArgs a; memset(&a, 0, sizeof(a));
    for (int i = 0; i < 19; ++i) a.in[i] = in[i];
    a.out = out; a.ws = ws; a.ph_lo = lo; a.ph_hi = hi; a.li = li; a.pad = 0;
    hipLaunchKernelGGL(mega, dim3(g_grid), dim3(NTHR), LDS_BYTES, stream, a);
    const hipError_t le = hipPeekAtLastError();
    if (le != hipSuccess) fprintf(stderr, "kernel_launch: mega launch [%d,%d) failed: %s\n", lo, hi, hipGetErrorName(le));
}
extern "C" void kernel_launch(void* const* d_in, const int* in_sizes, int n_in, void* d_out, int out_size, void* d_ws, size_t ws_size, hipStream_t stream) {
    if (n_in != 19 || out_size != T * D || ws_size < WS_END) { fprintf(stderr, "kernel_launch: unexpected shapes (n_in %d out %d ws %zu need %zu)\n", n_in, out_size, ws_size, (size_t)WS_END); return; }
    if (g_grid == 0) {
        int dev = 0, cus = 0, per_cu = 0;
        if (hipGetDevice(&dev) != hipSuccess || hipDeviceGetAttribute(&cus, hipDeviceAttributeMultiprocessorCount, dev) != hipSuccess) { g_grid = -1; return; }
        if (hipFuncSetAttribute((const void*)mega, hipFuncAttributeMaxDynamicSharedMemorySize, LDS_BYTES) != hipSuccess) { fprintf(stderr, "kernel_launch: hipFuncSetAttribute failed\n"); g_grid = -1; return; }
        if (hipOccupancyMaxActiveBlocksPerMultiprocessor(&per_cu, (const void*)mega, NTHR, LDS_BYTES) != hipSuccess || per_cu < 1) { fprintf(stderr, "kernel_launch: occupancy query says %d\n", per_cu); }
        (void)hipGetLastError();
        g_grid = cus;
    }
    if (g_grid < 0) return;
    const float* const* in = (const float* const*)d_in;
    unsigned char* ws = (unsigned char*)d_ws;
    (void)in_sizes;
    (void)hipMemsetAsync(ws + WS_CTL, 0, CTL_BYTES, stream);
    launch_mega(in, (float*)d_out, ws, 0, PH_END, 0, stream);
}
```

```cpp
#include <hip/hip_runtime.h>
#include <stdint.h>
#include <stdio.h>
#include <string.h>
#ifndef PROBE_KIND
#define PROBE_KIND -1
#define PROBE_REPS 0
#endif
#ifndef PROBE_DRY
#define PROBE_DRY 1
#endif

typedef unsigned short bf16_t;
typedef short bf16x8 __attribute__((ext_vector_type(8)));
typedef float f32x4 __attribute__((ext_vector_type(4)));
typedef float f32x16 __attribute__((ext_vector_type(16)));
typedef float f32x2 __attribute__((ext_vector_type(2)));
typedef unsigned u32x4 __attribute__((ext_vector_type(4)));
typedef unsigned u32x2 __attribute__((ext_vector_type(2)));

constexpr int NB = 8, S = 4096, T = NB * S, D = 1024, NL = 4, DIN = 5380, PW = 5376, NE = 32, CAP = 32768;
constexpr int ROWS_MAX = T * 4 + NE * 256;
constexpr float EPS = 1e-6f;
constexpr float LOG2E = 1.4426950408889634f;
constexpr float C2 = 0.125f * LOG2E;
constexpr int FQ = 0, FK = 256, FV = 512, SQ = 768, SK = 1280, SV = 1408, MQ = 1536, MK = 1792, MV = 2048, GA = 2304, GB = 3328, GC = 4352;
enum { I_X = 0, I_C, I_WADA, I_BADA, I_NGAIN, I_WIN, I_BF, I_QKG, I_SINK, I_WBF, I_WBS, I_WBM, I_WOUT, I_WR, I_BR, I_W1, I_B1, I_W2, I_B2 };

constexpr size_t MiB = 1ull << 20;
constexpr size_t WS_CTL = 0, CTL_BYTES = 2 * MiB;
constexpr size_t CTL_CNT = 512 * 1024;
constexpr int CNT_STRIDE = 32;
constexpr size_t CTL_KMEAN = 1 * MiB;
constexpr size_t WS_MOD = 2 * MiB;
constexpr size_t WS_LF = 3 * MiB;
constexpr size_t WS_CUM = 4 * MiB;
constexpr size_t WS_WG = 7 * MiB;
constexpr size_t WS_CB = 6 * MiB + 512 * 1024;
constexpr size_t WS_TOKE = 5 * MiB;
constexpr size_t WS_TOKP = 6 * MiB;
constexpr size_t WS_LIST = 8 * MiB;
constexpr size_t WS_LISTW = 12 * MiB;
constexpr size_t WS_H = 16 * MiB;
constexpr size_t WS_OCAT = 80 * MiB;
constexpr size_t WS_MERGED = 144 * MiB;
constexpr size_t WS_PROJ = 208 * MiB;
constexpr size_t WS_A2 = 544 * MiB;
constexpr size_t WS_Y = 816 * MiB;
constexpr size_t WS_NAIVE = 1088 * MiB;
constexpr size_t CTL_MCNT = 768 * 1024;
constexpr size_t WS_MSEL = 1160 * MiB;
constexpr size_t WS_MLIST = 1161 * MiB;
constexpr size_t WS_MPO = 1168 * MiB;
constexpr size_t WS_MPML = 1220 * MiB;
constexpr int MLCAP = 3840;
constexpr size_t WS_WGT = 1152 * MiB;
constexpr size_t WS_XB = 1088 * MiB;
constexpr size_t WS_WT = 2304 * MiB;
constexpr size_t WS_END = WS_WT + 4 * 216 * MiB;

__device__ __forceinline__ unsigned f2bf(float f) { unsigned u = __float_as_uint(f); return (u + 0x7fffu + ((u >> 16) & 1u)) >> 16; }
__device__ __forceinline__ float bf2f(unsigned b) { return __uint_as_float(b << 16); }
__device__ __forceinline__ unsigned pk2(float lo, float hi) { return f2bf(lo) | (f2bf(hi) << 16); }
__device__ __forceinline__ float wave_sum(float v) {
#pragma unroll
    for (int o = 1; o < 64; o <<= 1) v += __shfl_xor(v, o);
    return v;
}
__device__ __forceinline__ float wave_max(float v) {
#pragma unroll
    for (int o = 1; o < 64; o <<= 1) v = fmaxf(v, __shfl_xor(v, o));
    return v;
}
template <int CTRL> __device__ __forceinline__ float dpp_f(float v) { return __int_as_float(__builtin_amdgcn_update_dpp(0, __float_as_int(v), CTRL, 0xf, 0xf, true)); }
__device__ __forceinline__ float sum_x16(float v) { auto rr = __builtin_amdgcn_permlane16_swap(__float_as_uint(v), __float_as_uint(v), false, false); return __uint_as_float(rr[0]) + __uint_as_float(rr[1]); }
__device__ __forceinline__ float sum_x32(float v) { auto rr = __builtin_amdgcn_permlane32_swap(__float_as_uint(v), __float_as_uint(v), false, false); return __uint_as_float(rr[0]) + __uint_as_float(rr[1]); }
__device__ __forceinline__ float sum_row16(float v) {
    v += dpp_f<0xB1>(v);
    v += dpp_f<0x4E>(v);
    v += dpp_f<0x141>(v);
    v += dpp_f<0x140>(v);
    return v; }
__device__ __forceinline__ float wsum(float v) { return sum_x32(sum_x16(sum_row16(v))); }
__device__ __forceinline__ float alibi_slope(int i) { return exp2f(-8.0f * (float)(i + 1) / 12.0f); }
__device__ __forceinline__ float sigmoidf_(float x) { return 1.0f / (1.0f + __expf(-x)); }

__device__ __forceinline__ void seg_build(const int* cnt, int* seg) {
    int a = 0;
    for (int e = 0; e < NE; ++e) { seg[e] = a; a += (cnt[e] + 255) & ~255; }
    seg[NE] = a;
}
__device__ __forceinline__ int tile_prefix(const volatile __attribute__((address_space(3))) unsigned* cntL, int e) {
    int a = 0;
#pragma unroll
    for (int j = 0; j < NE; ++j) { const int t = ((int)cntL[j] + 255) >> 8; a += (j < e) ? t : 0; }
    return a;
}

struct NormP {
    const float* xin;
    const bf16_t* xinb;
    float* X;
    bf16_t* Xb;
    bf16_t* H;
    const float* mod;
    const float* modprev;
    const float* gain;
    const bf16_t* Y; const int* toke; const int* tokp; const int* cntprev;
    const float* wf;
    const float* bf;
    float* lf;
    const float* wr; const float* br;
    int* cnt; int* toke_o; int* tokp_o; int* list; float* listw;
};

#define LAS __attribute__((address_space(3)))
#define GAS __attribute__((address_space(1)))
constexpr int NWAVES = 8, NTHR = 512;
constexpr int LDS_BYTES = 163840;
constexpr int LDS_CTL = 131072;
constexpr int LC_BAR = 0, LC_SEG = 16, LC_TPF = 64, LC_CNT = 128, LC_UT = 192;
constexpr int CW_BAR = 1024;
constexpr size_t WT_IN = 0, WT_BR = (size_t)PW * D, WT_OUT = WT_BR + (size_t)D * D, WT_W1 = WT_OUT + (size_t)D * D, WT_W2 = WT_W1 + (size_t)NE * 2048 * D, WT_LAYER = 216ull * MiB / 2;
static_assert(WT_W2 + (size_t)NE * D * D <= WT_LAYER, "weights per layer");

#define XB_TMO      128
#define XB_XCNT(j)  (256  + 64 * (j))
#define XB_XSUB(j)  (1280 + 64 * (j))
#define XB_XGEN(j)  (2304 + 64 * (j))
#define XB_TOP      3328
#define XB_TOPGEN   3392
#define XCD_BAR_WORDS 3456
#define XB_SPIN_CAP (1u << 18)
__device__ __forceinline__ unsigned xb_ld(unsigned* p)              { return __hip_atomic_load(p, __ATOMIC_RELAXED, __HIP_MEMORY_SCOPE_AGENT); }
__device__ __forceinline__ unsigned xb_add(unsigned* p, unsigned v) { return __hip_atomic_fetch_add(p, v, __ATOMIC_RELAXED, __HIP_MEMORY_SCOPE_AGENT); }
__device__ __forceinline__ int xb_lane() { unsigned z = 0u; asm volatile("" : "+v"(z)); return (int)__builtin_amdgcn_mbcnt_hi(~0u, __builtin_amdgcn_mbcnt_lo(~0u, z)); }
__device__ __forceinline__ unsigned xb_xcc_id() { return (unsigned)__builtin_amdgcn_s_getreg((3 << 11) | 20) & 0xFu; }
#define XB_SPIN(cond, bar) do { unsigned _sp = 0; while (cond) { __builtin_amdgcn_s_sleep(1); \
    if ((++_sp & 255u) == 0u) { if (xb_ld(&(bar)[XB_TMO])) break; if (_sp > XB_SPIN_CAP) { atomicAdd(&(bar)[XB_TMO], 1u); break; } } } } while (0)
struct XcdBarrier { unsigned* bar; unsigned x; volatile LAS unsigned* st; int wv; };
__device__ __forceinline__ XcdBarrier xcd_barrier_post(unsigned* bar, volatile LAS unsigned* st, int wv) {
    XcdBarrier b; b.bar = bar; b.x = xb_xcc_id(); b.st = st; b.wv = wv;
    if (wv == 0 && xb_lane() == 0) (void)xb_add(&bar[XB_XCNT(b.x)], 1u);
    return b;
}
__device__ __forceinline__ void xcd_barrier_complete(unsigned* bar, unsigned x, unsigned& nloc, unsigned& nx) {
    const unsigned G = gridDim.x * gridDim.y * gridDim.z;
    unsigned sum, cnt, mine, sp = 0u;
    for (;;) {
        sum = 0u; cnt = 0u; mine = 0u;
#pragma unroll
        for (unsigned j = 0; j < 16; ++j) { const unsigned c = xb_ld(&bar[XB_XCNT(j)]); sum += c; cnt += (c > 0u) ? 1u : 0u; mine = (j == x) ? c : mine; }
        if (sum == G) break;
        __builtin_amdgcn_s_sleep(1);
        if ((++sp & 255u) == 0u) { if (xb_ld(&bar[XB_TMO])) break; if (sp > XB_SPIN_CAP) { atomicAdd(&bar[XB_TMO], 1u); break; } }
    }
    nloc = mine > 0u ? mine : 1u; nx = cnt > 0u ? cnt : 1u;
}
__device__ __forceinline__ void xcd_barrier(const XcdBarrier& b) {
    asm volatile("s_waitcnt vmcnt(0)" ::: "memory");
    __syncthreads();
    if (b.wv == 0 && xb_lane() == 0) {
        unsigned* bar = b.bar; unsigned bx = b.x;
        asm volatile("" : "+s"(bar), "+s"(bx));
        __builtin_amdgcn_s_waitcnt(0);
        unsigned nloc = b.st[0], nx = b.st[1];
        if (nloc == 0u) { xcd_barrier_complete(bar, bx, nloc, nx); b.st[0] = nloc; b.st[1] = nx; }
        const unsigned old = xb_add(&bar[XB_XSUB(bx)], 1u);
        const unsigned gen = old / nloc;
        if (old + 1u == (gen + 1u) * nloc) {
            __builtin_amdgcn_fence(__ATOMIC_RELEASE, "agent");
            asm volatile("s_waitcnt vmcnt(0)" ::: "memory");
            const unsigned og = xb_add(&bar[XB_TOP], 1u);
            const unsigned tg = og / nx;
            if (og + 1u == (tg + 1u) * nx) xb_add(&bar[XB_TOPGEN], 1u);
            else XB_SPIN(xb_ld(&bar[XB_TOPGEN]) == tg, bar);
            __builtin_amdgcn_fence(__ATOMIC_ACQUIRE, "agent");
            xb_add(&bar[XB_XGEN(bx)], 1u);
            asm volatile("s_waitcnt vmcnt(0)" ::: "memory");
        } else {
            XB_SPIN(xb_ld(&bar[XB_XGEN(bx)]) == gen, bar);
            __builtin_amdgcn_fence(__ATOMIC_ACQUIRE, "agent");
            asm volatile("s_waitcnt vmcnt(0)" ::: "memory");
        }
    }
    __syncthreads();
}

__device__ __forceinline__ int lane_id() { unsigned z = 0u; asm volatile("" : "+v"(z)); return (int)__builtin_amdgcn_mbcnt_hi(~0u, __builtin_amdgcn_mbcnt_lo(~0u, z)); }
__device__ __forceinline__ int tid_of(int wv) { return wv * 64 + lane_id(); }
__device__ __forceinline__ int opaque_s(int v) { asm volatile("" : "+s"(v)); return v; }
__device__ __forceinline__ int opaque(int v) { asm volatile("" : "+v"(v)); return v; }
struct MArgs { const float* in[19]; float* out; unsigned char* ws; int ph_lo, ph_hi, li, pad; };
static_assert(sizeof(MArgs) == 19 * 8 + 8 + 8 + 16, "MArgs has no padding");

__device__ __forceinline__ void p0_mod(const float* __restrict__ c, const float* __restrict__ w_ada, const float* __restrict__ b_ada, float* __restrict__ mod, LAS float* lds, int wv) {
    LAS float* sc = lds;
    LAS float* red = lds + NB * D;
    const int lane = lane_id(), w = wv, tid = w * 64 + lane;
    for (int i = tid; i < NB * D; i += NTHR) { const float v = c[i]; sc[i] = v / (1.0f + __expf(-v)); }
    __syncthreads();
    const int cl = lane & 31, kp = lane >> 5;
    for (int u = blockIdx.x; u < NL * 6144 / 32; u += gridDim.x) {
        const int col = u * 32 + cl, l = col / 6144, j = col % 6144;
        const float* wp = w_ada + (size_t)l * D * 6144 + j + (size_t)(w * 128 + kp) * 6144;
        float acc[NB];
#pragma unroll
        for (int b = 0; b < NB; ++b) acc[b] = 0.f;
#pragma unroll 1
        for (int i0 = 0; i0 < 64; i0 += 32) { float wv[32];
#pragma unroll
            for (int i = 0; i < 32; ++i) wv[i] = __builtin_nontemporal_load(wp + (size_t)(2 * (i0 + i)) * 6144);
#pragma unroll
            for (int i = 0; i < 32; ++i) { const int k = w * 128 + 2 * (i0 + i) + kp;
#pragma unroll
                for (int b = 0; b < NB; ++b) acc[b] += sc[b * D + k] * wv[i]; } }
#pragma unroll
        for (int b = 0; b < NB; ++b) { acc[b] = sum_x32(acc[b]); if (lane < 32) red[(w * NB + b) * 32 + lane] = acc[b]; }
        __syncthreads();
        if (tid < 256) { const int b = tid >> 5, c = tid & 31; float a = 0.f;
#pragma unroll
          for (int ww = 0; ww < 8; ++ww) a += red[(ww * NB + b) * 32 + c];
          const int oc = u * 32 + c, ol = oc / 6144, oj = oc % 6144;
          mod[(size_t)(ol * NB + b) * 6144 + oj] = a + b_ada[ol * 6144 + oj]; }
        __syncthreads();
    }
}
__device__ __forceinline__ int inproj_slot(int n) {
    if (n >= 768 && n < 772) return -1;
    const int c = n < 768 ? n : n - 4; const int pn = c >> 8, cc = c & 255;
    return pn * 256 + ((cc >> 5) & 1) * 128 + (cc >> 6) * 32 + (cc & 31);
}
__device__ __forceinline__ int w1_slot(int n) { const int pn = n >> 8, cc = n & 255, o = cc >> 1, r = cc & 1; return pn * 256 + ((o >> 2) & 1) * 128 + (o >> 5) * 32 + ((o >> 3) & 3) * 8 + (o & 3) * 2 + r; }
constexpr int CV_IN = 16 * 169, CV_BF = 4 * 32, CV_BS = 8 * 32, CV_BM = 4 * 32, CV_O = 16 * 32, CV_1 = NE * 16 * 64, CV_2 = NE * 16 * 32;
constexpr int CV_S1 = CV_IN + CV_BF + CV_BS + CV_BM + CV_O, CV_PER_L = CV_S1 + CV_1 + CV_2, CV_N = NL * CV_PER_L;
constexpr int CW_CONVQ = 6016;
#ifndef CV_QUOTA
#define CV_QUOTA 8
#endif
typedef const __attribute__((address_space(4))) MArgs* KArgs;
__device__ __forceinline__ void conv_block(const float* __restrict__ W, int ldn, int k0, int n0, int nvalid, bf16_t* __restrict__ WT, int kdst0, int map, LAS float* scr, int lane) {
    const int nl = lane & 31;
    const float wsc = (map == 1 && n0 + nl >= GA + 4) ? -LOG2E : 1.0f;
    const bool inr = nl < nvalid;
    const float* wp = W + (size_t)(k0 + (lane >> 5)) * ldn + n0 + (inr ? nl : 0);
    const float wsz = inr ? wsc : 0.f;
    LAS float* sp = scr + (lane >> 5) * 33 + nl;
#pragma unroll
    for (int i0 = 0; i0 < 32; i0 += 16) { float v[16];
#pragma unroll
        for (int i = 0; i < 16; ++i) v[i] = __builtin_nontemporal_load(wp + (size_t)(2 * (i0 + i)) * ldn);
#pragma unroll
        for (int i = 0; i < 16; ++i) sp[(2 * (i0 + i)) * 33] = v[i] * wsz; }
    asm volatile("s_waitcnt lgkmcnt(0)" ::: "memory");
    const int c = lane & 7;
#pragma unroll
    for (int j = 0; j < 4; ++j) { const int n = (lane >> 3) + 8 * j; const LAS float* s = scr + (8 * c) * 33 + n;
        u32x4 o; o.x = pk2(s[0 * 33], s[1 * 33]); o.y = pk2(s[2 * 33], s[3 * 33]); o.z = pk2(s[4 * 33], s[5 * 33]); o.w = pk2(s[6 * 33], s[7 * 33]);
        int row = n0 + n; bool ok = n < nvalid;
        if (map == 1) { row = inproj_slot(ok ? row : 0); ok = ok && row >= 0; }
        else if (map == 2) row = w1_slot(row);
        if (ok) *(u32x4*)(WT + (size_t)row * D + kdst0 + k0 + 8 * c) = o; }
    asm volatile("s_waitcnt lgkmcnt(0)" ::: "memory");
}
__device__ __forceinline__ void conv_item(KArgs ka, bf16_t* __restrict__ wt, int it, LAS float* scr, int lane) {
    const int l = it / CV_PER_L; int r = it - l * CV_PER_L;
    bf16_t* wl = wt + (size_t)l * WT_LAYER;
    const float* W; bf16_t* WT; int ldn = D, kb, nb, nv = 32, kd = 0, map = 0;
    if (r < CV_IN) { kb = r / 169; nb = r - kb * 169; nv = (nb == 168) ? 4 : 32; W = ka->in[I_WIN] + (size_t)l * D * DIN; ldn = DIN; WT = wl + WT_IN; map = 1; }
    else if (r < CV_IN + CV_BF) { r -= CV_IN; kb = r >> 5; nb = r & 31; W = ka->in[I_WBF] + (size_t)l * 256 * D; WT = wl + WT_BR; }
    else if (r < CV_IN + CV_BF + CV_BS) { r -= CV_IN + CV_BF; kb = r >> 5; nb = r & 31; W = ka->in[I_WBS] + (size_t)l * 512 * D; WT = wl + WT_BR; kd = 256; }
    else if (r < CV_IN + CV_BF + CV_BS + CV_BM) { r -= CV_IN + CV_BF + CV_BS; kb = r >> 5; nb = r & 31; W = ka->in[I_WBM] + (size_t)l * 256 * D; WT = wl + WT_BR; kd = 768; }
    else if (r < CV_S1) { r -= CV_S1 - CV_O; kb = r >> 5; nb = r & 31; W = ka->in[I_WOUT] + (size_t)l * D * D; WT = wl + WT_OUT; }
    else if (r < CV_S1 + CV_1) { r -= CV_S1; const int e = r >> 10, q = r & 1023; kb = q >> 6; nb = q & 63; W = ka->in[I_W1] + ((size_t)l * NE + e) * D * 2048; ldn = 2048; WT = wl + WT_W1 + (size_t)e * 2048 * D; map = 2; }
    else { r -= CV_S1 + CV_1; const int e = r >> 9, q = r & 511; kb = q >> 5; nb = q & 31; W = ka->in[I_W2] + ((size_t)l * NE + e) * D * D; WT = wl + WT_W2 + (size_t)e * D * D; }
    conv_block(W, ldn, kb * 64, nb * 32, nv, WT, kd, map, scr, lane);
}
constexpr int LC_CVQ = 8;
__device__ __forceinline__ void conv_flush(KArgs ka, unsigned char* ws, LAS unsigned char* lds, int wv_, int need) {
    const int wv = opaque_s(wv_);
    unsigned* q = (unsigned*)ws + CW_CONVQ;
    const int lane = opaque(lane_id());
    LAS float* scr = (LAS float*)lds + wv * (64 * 33 + 16);
    bf16_t* wt = (bf16_t*)(ws + WS_WT);
    const int head = __builtin_amdgcn_readfirstlane((int)__hip_atomic_load(q, __ATOMIC_RELAXED, __HIP_MEMORY_SCOPE_AGENT));
    const int gw = opaque_s((int)blockIdx.x) * NWAVES + wv, NGW = opaque_s((int)gridDim.x * NWAVES);
#pragma unroll 1
    for (int it = head + gw; it < need; it += NGW) conv_item(ka, wt, it, scr, lane);
}
__device__ __forceinline__ void conv_raise(unsigned char* ws, int wv_, int need) {
    const int wv = opaque_s(wv_);
    if (blockIdx.x == 0 && wv == 0 && lane_id() == 0) (void)__hip_atomic_fetch_max((unsigned*)ws + CW_CONVQ, (unsigned)need, __ATOMIC_RELAXED, __HIP_MEMORY_SCOPE_AGENT);
}
__device__ __forceinline__ void conv_tail(KArgs ka, unsigned char* ws, LAS unsigned char* lds, volatile LAS unsigned* LC, int wv_, int npw) {
    const int wv = opaque_s(wv_);
    unsigned* q = (unsigned*)ws + CW_CONVQ;
    const int lane = opaque(lane_id());
    if (wv == 0 && lane == 0) LC[LC_CVQ] = __hip_atomic_fetch_add(q, (unsigned)(NWAVES * npw), __ATOMIC_RELAXED, __HIP_MEMORY_SCOPE_AGENT);
    __syncthreads();
    const int base = __builtin_amdgcn_readfirstlane((int)LC[LC_CVQ]);
    LAS float* scr = (LAS float*)lds + wv * (64 * 33 + 16);
    bf16_t* wt = (bf16_t*)(ws + WS_WT);
#pragma unroll 1
    for (int k = 0; k < npw; ++k) { const int it = base + k * NWAVES + wv; if (it < CV_N) conv_item(ka, wt, it, scr, lane); }
}

namespace pg {
constexpr int BM = 256, BK = 64, HALF = 128, HTB = HALF * BK * 2, STAGE_BYTES = 8 * HTB, KK = 1024, NT = KK / BK;
__device__ __forceinline__ int lds_byte(int r, int c) { const int st = (r >> 4) * 2 + (c >> 5), rr = r & 15, cc = c & 31, ob = rr * 64 + cc * 2; return st * 1024 + (ob ^ (((ob >> 9) & 1) << 5)); }
__device__ __forceinline__ void stage_rc(int b, int& R, int& C) { const int st = b / 1024, sb = b % 1024, swz = sb ^ (((sb >> 9) & 1) << 5); R = (st >> 1) * 16 + swz / 64; C = (st & 1) * 32 + (swz % 64) / 2; }
__device__ __forceinline__ int perm32(int rho) { const int n = rho >> 4, i = rho & 15; return 8 * (i >> 2) + 4 * n + (i & 3); }
struct Unit { int pm, pn, e, rb; };
__device__ __forceinline__ unsigned cvt_pk_bf16(float lo, float hi) { unsigned r; asm volatile("v_cvt_pk_bf16_f32 %0, %1, %2" : "=v"(r) : "v"(lo), "v"(hi)); return r; }
typedef f32x4 Acc[2][2][4][2];
template <class G>
__device__ __forceinline__ void gemm_phase(LAS unsigned char* lds, const G& g, int wv) {
    const int wid = wv, lane = opaque(lane_id()), tid = wid * 64 + lane, wr = wid >> 2, wc = wid & 3, fr = lane & 15, fq = lane >> 4;
    unsigned voffA[2], voffB[2];
    int Rr[2];
#pragma unroll
    for (int i = 0; i < 2; ++i) { int R, C; stage_rc(tid * 16 + i * 8192, R, C); Rr[i] = R; const int Rb = G::PERM ? ((R & ~31) + perm32(R & 31)) : R;
        voffA[i] = G::GATHER ? (unsigned)C * 2u : (unsigned)(R * g.lda() + C) * 2u; voffB[i] = (unsigned)(Rb * KK + C) * 2u; }
    const size_t kstep = (size_t)(BK * 2), hstep = (size_t)HALF * KK * 2;
    const size_t hstepA = G::GATHER ? 0 : (size_t)HALF * g.lda() * 2;
    const unsigned ldsw = (unsigned)wid * 1024u;
    const int aoff = lds_byte(wr * 64 + fr, fq * 8), boff = lds_byte(wc * 32 + fr, fq * 8);
#define PG_SA(b, h) (((b) * 2 + (h)) * HTB)
#define PG_SB(b, h) ((4 + (b) * 2 + (h)) * HTB)
#define PG_STAGE(bufoff, gbase, voff) do { _Pragma("unroll") for (int _i = 0; _i < 2; ++_i) \
        __builtin_amdgcn_global_load_lds((const unsigned*)((const char*)(gbase) + (voff)[_i]), (LAS unsigned*)(lds + (bufoff) + ldsw + _i * 8192), 16, 0, 0); } while (0)
#define PG_STAGE_A(bufoff, ab, h, go) do { if constexpr (G::GATHER) { PG_STAGE(bufoff, ab, (go)[h]); } else { PG_STAGE(bufoff, (ab) + (h) * hstepA, voffA); } } while (0)
#define PG_LDA(dst, b, h) do { _Pragma("unroll") for (int m = 0; m < 4; ++m) _Pragma("unroll") for (int k = 0; k < 2; ++k) dst[m][k] = *(const LAS bf16x8*)(lds + PG_SA(b, h) + aoff + m * 2048 + k * 1024); } while (0)
#define PG_LDB(dst, b, h) do { _Pragma("unroll") for (int n = 0; n < 2; ++n) _Pragma("unroll") for (int k = 0; k < 2; ++k) dst[n][k] = *(const LAS bf16x8*)(lds + PG_SB(b, h) + boff + n * 2048 + k * 1024); } while (0)
#define PG_MMA(ai, bj, At, Bt) do { __builtin_amdgcn_s_setprio(1); _Pragma("unroll") for (int m = 0; m < 4; ++m) _Pragma("unroll") for (int n = 0; n < 2; ++n) _Pragma("unroll") for (int k = 0; k < 2; ++k) \
        acc[ai][bj][m][n] = __builtin_amdgcn_mfma_f32_16x16x32_bf16(Bt[n][k], At[m][k], acc[ai][bj][m][n], 0, 0, 0); __builtin_amdgcn_s_setprio(0); } while (0)
#define PG_WAIT_V(n) asm volatile("s_waitcnt vmcnt(" #n ")" ::: "memory")
#define PG_WAIT_L(n) asm volatile("s_waitcnt lgkmcnt(" #n ")" ::: "memory")
#define PG_BAR __builtin_amdgcn_s_barrier()
#define PG_SCHED __builtin_amdgcn_sched_barrier(0)
    Unit cur, nxt; int ui = 0;
    if (!g.next(0, cur)) return;
    if constexpr (G::STAGGER > 0) {
        const unsigned long long t0 = __builtin_amdgcn_s_memrealtime(); const unsigned long long dl = (unsigned long long)(((int)blockIdx.x >> 3) & 31) * (G::STAGGER / 32);
        while (__builtin_amdgcn_s_memrealtime() - t0 < dl) __builtin_amdgcn_s_sleep(8);
    }
    Acc acc;
#pragma unroll
    for (int a = 0; a < 2; ++a)
#pragma unroll
        for (int b = 0; b < 2; ++b)
#pragma unroll
            for (int m = 0; m < 4; ++m)
#pragma unroll
                for (int n = 0; n < 2; ++n) acc[a][b][m][n] = (f32x4){0.f, 0.f, 0.f, 0.f};
    bf16x8 At[4][2], B0[2][2], B1[2][2];
    unsigned goC[2][2];
    if constexpr (G::GATHER) g.gather_offs(0, Rr, voffA, goC);
    const char* cA = g.a_tile(cur); const char* cB = g.b_tile(cur);
    PG_STAGE(PG_SB(0, 0), cB, voffB); PG_STAGE(PG_SB(0, 1), cB + hstep, voffB); PG_STAGE_A(PG_SA(0, 0), cA, 0, goC); PG_STAGE_A(PG_SA(0, 1), cA, 1, goC);
    if (wr == 1) PG_BAR;
    PG_WAIT_V(2); PG_BAR;
    PG_STAGE(PG_SB(1, 0), cB + kstep, voffB); PG_STAGE_A(PG_SA(1, 0), cA + kstep, 0, goC); PG_STAGE(PG_SB(1, 1), cB + hstep + kstep, voffB);
    PG_WAIT_V(6); PG_BAR;
    for (;;) {
        const bool has_next = g.next(ui + 1, nxt);
        const char* nA = has_next ? g.a_tile(nxt) : cA; const char* nB = has_next ? g.b_tile(nxt) : cB;
        for (int t = 0; t < NT; t += 2) {
            const bool last = (t == NT - 2);
            if constexpr (G::MID) { if (t == 4 || t == 12) { g.mid(acc, cur, t, wr, wc, opaque(fr), opaque(fq)); PG_SCHED; } }
            const char* a1 = cA + (size_t)(t + 1) * kstep;
            const char* a2 = last ? nA : cA + (size_t)(t + 2) * kstep; const char* b2 = last ? nB : cB + (size_t)(t + 2) * kstep;
            const char* a3 = a2 + kstep; const char* b3 = b2 + kstep;
            unsigned go2[2][2];
            if constexpr (G::GATHER) {
                if (last && has_next) g.gather_offs(ui + 1, Rr, voffA, go2);
                else {
#pragma unroll
                    for (int h = 0; h < 2; ++h)
#pragma unroll
                        for (int i = 0; i < 2; ++i) go2[h][i] = goC[h][i]; } }
            PG_LDB(B0, 0, 0); PG_LDB(B1, 0, 1); PG_SCHED; PG_LDA(At, 0, 0); PG_STAGE_A(PG_SA(1, 1), a1, 1, goC);
            PG_WAIT_V(8); PG_WAIT_L(0); PG_BAR; PG_MMA(0, 0, At, B0); PG_MMA(0, 1, At, B1); PG_BAR; PG_SCHED;
            PG_LDA(At, 0, 1); PG_STAGE(PG_SB(0, 0), b2, voffB); PG_STAGE(PG_SB(0, 1), b2 + hstep, voffB); PG_STAGE_A(PG_SA(0, 0), a2, 0, go2);
            PG_WAIT_V(8); PG_WAIT_L(0); PG_BAR; PG_MMA(1, 0, At, B0); PG_MMA(1, 1, At, B1); PG_BAR; PG_SCHED;
            PG_LDB(B0, 1, 0); PG_LDB(B1, 1, 1); PG_SCHED; PG_LDA(At, 1, 0); PG_STAGE_A(PG_SA(0, 1), a2, 1, go2);
            PG_WAIT_V(8); PG_WAIT_L(0); PG_BAR; PG_MMA(0, 0, At, B0); PG_MMA(0, 1, At, B1); PG_BAR; PG_SCHED;
            PG_LDA(At, 1, 1); PG_STAGE(PG_SB(1, 0), b3, voffB); PG_STAGE(PG_SB(1, 1), b3 + hstep, voffB); PG_STAGE_A(PG_SA(1, 0), a3, 0, go2);
            PG_WAIT_V(8); PG_WAIT_L(0); PG_BAR; PG_MMA(1, 0, At, B0); PG_MMA(1, 1, At, B1); PG_BAR; PG_SCHED;
        }
        if (wr == 0) PG_BAR;
        if (!(g.dry && PROBE_DRY)) g.epi(acc, cur, wr, wc, opaque(fr), opaque(fq));
        if (!has_next) break;
#pragma unroll
        for (int a = 0; a < 2; ++a)
#pragma unroll
            for (int b = 0; b < 2; ++b)
#pragma unroll
                for (int m = 0; m < 4; ++m)
#pragma unroll
                    for (int n = 0; n < 2; ++n) acc[a][b][m][n] = (f32x4){0.f, 0.f, 0.f, 0.f};
        cur = nxt; cA = nA; cB = nB; ++ui;
        if constexpr (G::GATHER) g.gather_offs(ui, Rr, voffA, goC);
        if (wr == 1) PG_BAR;
    }
    PG_WAIT_V(0);
    PG_BAR;
#undef PG_SA
#undef PG_SB
#undef PG_STAGE
#undef PG_STAGE_A
#undef PG_LDA
#undef PG_LDB
#undef PG_MMA
#undef PG_WAIT_V
#undef PG_WAIT_L
#undef PG_BAR
#undef PG_SCHED
}

struct TileOrder {
    int nM, nN, nwg, G, c;
    __device__ __forceinline__ void init(int nM_, int nN_, int G_, int c_) { nM = nM_; nN = nN_; nwg = nM * nN; G = G_; c = c_; }
    __device__ __forceinline__ bool next(int i, Unit& u) const {
        const long L = (long)i * G + c; if (L >= nwg) return false;
        int wgid = (int)L; { const int q = nwg / 8, r = nwg % 8, xcd = wgid % 8, off = wgid / 8; wgid = (xcd < r ? xcd * (q + 1) : r * (q + 1) + (xcd - r) * q) + off; }
        const int nig = 8 * nN, gid = wgid / nig, fm = gid * 8, gsz = (nM - fm) < 8 ? (nM - fm) : 8;
        u.pm = fm + ((wgid % nig) % gsz); u.pn = (wgid % nig) / gsz; u.e = 0; u.rb = u.pm * BM; return true;
    }
};
struct GOut {
    static constexpr bool PERM = true, MID = false, GATHER = false; static constexpr int STAGGER = 0;
    TileOrder ord; const bf16_t* A; const bf16_t* Bt; bf16_t* X; const float* modl; int dry;
    __device__ __forceinline__ bool next(int i, Unit& u) const { return ord.next(i, u); }
    __device__ __forceinline__ int lda() const { return D; }
    __device__ __forceinline__ void gather_offs(int, const int (&)[2], const unsigned (&)[2], unsigned (&)[2][2]) const {}
    __device__ __forceinline__ const char* a_tile(const Unit& u) const { return (const char*)(A + (size_t)u.pm * BM * D); }
    __device__ __forceinline__ const char* b_tile(const Unit& u) const { return (const char*)(Bt + (size_t)u.pn * BM * KK); }
    __device__ __forceinline__ void mid(Acc&, const Unit&, int, int, int, int, int) const {}
    __device__ __forceinline__ void epi(Acc& acc, const Unit& u, int wr, int wc, int fr, int fq) const {
        const int row0 = u.pm * BM + wr * 64 + fr, col0 = u.pn * BM + wc * 32 + 8 * fq;
        const float* g1 = modl + (size_t)(u.pm >> 4) * 6144 + 2 * D;
        f32x4 gv[2][2];
#pragma unroll
        for (int bj = 0; bj < 2; ++bj)
#pragma unroll
            for (int n = 0; n < 2; ++n) gv[bj][n] = *(const f32x4*)(g1 + col0 + bj * HALF + 4 * n);
#pragma unroll
        for (int ai = 0; ai < 2; ++ai) {
            u32x4 x[4][2];
#pragma unroll
            for (int m = 0; m < 4; ++m)
#pragma unroll
                for (int bj = 0; bj < 2; ++bj) x[m][bj] = *(const u32x4*)(X + (size_t)(row0 + ai * HALF + m * 16) * D + col0 + bj * HALF);
#pragma unroll
            for (int m = 0; m < 4; ++m)
#pragma unroll
                for (int bj = 0; bj < 2; ++bj) { const u32x4 xo = x[m][bj]; const f32x4 a0 = acc[ai][bj][m][0] * gv[bj][0], a1 = acc[ai][bj][m][1] * gv[bj][1];
                    u32x4 w; w.x = cvt_pk_bf16(bf2f(xo.x & 0xffffu) + a0[0], bf2f(xo.x >> 16) + a0[1]); w.y = cvt_pk_bf16(bf2f(xo.y & 0xffffu) + a0[2], bf2f(xo.y >> 16) + a0[3]);
                    w.z = cvt_pk_bf16(bf2f(xo.z & 0xffffu) + a1[0], bf2f(xo.z >> 16) + a1[1]); w.w = cvt_pk_bf16(bf2f(xo.w & 0xffffu) + a1[2], bf2f(xo.w >> 16) + a1[3]);
                    *(u32x4*)(X + (size_t)(row0 + ai * HALF + m * 16) * D + col0 + bj * HALF) = w; }
            asm volatile("" ::: "memory"); }
    }
};

struct GBranch {
    static constexpr bool PERM = true, MID = true, GATHER = false; static constexpr int STAGGER = 0;
    TileOrder ord; const bf16_t* A; const bf16_t* Bt; const bf16_t* PROJ; bf16_t* MERGED; int dry;
    __device__ __forceinline__ bool next(int i, Unit& u) const { return ord.next(i, u); }
    __device__ __forceinline__ int lda() const { return D; }
    __device__ __forceinline__ void gather_offs(int, const int (&)[2], const unsigned (&)[2], unsigned (&)[2][2]) const {}
    __device__ __forceinline__ const char* a_tile(const Unit& u) const { return (const char*)(A + (size_t)u.pm * BM * D); }
    __device__ __forceinline__ const char* b_tile(const Unit& u) const { return (const char*)(Bt + (size_t)u.pn * BM * KK); }
    __device__ __forceinline__ void mid(Acc& acc, const Unit& u, int t, int wr, int wc, int fr, int fq) const {
        const int num = (t == 4) ? GA : GB, den = (t == 4) ? GB : GC;
        const int row0 = u.pm * BM + wr * 64 + fr, col0 = u.pn * BM + wc * 32 + 8 * fq;
#pragma unroll
        for (int ai = 0; ai < 2; ++ai) {
            u32x4 gn[4][2], gd[4][2];
#pragma unroll
            for (int m = 0; m < 4; ++m) { const bf16_t* pr = PROJ + (size_t)(row0 + ai * HALF + m * 16) * PW + col0;
#pragma unroll
                for (int bj = 0; bj < 2; ++bj) { gn[m][bj] = *(const u32x4*)(pr + num + bj * HALF); gd[m][bj] = *(const u32x4*)(pr + den + bj * HALF); } }
#pragma unroll
            for (int m = 0; m < 4; ++m)
#pragma unroll
                for (int bj = 0; bj < 2; ++bj)
#pragma unroll
                    for (int i = 0; i < 4; ++i) {
                        const float r0 = bf2f(gn[m][bj][i] & 0xffffu) * __builtin_amdgcn_rcpf(fmaxf(bf2f(gd[m][bj][i] & 0xffffu), 1e-30f));
                        const float r1 = bf2f(gn[m][bj][i] >> 16) * __builtin_amdgcn_rcpf(fmaxf(bf2f(gd[m][bj][i] >> 16), 1e-30f));
                        acc[ai][bj][m][i >> 1][(i & 1) * 2] *= r0; acc[ai][bj][m][i >> 1][(i & 1) * 2 + 1] *= r1; }
            asm volatile("" ::: "memory"); }
    }
    __device__ __forceinline__ void epi(Acc& acc, const Unit& u, int wr, int wc, int fr, int fq) const {
        const int row0 = u.pm * BM + wr * 64 + fr, col0 = u.pn * BM + wc * 32 + 8 * fq;
#pragma unroll
        for (int ai = 0; ai < 2; ++ai) {
            u32x4 gcv[4][2];
#pragma unroll
            for (int m = 0; m < 4; ++m)
#pragma unroll
                for (int bj = 0; bj < 2; ++bj) gcv[m][bj] = *(const u32x4*)(PROJ + (size_t)(row0 + ai * HALF + m * 16) * PW + GC + col0 + bj * HALF);
#pragma unroll
            for (int m = 0; m < 4; ++m) { const size_t row = (size_t)(row0 + ai * HALF + m * 16);
#pragma unroll
                for (int bj = 0; bj < 2; ++bj) { const u32x4 gc = gcv[m][bj];
                    const f32x4 v0 = acc[ai][bj][m][0], v1 = acc[ai][bj][m][1];
                    u32x4 w; w.x = cvt_pk_bf16(v0[0] * bf2f(gc.x & 0xffffu), v0[1] * bf2f(gc.x >> 16)); w.y = cvt_pk_bf16(v0[2] * bf2f(gc.y & 0xffffu), v0[3] * bf2f(gc.y >> 16));
                    w.z = cvt_pk_bf16(v1[0] * bf2f(gc.z & 0xffffu), v1[1] * bf2f(gc.z >> 16)); w.w = cvt_pk_bf16(v1[2] * bf2f(gc.w & 0xffffu), v1[3] * bf2f(gc.w >> 16));
                    *(u32x4*)(MERGED + row * D + col0 + bj * HALF) = w; } }
            asm volatile("" ::: "memory"); }
    }
};

struct GIn {
    static constexpr bool PERM = true, MID = false, GATHER = false; static constexpr int STAGGER = 0;
    TileOrder ord; const bf16_t* A; const bf16_t* Bt; bf16_t* PROJ; const float* qkg; float* kmean; int dry;
    __device__ __forceinline__ bool next(int i, Unit& u) const { return ord.next(i, u); }
    __device__ __forceinline__ int lda() const { return D; }
    __device__ __forceinline__ void gather_offs(int, const int (&)[2], const unsigned (&)[2], unsigned (&)[2][2]) const {}
    __device__ __forceinline__ const char* a_tile(const Unit& u) const { return (const char*)(A + (size_t)u.pm * BM * D); }
    __device__ __forceinline__ const char* b_tile(const Unit& u) const { return (const char*)(Bt + (size_t)u.pn * BM * KK); }
    __device__ __forceinline__ void mid(Acc&, const Unit&, int, int, int, int, int) const {}
    __device__ __forceinline__ void epi(Acc& acc, const Unit& u, int wr, int wc, int fr, int fq) const {
        const int c0 = u.pn * BM + wc * 64;
        int kind, gi = 0;
        if (c0 < 256) { kind = 1; gi = 0; } else if (c0 < 512) { kind = 2; gi = 1; } else if (c0 < 768) kind = 0;
        else if (c0 < 1280) { kind = 1; gi = 2; } else if (c0 < 1408) { kind = 2; gi = 3; } else if (c0 < 1536) kind = 0;
        else if (c0 < 1792) { kind = 1; gi = 4; } else if (c0 < 2048) { kind = 2; gi = 5; } else if (c0 < 2304) kind = 0; else kind = 3;
        const bool mk = (c0 >= MK && c0 < MV) && !dry;
        const int row0 = u.pm * BM + wr * 64 + fr;
        bf16_t* pbase = PROJ + (size_t)row0 * PW + c0 + 8 * fq;
        if (kind == 1 || kind == 2) {
            f32x4 gq[2][2]; f32x4 ks[2][2];
#pragma unroll
            for (int bj = 0; bj < 2; ++bj)
#pragma unroll
                for (int n = 0; n < 2; ++n) { gq[bj][n] = *(const f32x4*)(qkg + gi * 64 + 32 * bj + 8 * fq + 4 * n); ks[bj][n] = (f32x4){0.f, 0.f, 0.f, 0.f}; }
            const float post = (kind == 1) ? C2 : 1.0f;
#pragma unroll
            for (int ai = 0; ai < 2; ++ai)
#pragma unroll
                for (int m = 0; m < 4; ++m) {
                    float ss = 0.f;
#pragma unroll
                    for (int bj = 0; bj < 2; ++bj)
#pragma unroll
                        for (int n = 0; n < 2; ++n) { const f32x4 x = acc[ai][bj][m][n]; ss += (x[0] * x[0] + x[1] * x[1]) + (x[2] * x[2] + x[3] * x[3]); }
                    ss = sum_x32(sum_x16(ss));
                    const float r = rsqrtf(ss * (1.0f / 64.0f) + EPS) * post;
                    bf16_t* rowp = pbase + (size_t)(ai * HALF + m * 16) * PW;
#pragma unroll
                    for (int bj = 0; bj < 2; ++bj) { const f32x4 v0 = acc[ai][bj][m][0] * r * gq[bj][0], v1 = acc[ai][bj][m][1] * r * gq[bj][1];
                        u32x4 w; w.x = cvt_pk_bf16(v0[0], v0[1]); w.y = cvt_pk_bf16(v0[2], v0[3]); w.z = cvt_pk_bf16(v1[0], v1[1]); w.w = cvt_pk_bf16(v1[2], v1[3]);
                        *(u32x4*)(rowp + 32 * bj) = w;
                        if (mk) { ks[bj][0][0] += bf2f(w.x & 0xffffu); ks[bj][0][1] += bf2f(w.x >> 16); ks[bj][0][2] += bf2f(w.y & 0xffffu); ks[bj][0][3] += bf2f(w.y >> 16);
                                  ks[bj][1][0] += bf2f(w.z & 0xffffu); ks[bj][1][1] += bf2f(w.z >> 16); ks[bj][1][2] += bf2f(w.w & 0xffffu); ks[bj][1][3] += bf2f(w.w >> 16); } }
                    asm volatile("" ::: "memory");
                }
            if (mk) {
                float* km = kmean + (size_t)u.pm * 256 + wc * 64 + 8 * fq;
#pragma unroll
                for (int bj = 0; bj < 2; ++bj)
#pragma unroll
                    for (int n = 0; n < 2; ++n)
#pragma unroll
                        for (int i = 0; i < 4; ++i) { float v = ks[bj][n][i]; v = sum_row16(v);
                            if (fr == 0) atomicAdd(km + 32 * bj + 4 * n + i, v); }
            }
        } else if (kind == 3) {
#pragma unroll
            for (int ai = 0; ai < 2; ++ai)
#pragma unroll
                for (int m = 0; m < 4; ++m) { bf16_t* rowp = pbase + (size_t)(ai * HALF + m * 16) * PW;
#pragma unroll
                    for (int bj = 0; bj < 2; ++bj) { f32x4 v0, v1;
#pragma unroll
                        for (int i = 0; i < 4; ++i) { v0[i] = __builtin_amdgcn_rcpf(1.0f + __builtin_amdgcn_exp2f(acc[ai][bj][m][0][i])); v1[i] = __builtin_amdgcn_rcpf(1.0f + __builtin_amdgcn_exp2f(acc[ai][bj][m][1][i])); }
                        u32x4 w; w.x = cvt_pk_bf16(v0[0], v0[1]); w.y = cvt_pk_bf16(v0[2], v0[3]); w.z = cvt_pk_bf16(v1[0], v1[1]); w.w = cvt_pk_bf16(v1[2], v1[3]);
                        __builtin_nontemporal_store(w, (u32x4*)(rowp + 32 * bj)); }
                    asm volatile("" ::: "memory"); }
        } else {
#pragma unroll
            for (int ai = 0; ai < 2; ++ai)
#pragma unroll
                for (int m = 0; m < 4; ++m) { bf16_t* rowp = pbase + (size_t)(ai * HALF + m * 16) * PW;
#pragma unroll
                    for (int bj = 0; bj < 2; ++bj) { const f32x4 v0 = acc[ai][bj][m][0], v1 = acc[ai][bj][m][1];
                        u32x4 w; w.x = cvt_pk_bf16(v0[0], v0[1]); w.y = cvt_pk_bf16(v0[2], v0[3]); w.z = cvt_pk_bf16(v1[0], v1[1]); w.w = cvt_pk_bf16(v1[2], v1[3]);
                        *(u32x4*)(rowp + 32 * bj) = w; }
                    asm volatile("" ::: "memory"); }
        }
    }
};

constexpr int LDS_GTAB = LDS_CTL + 2048, GTAB_UNITS = 24;
__device__ __forceinline__ int moe_find(const LAS unsigned* LCn, int mg) { int e = 0;
#pragma unroll
    for (int st = 16; st >= 1; st >>= 1) e = ((int)LCn[LC_TPF + e + st] <= mg) ? e + st : e;
    return e; }
template <int NN>
__device__ __forceinline__ bool moe_unit(const volatile LAS unsigned* LCv, int c, int G, int i, Unit& u) {
    const LAS unsigned* LC = (const LAS unsigned*)LCv;
    const int W = G >> 3, x = c & 7, j = c >> 3;
    const int U = (int)LC[LC_TPF + NE] * NN, q = U >> 3, r = U & 7;
    const int start = (x < r) ? x * (q + 1) : r * (q + 1) + (x - r) * q, len = q + (x < r ? 1 : 0);
    const int li = i * W + j; if (li >= len) return false;
    const int L = (NN == 4) ? start + len - 1 - li : start + li, mgl = L / NN;
    const int e = moe_find(LC, mgl);
    const int t0 = (int)LC[LC_TPF + e], mte = (int)LC[LC_TPF + e + 1] - t0, idx = L - t0 * NN;
    const int nig = 8 * NN, gid = idx / nig, fm = gid * 8, gsz = (mte - fm) < 8 ? (mte - fm) : 8, rem = idx - gid * nig;
    u.pm = t0 + fm + rem % gsz; u.pn = rem / gsz; u.e = e; u.rb = u.pm * BM; return true;
}
struct GMoe1 {
    static constexpr bool PERM = true, MID = false, GATHER = true; static constexpr int STAGGER = 0;
    const volatile LAS unsigned* LC; const LAS unsigned short* gtab; const bf16_t* A; const bf16_t* Bt; const float* b1; bf16_t* A2; int c; int dry;
    __device__ __forceinline__ bool next(int i, Unit& u) const { if (i >= GTAB_UNITS) return false;
        const unsigned w = (unsigned)__builtin_amdgcn_readfirstlane((int)((const LAS unsigned*)LC)[LC_UT + i]); if (!(w >> 31)) return false;
        u.pm = (int)(w & 1023u); u.pn = (int)((w >> 10) & 7u); u.e = (int)((w >> 13) & 31u); u.rb = u.pm * BM; return true; }
    __device__ __forceinline__ int lda() const { return D; }
    __device__ __forceinline__ void gather_offs(int ui, const int (&R)[2], const unsigned (&voffA)[2], unsigned (&go)[2][2]) const {
#pragma unroll
        for (int h = 0; h < 2; ++h)
#pragma unroll
            for (int i = 0; i < 2; ++i) go[h][i] = (unsigned)gtab[ui * 256 + h * HALF + R[i]] * (unsigned)(D * 2) + voffA[i]; }
    __device__ __forceinline__ const char* a_tile(const Unit&) const { return (const char*)A; }
    __device__ __forceinline__ const char* b_tile(const Unit& u) const { return (const char*)(Bt + ((size_t)u.e * 2048 + (size_t)u.pn * BM) * KK); }
    __device__ __forceinline__ void mid(Acc&, const Unit&, int, int, int, int, int) const {}
    __device__ __forceinline__ void epi(Acc& acc, const Unit& u, int wr, int wc, int fr, int fq) const {
        const int row0 = u.rb + wr * 64 + fr, ucol = u.pn * BM + wc * 64 + 16 * fq, ocol = u.pn * (BM / 2) + wc * 32 + 8 * fq;
        const float* bp = b1 + (size_t)u.e * 2048 + ucol;
        const f32x4 bv00 = *(const f32x4*)(bp), bv01 = *(const f32x4*)(bp + 4), bv10 = *(const f32x4*)(bp + 8), bv11 = *(const f32x4*)(bp + 12);
#pragma unroll
        for (int ai = 0; ai < 2; ++ai)
#pragma unroll
            for (int m = 0; m < 4; ++m) { bf16_t* rowp = A2 + (size_t)(row0 + ai * HALF + m * 16) * D + ocol;
                u32x4 w;
#pragma unroll
                for (int bj = 0; bj < 2; ++bj) { const f32x4 v0 = acc[ai][bj][m][0] + (bj ? bv10 : bv00), v1 = acc[ai][bj][m][1] + (bj ? bv11 : bv01);
                    float o[4];
#pragma unroll
                    for (int q = 0; q < 4; ++q) { float gl = (q < 2) ? v0[2 * q] : v1[2 * q - 4], ln = (q < 2) ? v0[2 * q + 1] : v1[2 * q - 3];
                        gl = fminf(gl, 7.0f); ln = fminf(fmaxf(ln, -7.0f), 7.0f);
                        o[q] = gl * __builtin_amdgcn_rcpf(1.0f + __builtin_amdgcn_exp2f(gl * (-1.702f * LOG2E))) * (ln + 1.0f); }
                    if (bj == 0) { w.x = cvt_pk_bf16(o[0], o[1]); w.y = cvt_pk_bf16(o[2], o[3]); } else { w.z = cvt_pk_bf16(o[0], o[1]); w.w = cvt_pk_bf16(o[2], o[3]); } }
                *(u32x4*)rowp = w;
                asm volatile("" ::: "memory"); }
    }
};
struct GMoe2 {
    static constexpr bool PERM = true, MID = false, GATHER = false; static constexpr int STAGGER = 0;
    const volatile LAS unsigned* LC; const bf16_t* A; const bf16_t* Bt; const float* b2; const float* listw; bf16_t* Y; int c; int dry;
    __device__ __forceinline__ bool next(int i, Unit& u) const { if (i >= GTAB_UNITS) return false;
        const unsigned w = (unsigned)__builtin_amdgcn_readfirstlane((int)((const LAS unsigned*)LC)[LC_UT + i]); if (!(w >> 31)) return false;
        u.pm = (int)(w & 1023u); u.pn = (int)((w >> 10) & 7u); u.e = (int)((w >> 13) & 31u); u.rb = u.pm * BM; return true; }
    __device__ __forceinline__ int lda() const { return D; }
    __device__ __forceinline__ void gather_offs(int, const int (&)[2], const unsigned (&)[2], unsigned (&)[2][2]) const {}
    __device__ __forceinline__ const char* a_tile(const Unit& u) const { return (const char*)(A + (size_t)u.rb * D); }
    __device__ __forceinline__ const char* b_tile(const Unit& u) const { return (const char*)(Bt + ((size_t)u.e * D + (size_t)u.pn * BM) * KK); }
    __device__ __forceinline__ void mid(Acc&, const Unit&, int, int, int, int, int) const {}
    __device__ __forceinline__ void epi(Acc& acc, const Unit& u, int wr, int wc, int fr, int fq) const {
        const int row0 = u.rb + wr * 64 + fr, col0 = u.pn * BM + wc * 32 + 8 * fq;
        const int p0 = row0 - (int)LC[LC_TPF + u.e] * BM, cn = (int)LC[LC_CNT + u.e];
        const float* bp = b2 + (size_t)u.e * D + col0;
        float gw[2][4];
#pragma unroll
        for (int ai = 0; ai < 2; ++ai)
#pragma unroll
            for (int m = 0; m < 4; ++m) { const int pos = p0 + ai * HALF + m * 16; gw[ai][m] = (pos < cn) ? listw[(size_t)u.e * CAP + pos] : 0.f; }
        f32x4 bv[2][2];
#pragma unroll
        for (int bj = 0; bj < 2; ++bj)
#pragma unroll
            for (int n = 0; n < 2; ++n) bv[bj][n] = *(const f32x4*)(bp + bj * HALF + 4 * n);
#pragma unroll
        for (int ai = 0; ai < 2; ++ai)
#pragma unroll
            for (int m = 0; m < 4; ++m) { const float g = gw[ai][m];
                bf16_t* rowp = Y + (size_t)(row0 + ai * HALF + m * 16) * D + col0;
#pragma unroll
                for (int bj = 0; bj < 2; ++bj) { const f32x4 v0 = (acc[ai][bj][m][0] + bv[bj][0]) * g, v1 = (acc[ai][bj][m][1] + bv[bj][1]) * g;
                    u32x4 w; w.x = cvt_pk_bf16(v0[0], v0[1]); w.y = cvt_pk_bf16(v0[2], v0[3]); w.z = cvt_pk_bf16(v1[0], v1[1]); w.w = cvt_pk_bf16(v1[2], v1[3]);
                    *(u32x4*)(rowp + bj * HALF) = w; } }
    }
};
}

namespace at {
constexpr int L_K = 0, L_V = 24576, L_BIAS = 49152, L_SEL = 65536, L_GATE = 66560, L_RED = 84992, L_KM = 86016;
typedef short v4i16_t __attribute__((ext_vector_type(4)));
__device__ __forceinline__ int crow(int r, int hi) { return (r & 3) + 8 * (r >> 2) + 4 * hi; }
__device__ __forceinline__ float halves_max(float m) { auto rr = __builtin_amdgcn_permlane32_swap(__float_as_uint(m), __float_as_uint(m), false, false); return fmaxf(__uint_as_float(rr[0]), __uint_as_float(rr[1])); }
__device__ __forceinline__ float halves_sum(float m) { auto rr = __builtin_amdgcn_permlane32_swap(__float_as_uint(m), __float_as_uint(m), false, false); return __uint_as_float(rr[0]) + __uint_as_float(rr[1]); }
__device__ __forceinline__ unsigned cvtpk(float lo, float hi) { unsigned r; asm volatile("v_cvt_pk_bf16_f32 %0, %1, %2" : "=v"(r) : "v"(lo), "v"(hi)); return r; }

template <int VAR  >
__device__ __forceinline__ void attn_unit(LAS unsigned char* lds, int b, int h, int qb, const bf16_t* __restrict__ PROJ, const float* __restrict__ lf, const float* __restrict__ kmean, const float* __restrict__ sinks, bf16_t* __restrict__ OCAT, int wv, const float* __restrict__ qkg = nullptr) {
    const int w = wv, lane = opaque(lane_id()), tid = w * 64 + lane, r32 = lane & 31, hi = lane >> 5;
    const int q0 = qb * 256, n_keys = q0 + 256;
    int qoff, koff, voff, ooff; float slope2 = 0.f;
    if (VAR == 0) { qoff = FQ + h * 64; koff = FK + h * 64; voff = FV + h * 64; ooff = h * 64; }
    else if (VAR == 1) { qoff = SQ + h * 64; koff = SK + (h >> 2) * 64; voff = SV + (h >> 2) * 64; ooff = 256 + h * 64; slope2 = alibi_slope(h) * LOG2E; }
    else { qoff = MQ + h * 64; koff = MK + h * 64; voff = MV + h * 64; ooff = 768 + h * 64; slope2 = alibi_slope(8 + h) * LOG2E; }
    const bf16_t* base = PROJ + (size_t)b * S * PW;
    LAS float* biasT = (LAS float*)(lds + L_BIAS);
    LAS float* red = (LAS float*)(lds + L_RED);
    int t_lo = (VAR == 1) ? (qb > 0 ? 4 * qb - 2 : 0) : 0; const int t_hi = 4 * qb + 4;
    if (VAR == 0) {
        float c8[8]; const int s0 = 8 * tid;
        if (s0 < n_keys) { const f32x4 a = *(const f32x4*)(lf + (size_t)(b * 4 + h) * S + s0), c = *(const f32x4*)(lf + (size_t)(b * 4 + h) * S + s0 + 4);
            c8[0] = a[0]; c8[1] = c8[0] + a[1]; c8[2] = c8[1] + a[2]; c8[3] = c8[2] + a[3]; c8[4] = c8[3] + c[0]; c8[5] = c8[4] + c[1]; c8[6] = c8[5] + c[2]; c8[7] = c8[6] + c[3]; }
        else {
#pragma unroll
            for (int i = 0; i < 8; ++i) c8[i] = 0.f; }
        float incl = c8[7];
#pragma unroll
        for (int o = 1; o < 64; o <<= 1) { const float v = __int_as_float(__builtin_amdgcn_ds_bpermute((lane - o) << 2, __float_as_int(incl))); if (lane >= o) incl += v; }
        if (lane == 63) red[w] = incl;
        __syncthreads();
        float wp = 0.f;
#pragma unroll
        for (int i = 0; i < 8; ++i) wp += (i < w) ? red[i] : 0.f;
        const float offs = wp + incl - c8[7];
#pragma unroll
        for (int i = 0; i < 8; ++i) c8[i] += offs;
        if (s0 == q0) red[15] = c8[0];
        if (tid == 0) ((LAS int*)red)[14] = 1 << 20;
        __syncthreads();
        const float cref = red[15];
        if (s0 < n_keys) { *(LAS f32x4*)(biasT + s0) = (f32x4){(cref - c8[0]) * LOG2E, (cref - c8[1]) * LOG2E, (cref - c8[2]) * LOG2E, (cref - c8[3]) * LOG2E};
                           *(LAS f32x4*)(biasT + s0 + 4) = (f32x4){(cref - c8[4]) * LOG2E, (cref - c8[5]) * LOG2E, (cref - c8[6]) * LOG2E, (cref - c8[7]) * LOG2E}; }
        { float gq = fabsf(qkg[lane]), gk = fabsf(qkg[64 + lane]);
#pragma unroll
          for (int o = 0; o < 6; ++o) { gq = fmaxf(gq, __int_as_float(__builtin_amdgcn_ds_bpermute((lane ^ (1 << o)) << 2, __float_as_int(gq)))); gk = fmaxf(gk, __int_as_float(__builtin_amdgcn_ds_bpermute((lane ^ (1 << o)) << 2, __float_as_int(gk)))); }
          const float thr = 2.0f * (64.0f * C2 * 1.02f) * gq * gk + 40.0f;
          if ((tid & 7) == 7 && s0 < n_keys && (cref - c8[7]) * LOG2E >= -thr) atomicMin((int*)((LAS int*)red + 14), tid >> 3); }
        __syncthreads();
        t_lo = ((LAS int*)red)[14] & ~1;
    } else {
        for (int s = 64 * t_lo + tid; s < n_keys; s += NTHR) biasT[s] = slope2 * (float)(s - q0);
    }
    unsigned selmask = 0u;
    if (VAR == 2 && qb > 0) {
        LAS float* gate = (LAS float*)(lds + L_GATE);
        LAS float* kmL = (LAS float*)(lds + L_KM);
        if (tid < qb * 16) *(LAS f32x4*)(kmL + 4 * tid) = *(const f32x4*)(kmean + (size_t)(b * 16 + (tid >> 4)) * 256 + h * 64 + 4 * (tid & 15));
        { const int q = (w & 3) * 64 + lane, half = w >> 2;
          float qf[64];
          const u32x4* qp = (const u32x4*)(base + (size_t)(q0 + q) * PW + qoff);
#pragma unroll
          for (int c = 0; c < 8; ++c) { const u32x4 x = qp[c];
#pragma unroll
              for (int i = 0; i < 4; ++i) { qf[8 * c + 2 * i] = bf2f(x[i] & 0xffffu); qf[8 * c + 2 * i + 1] = bf2f(x[i] >> 16); } }
          __syncthreads();
          for (int j = half; j < qb; j += 2) { const LAS f32x4* km = (const LAS f32x4*)(kmL + j * 64); float a = 0.f;
#pragma unroll
              for (int d4 = 0; d4 < 16; ++d4) { const f32x4 kv = km[d4]; a += qf[4 * d4] * kv[0]; a += qf[4 * d4 + 1] * kv[1]; a += qf[4 * d4 + 2] * kv[2]; a += qf[4 * d4 + 3] * kv[3]; }
              gate[q * 17 + j] = a; } }
        __syncthreads();
        if (tid < 256) { const int nsel = qb < 3 ? qb : 3; unsigned mask = 0u;
            for (int kk = 0; kk < nsel; ++kk) { int bi = 0; float bv = -INFINITY;
                for (int j = 0; j < qb; ++j) { const float a = gate[tid * 17 + j]; if (!((mask >> j) & 1u) && a > bv) { bv = a; bi = j; } }
                mask |= 1u << bi; }
            ((LAS unsigned*)(lds + L_SEL))[tid] = mask; }
        __syncthreads();
        selmask = ((LAS unsigned*)(lds + L_SEL))[32 * w + r32];
    }
    const int qa = q0 + 32 * w + r32;
    bf16x8 qr[4];
#pragma unroll
    for (int d0 = 0; d0 < 4; ++d0) qr[d0] = *(const bf16x8*)(base + (size_t)qa * PW + qoff + 16 * d0 + 8 * hi);
    const bf16_t* kg = base + (size_t)lane * PW + koff + w * 8;
    const bf16_t* vg = base + (size_t)(16 * (w & 3) + (lane >> 2)) * PW + voff + (w >> 2) * 32 + (lane & 3) * 8;
    const int kdst = L_K + w * 1024 + lane * 16, vdst = L_V + (w >> 2) * 4096 + (16 * (w & 3) + (lane >> 2)) * 64 + (lane & 3) * 16;
    const int kfr = L_K + hi * 1024 + r32 * 16;
    const int vfr = L_V + ((lane >> 4) & 1) * 32 + (lane & 3) * 8 + (4 * hi + ((lane & 15) >> 2)) * 64;
    const int qlo = q0 + 32 * w, qhi = qlo + 31;
    u32x4 kreg, vreg;
    kreg = *(const u32x4*)(kg + (size_t)(64 * t_lo) * PW); vreg = *(const u32x4*)(vg + (size_t)(64 * t_lo) * PW);
    *(LAS u32x4*)(lds + kdst) = kreg; *(LAS u32x4*)(lds + vdst) = vreg;
    kreg = *(const u32x4*)(kg + (size_t)(64 * t_lo + 64) * PW); vreg = *(const u32x4*)(vg + (size_t)(64 * t_lo + 64) * PW);
    *(LAS u32x4*)(lds + 8192 + kdst) = kreg; *(LAS u32x4*)(lds + 8192 + vdst) = vreg;
    __syncthreads();
    f32x16 o0 = {}, o1 = {};
    float m = -1e30f, l = 0.f;
#define AT_MODE(MD, JT) do { const int kv0_ = 64 * (JT); \
        if (VAR == 0) MD = (kv0_ > qhi) ? 0 : (kv0_ + 63 <= qlo ? 1 : 2); \
        else if (VAR == 1) MD = (kv0_ > qhi || kv0_ + 63 < qlo - 127) ? 0 : ((kv0_ + 63 <= qlo && kv0_ >= qhi - 127) ? 1 : 2); \
        else { const int jb_ = kv0_ >> 8; \
            if (jb_ < qb) { const unsigned long long bal_ = __ballot((selmask >> jb_) & 1u); MD = (bal_ == 0ull) ? 0 : (bal_ == ~0ull ? 1 : 2); } \
            else MD = (kv0_ > qhi) ? 0 : (kv0_ + 63 <= qlo ? 1 : 2); } } while (0)
#define AT_QK_LOAD(P0, P1, KF, JT, SL) do { const int kv0_ = 64 * (JT); \
        _Pragma("unroll") for (int g = 0; g < 4; ++g) { const f32x4 x0 = *(const LAS f32x4*)(biasT + kv0_ + 8 * g + 4 * hi), x1 = *(const LAS f32x4*)(biasT + kv0_ + 32 + 8 * g + 4 * hi); \
            _Pragma("unroll") for (int i = 0; i < 4; ++i) { P0[4 * g + i] = x0[i]; P1[4 * g + i] = x1[i]; } } \
        _Pragma("unroll") for (int d0 = 0; d0 < 4; ++d0) { KF[2 * d0] = *(const LAS bf16x8*)(lds + (SL) + kfr + d0 * 2048); KF[2 * d0 + 1] = *(const LAS bf16x8*)(lds + (SL) + kfr + d0 * 2048 + 512); } } while (0)
#define AT_QK_MMA(P0, P1, KF) do { \
        _Pragma("unroll") for (int d0 = 0; d0 < 4; ++d0) { P0 = __builtin_amdgcn_mfma_f32_32x32x16_bf16(KF[2 * d0], qr[d0], P0, 0, 0, 0); P1 = __builtin_amdgcn_mfma_f32_32x32x16_bf16(KF[2 * d0 + 1], qr[d0], P1, 0, 0, 0); } } while (0)
#define AT_STEP(PC0, PC1, MC, PN0, PN1, MN, JT, SC, SN, SNN) do { \
        const int kv0 = 64 * (JT); const bool more2 = (JT) + 2 < t_hi; \
        if (more2) { kreg = *(const u32x4*)(kg + (size_t)(kv0 + 128) * PW); vreg = *(const u32x4*)(vg + (size_t)(kv0 + 128) * PW); } \
        MN = 0; if ((JT) + 1 < t_hi) AT_MODE(MN, (JT) + 1); \
        float alpha = 1.0f, mn = m; \
        if (MC != 0) { \
            if (MC == 2) { \
                if (VAR == 2 && (kv0 >> 8) < qb) { if (!((selmask >> (kv0 >> 8)) & 1u)) { _Pragma("unroll") for (int r = 0; r < 16; ++r) { PC0[r] = -INFINITY; PC1[r] = -INFINITY; } } } \
                else { _Pragma("unroll") for (int r = 0; r < 16; ++r) { const int kv = kv0 + crow(r, hi); bool bad0 = kv > qa, bad1 = kv + 32 > qa; \
                        if (VAR == 1) { bad0 = bad0 || kv < qa - 127; bad1 = bad1 || kv + 32 < qa - 127; } \
                        PC0[r] = bad0 ? -INFINITY : PC0[r]; PC1[r] = bad1 ? -INFINITY : PC1[r]; } } } \
            float mxa = __builtin_fmaxf(__builtin_fmaxf(PC0[0], PC0[1]), PC0[2]), mxb = __builtin_fmaxf(__builtin_fmaxf(PC1[0], PC1[1]), PC1[2]);     \
            mxa = __builtin_fmaxf(__builtin_fmaxf(mxa, PC0[3]), PC1[3]); \
            _Pragma("unroll") for (int r = 4; r < 16; r += 2) { mxa = __builtin_fmaxf(__builtin_fmaxf(mxa, PC0[r]), PC0[r + 1]); mxb = __builtin_fmaxf(__builtin_fmaxf(mxb, PC1[r]), PC1[r + 1]); } \
            float mx = halves_max(__builtin_fmaxf(mxa, mxb)); \
            mn = (mx > m + 8.0f) ? mx : m;        \
            if (__any(mn != m)) alpha = __builtin_amdgcn_exp2f(m - mn); \
            m = mn; } \
        __builtin_amdgcn_sched_barrier(0); \
        if ((JT) + 1 < t_hi) { bf16x8 kf[8]; AT_QK_LOAD(PN0, PN1, kf, (JT) + 1, SN); AT_QK_MMA(PN0, PN1, kf); }     \
        __builtin_amdgcn_sched_barrier(0); \
        if (MC != 0) { \
            float rs = 0.f; \
            _Pragma("unroll") for (int r = 0; r < 16; ++r) { PC0[r] = __builtin_amdgcn_exp2f(PC0[r] - mn); PC1[r] = __builtin_amdgcn_exp2f(PC1[r] - mn); rs += PC0[r] + PC1[r]; } \
            l = l * alpha + rs; \
            if (__any(alpha != 1.0f)) { _Pragma("unroll") for (int r = 0; r < 16; ++r) { o0[r] *= alpha; o1[r] *= alpha; } } \
            u32x4 pw[4]; \
            _Pragma("unroll") for (int i = 0; i < 4; ++i) { pw[0][i] = cvtpk(PC0[2 * i], PC0[2 * i + 1]); pw[1][i] = cvtpk(PC0[8 + 2 * i], PC0[8 + 2 * i + 1]); pw[2][i] = cvtpk(PC1[2 * i], PC1[2 * i + 1]); pw[3][i] = cvtpk(PC1[8 + 2 * i], PC1[8 + 2 * i + 1]); } \
            _Pragma("unroll") for (int ks = 0; ks < 4; ++ks) { \
                const bf16x8 pb = __builtin_bit_cast(bf16x8, pw[ks]); \
                const v4i16_t a0 = __builtin_amdgcn_ds_read_tr16_b64_v4i16((LAS v4i16_t*)(lds + (SC) + vfr + ks * 1024)), a1 = __builtin_amdgcn_ds_read_tr16_b64_v4i16((LAS v4i16_t*)(lds + (SC) + vfr + ks * 1024 + 512)); \
                const v4i16_t c0 = __builtin_amdgcn_ds_read_tr16_b64_v4i16((LAS v4i16_t*)(lds + (SC) + vfr + 4096 + ks * 1024)), c1 = __builtin_amdgcn_ds_read_tr16_b64_v4i16((LAS v4i16_t*)(lds + (SC) + vfr + 4096 + ks * 1024 + 512)); \
                const bf16x8 v0 = (bf16x8){a0[0], a0[1], a0[2], a0[3], a1[0], a1[1], a1[2], a1[3]}, v1 = (bf16x8){c0[0], c0[1], c0[2], c0[3], c1[0], c1[1], c1[2], c1[3]}; \
                o0 = __builtin_amdgcn_mfma_f32_32x32x16_bf16(v0, pb, o0, 0, 0, 0); \
                o1 = __builtin_amdgcn_mfma_f32_32x32x16_bf16(v1, pb, o1, 0, 0, 0); } } \
        if (more2) { *(LAS u32x4*)(lds + (SNN) + kdst) = kreg; *(LAS u32x4*)(lds + (SNN) + vdst) = vreg; } \
        __syncthreads(); } while (0)
    f32x16 pA0, pA1, pB0, pB1; int mA = 0, mB = 0;
    AT_MODE(mA, t_lo);
    { bf16x8 kf0[8]; AT_QK_LOAD(pA0, pA1, kf0, t_lo, 0); AT_QK_MMA(pA0, pA1, kf0); }
    int s0 = 0, s1 = 8192, s2 = 16384;
#pragma unroll 1
    for (int jt = t_lo; jt < t_hi; jt += 2) {
        AT_STEP(pA0, pA1, mA, pB0, pB1, mB, jt, s0, s1, s2);
        AT_STEP(pB0, pB1, mB, pA0, pA1, mA, jt + 1, s1, s2, s0);
        { const int t_ = s0; s0 = s2; s2 = s1; s1 = t_; }
    }
#undef AT_MODE
#undef AT_QK_LOAD
#undef AT_QK_MMA
#undef AT_STEP
    float lt = halves_sum(l);
    if (VAR == 1) lt += __builtin_amdgcn_exp2f(sinks[h] * LOG2E - (m - slope2 * (float)(qa - q0)));
    const float inv = 1.0f / lt;
    bf16_t* op = OCAT + (size_t)(b * S + qa) * D + ooff + 4 * hi;
#pragma unroll
    for (int g = 0; g < 4; ++g) {
        u32x2 w0; w0.x = cvtpk(o0[4 * g] * inv, o0[4 * g + 1] * inv); w0.y = cvtpk(o0[4 * g + 2] * inv, o0[4 * g + 3] * inv); *(u32x2*)(op + 8 * g) = w0;
        u32x2 w1; w1.x = cvtpk(o1[4 * g] * inv, o1[4 * g + 1] * inv); w1.y = cvtpk(o1[4 * g + 2] * inv, o1[4 * g + 3] * inv); *(u32x2*)(op + 32 + 8 * g) = w1; }
}

__device__ __forceinline__ void swa_unit(LAS unsigned char* lds, int b, int hkv, int qb, const bf16_t* __restrict__ PROJ, const float* __restrict__ sinks, bf16_t* __restrict__ OCAT, int wv) {
    const int w = wv, lane = opaque(lane_id()), r32 = lane & 31, hi = lane >> 5;
    const int q0 = qb * 256, tb = (qb > 0) ? 4 * qb - 2 : 0, nt = 4 * qb + 4 - tb;
    constexpr int SW_K = 0, SW_V = 49152;
    const bf16_t* base = PROJ + (size_t)b * S * PW;
    { const bf16_t* kg = base + (size_t)lane * PW + SK + hkv * 64 + w * 8;
      const bf16_t* vg = base + (size_t)(16 * (w & 3) + (lane >> 2)) * PW + SV + hkv * 64 + (w >> 2) * 32 + (lane & 3) * 8;
      const int kdst = SW_K + w * 1024 + lane * 16, vdst = SW_V + (w >> 2) * 4096 + (16 * (w & 3) + (lane >> 2)) * 64 + (lane & 3) * 16;
#pragma unroll
      for (int i0 = 0; i0 < 6; i0 += 3) { u32x4 kr[3], vr[3];
#pragma unroll
          for (int i = 0; i < 3; ++i) if (i0 + i < nt) { kr[i] = *(const u32x4*)(kg + (size_t)(64 * (tb + i0 + i)) * PW); vr[i] = *(const u32x4*)(vg + (size_t)(64 * (tb + i0 + i)) * PW); }
#pragma unroll
          for (int i = 0; i < 3; ++i) if (i0 + i < nt) { *(LAS u32x4*)(lds + (i0 + i) * 8192 + kdst) = kr[i]; *(LAS u32x4*)(lds + (i0 + i) * 8192 + vdst) = vr[i]; } } }
    __syncthreads();
    const int h = hkv * 4 + (w >> 1);
    const float slope2 = alibi_slope(h) * LOG2E, sink2 = sinks[h] * LOG2E;
    float cb[16];
#pragma unroll
    for (int r = 0; r < 16; ++r) cb[r] = slope2 * (float)crow(r, hi);
    const int kfr = SW_K + hi * 1024 + r32 * 16;
    const int vfr = SW_V + ((lane >> 4) & 1) * 32 + (lane & 3) * 8 + (4 * hi + ((lane & 15) >> 2)) * 64;
#pragma unroll 1
    for (int st = 0; st < 4; ++st) {
        const int r0 = q0 + (w & 1) * 128 + st * 32, qa = r0 + r32;
        bf16x8 qr[4];
#pragma unroll
        for (int d0 = 0; d0 < 4; ++d0) qr[d0] = *(const bf16x8*)(base + (size_t)qa * PW + SQ + h * 64 + 16 * d0 + 8 * hi);
        f32x16 o0 = {}, o1 = {}; float m = -1e30f, l = 0.f;
        const int t0 = (r0 - 127) >> 6;
#pragma unroll 1
        for (int jt = (t0 > tb ? t0 : tb); jt <= (r0 >> 6); ++jt) {
            const int kv0 = 64 * jt, slot = (jt - tb) * 8192;
            const float tb0 = slope2 * (float)(kv0 - q0), tb1 = slope2 * (float)(kv0 + 32 - q0);
            f32x16 p0, p1;
#pragma unroll
            for (int r = 0; r < 16; r += 2) { const f32x2 c2 = {cb[r], cb[r + 1]}; const f32x2 a2 = c2 + tb0, b2 = c2 + tb1; p0[r] = a2[0]; p0[r + 1] = a2[1]; p1[r] = b2[0]; p1[r + 1] = b2[1]; }
#pragma unroll
            for (int d0 = 0; d0 < 4; ++d0) {
                const bf16x8 k0 = *(const LAS bf16x8*)(lds + slot + kfr + d0 * 2048), k1 = *(const LAS bf16x8*)(lds + slot + kfr + d0 * 2048 + 512);
                p0 = __builtin_amdgcn_mfma_f32_32x32x16_bf16(k0, qr[d0], p0, 0, 0, 0);
                p1 = __builtin_amdgcn_mfma_f32_32x32x16_bf16(k1, qr[d0], p1, 0, 0, 0); }
            if (!(kv0 + 63 <= r0 && kv0 >= r0 + 31 - 127)) {
#pragma unroll
                for (int r = 0; r < 16; ++r) { const int kv = kv0 + crow(r, hi);
                    p0[r] = (kv > qa || kv < qa - 127) ? -INFINITY : p0[r]; p1[r] = (kv + 32 > qa || kv + 32 < qa - 127) ? -INFINITY : p1[r]; } }
            float mx = fmaxf(p0[0], p1[0]);
#pragma unroll
            for (int r = 1; r < 16; ++r) mx = fmaxf(mx, fmaxf(p0[r], p1[r]));
            mx = halves_max(mx);
            const float mn = (mx > m + 8.0f) ? mx : m; float alpha = 1.0f;
            if (__any(mn != m)) alpha = __builtin_amdgcn_exp2f(m - mn);
            m = mn;
            float rs = 0.f;
#pragma unroll
            for (int r = 0; r < 16; r += 2) { const f32x2 a2 = (f32x2){p0[r], p0[r + 1]} - mn, b2 = (f32x2){p1[r], p1[r + 1]} - mn; p0[r] = __builtin_amdgcn_exp2f(a2[0]); p0[r + 1] = __builtin_amdgcn_exp2f(a2[1]); p1[r] = __builtin_amdgcn_exp2f(b2[0]); p1[r + 1] = __builtin_amdgcn_exp2f(b2[1]); rs += (p0[r] + p0[r + 1]) + (p1[r] + p1[r + 1]); }
            l = l * alpha + rs;
            if (__any(alpha != 1.0f)) {
#pragma unroll
                for (int r = 0; r < 16; ++r) { o0[r] *= alpha; o1[r] *= alpha; } }
            u32x4 pw[4];
#pragma unroll
            for (int i = 0; i < 4; ++i) { pw[0][i] = cvtpk(p0[2 * i], p0[2 * i + 1]); pw[1][i] = cvtpk(p0[8 + 2 * i], p0[8 + 2 * i + 1]); pw[2][i] = cvtpk(p1[2 * i], p1[2 * i + 1]); pw[3][i] = cvtpk(p1[8 + 2 * i], p1[8 + 2 * i + 1]); }
#pragma unroll
            for (int ks = 0; ks < 4; ++ks) {
                const bf16x8 pb = __builtin_bit_cast(bf16x8, pw[ks]);
                const v4i16_t a0 = __builtin_amdgcn_ds_read_tr16_b64_v4i16((LAS v4i16_t*)(lds + slot + vfr + ks * 1024)), a1 = __builtin_amdgcn_ds_read_tr16_b64_v4i16((LAS v4i16_t*)(lds + slot + vfr + ks * 1024 + 512));
                const v4i16_t c0 = __builtin_amdgcn_ds_read_tr16_b64_v4i16((LAS v4i16_t*)(lds + slot + vfr + 4096 + ks * 1024)), c1 = __builtin_amdgcn_ds_read_tr16_b64_v4i16((LAS v4i16_t*)(lds + slot + vfr + 4096 + ks * 1024 + 512));
                const bf16x8 v0 = (bf16x8){a0[0], a0[1], a0[2], a0[3], a1[0], a1[1], a1[2], a1[3]}, v1 = (bf16x8){c0[0], c0[1], c0[2], c0[3], c1[0], c1[1], c1[2], c1[3]};
                o0 = __builtin_amdgcn_mfma_f32_32x32x16_bf16(v0, pb, o0, 0, 0, 0);
                o1 = __builtin_amdgcn_mfma_f32_32x32x16_bf16(v1, pb, o1, 0, 0, 0); }
        }
        float lt = halves_sum(l);
        lt += __builtin_amdgcn_exp2f(sink2 - (m - slope2 * (float)(qa - q0)));
        const float inv = 1.0f / lt;
        bf16_t* op = OCAT + (size_t)(b * S + qa) * D + 256 + h * 64 + 4 * hi;
#pragma unroll
        for (int g = 0; g < 4; ++g) {
            u32x2 w0; w0.x = cvtpk(o0[4 * g] * inv, o0[4 * g + 1] * inv); w0.y = cvtpk(o0[4 * g + 2] * inv, o0[4 * g + 3] * inv); *(u32x2*)(op + 8 * g) = w0;
            u32x2 w1; w1.x = cvtpk(o1[4 * g] * inv, o1[4 * g + 1] * inv); w1.y = cvtpk(o1[4 * g + 2] * inv, o1[4 * g + 3] * inv); *(u32x2*)(op + 32 + 8 * g) = w1; }
    }
    __syncthreads();
}

constexpr int MB_CNT = 256, MB_TP = 320, MB_UT = 384;
constexpr int MS_CNT = 90112, MS_BASE = 90176;
__device__ __forceinline__ void moba_select(LAS unsigned char* lds, int b, int h, int qb, const bf16_t* __restrict__ PROJ, const float* __restrict__ kmean, unsigned short* __restrict__ msel, unsigned short* __restrict__ mlist, int* __restrict__ mcnt, int wv) {
    const int w = wv, lane = opaque(lane_id()), tid = w * 64 + lane, q0 = qb * 256, bh = b * 4 + h;
    if (qb == 0) { if (tid < 256) msel[(size_t)bh * S + tid] = 0; return; }
    const bf16_t* base = PROJ + (size_t)b * S * PW;
    LAS float* gate = (LAS float*)(lds + L_GATE); LAS float* kmL = (LAS float*)(lds + L_KM);
    LAS int* lcnt = (LAS int*)(lds + MS_CNT); LAS int* lbase = (LAS int*)(lds + MS_BASE);
    if (tid < qb * 16) *(LAS f32x4*)(kmL + 4 * tid) = *(const f32x4*)(kmean + (size_t)(b * 16 + (tid >> 4)) * 256 + h * 64 + 4 * (tid & 15));
    if (tid < 16) lcnt[tid] = 0;
    {
      const int r32 = lane & 31, hi = lane >> 5;
      bf16x8 qa4[4];
#pragma unroll
      for (int ks = 0; ks < 4; ++ks) qa4[ks] = *(const bf16x8*)(base + (size_t)(q0 + 32 * w + r32) * PW + MQ + h * 64 + 16 * ks + 8 * hi);
      __syncthreads();
      f32x16 acc = {};
#pragma unroll
      for (int ks = 0; ks < 4; ++ks) {
          f32x4 k0 = {0.f, 0.f, 0.f, 0.f}, k1 = {0.f, 0.f, 0.f, 0.f};
          if (r32 < qb) { k0 = *(const LAS f32x4*)(kmL + r32 * 64 + 16 * ks + 8 * hi); k1 = *(const LAS f32x4*)(kmL + r32 * 64 + 16 * ks + 8 * hi + 4); }
          u32x4 ph, pm, pl;
#pragma unroll
          for (int c = 0; c < 4; ++c) { const float v0 = (c < 2) ? k0[2 * c] : k1[2 * c - 4], v1 = (c < 2) ? k0[2 * c + 1] : k1[2 * c - 3];
              const unsigned h0 = f2bf(v0), h1 = f2bf(v1); const float r0 = v0 - bf2f(h0), r1 = v1 - bf2f(h1);
              const unsigned m0 = f2bf(r0), m1 = f2bf(r1); const unsigned l0 = f2bf(r0 - bf2f(m0)), l1 = f2bf(r1 - bf2f(m1));
              ph[c] = h0 | (h1 << 16); pm[c] = m0 | (m1 << 16); pl[c] = l0 | (l1 << 16); }
          acc = __builtin_amdgcn_mfma_f32_32x32x16_bf16(qa4[ks], __builtin_bit_cast(bf16x8, pl), acc, 0, 0, 0);
          acc = __builtin_amdgcn_mfma_f32_32x32x16_bf16(qa4[ks], __builtin_bit_cast(bf16x8, pm), acc, 0, 0, 0);
          acc = __builtin_amdgcn_mfma_f32_32x32x16_bf16(qa4[ks], __builtin_bit_cast(bf16x8, ph), acc, 0, 0, 0); }
      if (r32 < qb) {
#pragma unroll
          for (int r = 0; r < 16; ++r) gate[(32 * w + crow(r, hi)) * 17 + r32] = acc[r]; } }
    __syncthreads();
    unsigned mask = 0u; int sj[3] = {0, 0, 0}, sp[3] = {0, 0, 0}; const int nsel = qb < 3 ? qb : 3;
    if (tid < 256) {
        for (int kk = 0; kk < nsel; ++kk) { int bi = 0; float bv = -INFINITY;
            for (int j = 0; j < qb; ++j) { const float a = gate[tid * 17 + j]; if (!((mask >> j) & 1u) && a > bv) { bv = a; bi = j; } }
            mask |= 1u << bi; sj[kk] = bi; sp[kk] = atomicAdd((int*)(lcnt + bi), 1); } }
    __syncthreads();
    if (tid < 16) { const int c = lcnt[tid]; lbase[tid] = (c > 0) ? atomicAdd(mcnt + bh * 16 + tid, c) : 0; }
    __syncthreads();
    if (tid < 256) { msel[(size_t)bh * S + q0 + tid] = (unsigned short)mask;
        for (int kk = 0; kk < nsel; ++kk) mlist[((size_t)bh * 16 + sj[kk]) * MLCAP + lbase[sj[kk]] + sp[kk]] = (unsigned short)(q0 + tid); }
    __syncthreads();
}
template <bool OWN>
__device__ __forceinline__ void moba_block(LAS unsigned char* lds_, int ldsoff, int grp, bool standalone, int b, int h, int jb, int chunk, int n, const bf16_t* __restrict__ PROJ, const unsigned short* __restrict__ msel, const unsigned short* __restrict__ mlist,
                                           bf16_t* __restrict__ mpo, float* __restrict__ mpml, bf16_t* __restrict__ OCAT, int wv) {
    LAS unsigned char* lds = lds_ + ldsoff;
    const int w = wv, lane = opaque(lane_id()), tid = w * 64 + lane, r32 = lane & 31, hi = lane >> 5, bh = b * 4 + h;
    constexpr int MK_K = 0, MK_V = 32768, MK_TOK = 65536;
    const bf16_t* base = PROJ + (size_t)b * S * PW;
    const int tb = 4 * jb;
    if (standalone) { const bf16_t* kg = base + (size_t)lane * PW + MK + h * 64 + w * 8;
      const bf16_t* vg = base + (size_t)(16 * (w & 3) + (lane >> 2)) * PW + MV + h * 64 + (w >> 2) * 32 + (lane & 3) * 8;
      const int kdst = MK_K + w * 1024 + lane * 16, vdst = MK_V + (w >> 2) * 4096 + (16 * (w & 3) + (lane >> 2)) * 64 + (lane & 3) * 16;
      u32x4 kr[4], vr[4];
#pragma unroll
      for (int i = 0; i < 4; ++i) { kr[i] = *(const u32x4*)(kg + (size_t)(64 * (tb + i)) * PW); vr[i] = *(const u32x4*)(vg + (size_t)(64 * (tb + i)) * PW); }
      if (!OWN && tid < 256) { int p = chunk * 256 + tid; p = p < n ? p : n - 1; ((LAS unsigned short*)(lds + MK_TOK))[tid] = mlist[((size_t)bh * 16 + jb) * MLCAP + p]; }
#pragma unroll
      for (int i = 0; i < 4; ++i) { *(LAS u32x4*)(lds + i * 8192 + kdst) = kr[i]; *(LAS u32x4*)(lds + i * 8192 + vdst) = vr[i]; }
      __syncthreads(); }
    const float slope2 = alibi_slope(8 + h) * LOG2E;
    const int kfr = MK_K + hi * 1024 + r32 * 16;
    const int vfr = MK_V + ((lane >> 4) & 1) * 32 + (lane & 3) * 8 + (4 * hi + ((lane & 15) >> 2)) * 64;
    const int r0 = jb * 256 + 32 * grp;
    const int qa = OWN ? r0 + r32 : (int)((const LAS unsigned short*)(lds + MK_TOK))[32 * grp + r32];
    const bool valid = OWN || (chunk * 256 + 32 * grp + r32 < n);
    bf16x8 qr[4];
#pragma unroll
    for (int d0 = 0; d0 < 4; ++d0) qr[d0] = *(const bf16x8*)(base + (size_t)qa * PW + MQ + h * 64 + 16 * d0 + 8 * hi);
    f32x16 o0 = {}, o1 = {}; float m = -1e30f, l = 0.f;
    float cb[16];
#pragma unroll
    for (int r = 0; r < 16; ++r) cb[r] = slope2 * (float)crow(r, hi);
#pragma unroll 1
    for (int jt = 0; jt < 4; ++jt) {
        const int kv0 = 64 * (tb + jt), slot = jt * 8192;
        const float tb0 = slope2 * (float)kv0, tb1 = slope2 * (float)(kv0 + 32);
        if (OWN && kv0 > r0 + 31) break;
        f32x16 p0, p1;
#pragma unroll
        for (int r = 0; r < 16; r += 2) { const f32x2 c2 = {cb[r], cb[r + 1]}; const f32x2 a2 = c2 + tb0, b2 = c2 + tb1; p0[r] = a2[0]; p0[r + 1] = a2[1]; p1[r] = b2[0]; p1[r + 1] = b2[1]; }
#pragma unroll
        for (int d0 = 0; d0 < 4; ++d0) {
            const bf16x8 k0 = *(const LAS bf16x8*)(lds + slot + kfr + d0 * 2048), k1 = *(const LAS bf16x8*)(lds + slot + kfr + d0 * 2048 + 512);
            p0 = __builtin_amdgcn_mfma_f32_32x32x16_bf16(k0, qr[d0], p0, 0, 0, 0);
            p1 = __builtin_amdgcn_mfma_f32_32x32x16_bf16(k1, qr[d0], p1, 0, 0, 0); }
        if (OWN && !(kv0 + 63 <= r0)) {
#pragma unroll
            for (int r = 0; r < 16; ++r) { const int kv = kv0 + crow(r, hi); p0[r] = (kv > qa) ? -INFINITY : p0[r]; p1[r] = (kv + 32 > qa) ? -INFINITY : p1[r]; } }
        float mx = fmaxf(p0[0], p1[0]);
#pragma unroll
        for (int r = 1; r < 16; ++r) mx = fmaxf(mx, fmaxf(p0[r], p1[r]));
        mx = halves_max(mx);
        const float mn = (mx > m + 8.0f) ? mx : m; float alpha = 1.0f;
        if (__any(mn != m)) alpha = __builtin_amdgcn_exp2f(m - mn);
        m = mn;
        float rs = 0.f;
#pragma unroll
        for (int r = 0; r < 16; r += 2) { const f32x2 a2 = (f32x2){p0[r], p0[r + 1]} - mn, b2 = (f32x2){p1[r], p1[r + 1]} - mn; p0[r] = __builtin_amdgcn_exp2f(a2[0]); p0[r + 1] = __builtin_amdgcn_exp2f(a2[1]); p1[r] = __builtin_amdgcn_exp2f(b2[0]); p1[r + 1] = __builtin_amdgcn_exp2f(b2[1]); rs += (p0[r] + p0[r + 1]) + (p1[r] + p1[r + 1]); }
        l = l * alpha + rs;
        if (__any(alpha != 1.0f)) {
#pragma unroll
            for (int r = 0; r < 16; ++r) { o0[r] *= alpha; o1[r] *= alpha; } }
        u32x4 pw[4];
#pragma unroll
        for (int i = 0; i < 4; ++i) { pw[0][i] = cvtpk(p0[2 * i], p0[2 * i + 1]); pw[1][i] = cvtpk(p0[8 + 2 * i], p0[8 + 2 * i + 1]); pw[2][i] = cvtpk(p1[2 * i], p1[2 * i + 1]); pw[3][i] = cvtpk(p1[8 + 2 * i], p1[8 + 2 * i + 1]); }
#pragma unroll
        for (int ks = 0; ks < 4; ++ks) {
            const bf16x8 pb = __builtin_bit_cast(bf16x8, pw[ks]);
            const v4i16_t a0 = __builtin_amdgcn_ds_read_tr16_b64_v4i16((LAS v4i16_t*)(lds + slot + vfr + ks * 1024)), a1 = __builtin_amdgcn_ds_read_tr16_b64_v4i16((LAS v4i16_t*)(lds + slot + vfr + ks * 1024 + 512));
            const v4i16_t c0 = __builtin_amdgcn_ds_read_tr16_b64_v4i16((LAS v4i16_t*)(lds + slot + vfr + 4096 + ks * 1024)), c1 = __builtin_amdgcn_ds_read_tr16_b64_v4i16((LAS v4i16_t*)(lds + slot + vfr + 4096 + ks * 1024 + 512));
            const bf16x8 v0 = (bf16x8){a0[0], a0[1], a0[2], a0[3], a1[0], a1[1], a1[2], a1[3]}, v1 = (bf16x8){c0[0], c0[1], c0[2], c0[3], c1[0], c1[1], c1[2], c1[3]};
            o0 = __builtin_amdgcn_mfma_f32_32x32x16_bf16(v0, pb, o0, 0, 0, 0);
            o1 = __builtin_amdgcn_mfma_f32_32x32x16_bf16(v1, pb, o1, 0, 0, 0); }
    }
    const float lt = halves_sum(l);
    const unsigned mask = (unsigned)msel[(size_t)bh * S + qa];
    const size_t prow = (size_t)bh * S + qa;
    if (!OWN) {
        const int slot = __builtin_popcount(mask & ((1u << jb) - 1u));
        const float inv = 1.0f / lt;
        if (valid) {
            u32x4* po = (u32x4*)(mpo + ((prow * 3 + slot) * 2 + hi) * 32);
#pragma unroll
            for (int g = 0; g < 2; ++g) {
                po[g] = (u32x4){cvtpk(o0[8 * g] * inv, o0[8 * g + 1] * inv), cvtpk(o0[8 * g + 2] * inv, o0[8 * g + 3] * inv), cvtpk(o0[8 * g + 4] * inv, o0[8 * g + 5] * inv), cvtpk(o0[8 * g + 6] * inv, o0[8 * g + 7] * inv)};
                po[2 + g] = (u32x4){cvtpk(o1[8 * g] * inv, o1[8 * g + 1] * inv), cvtpk(o1[8 * g + 2] * inv, o1[8 * g + 3] * inv), cvtpk(o1[8 * g + 4] * inv, o1[8 * g + 5] * inv), cvtpk(o1[8 * g + 6] * inv, o1[8 * g + 7] * inv)}; }
            if (hi == 0) { float* pm = mpml + (prow * 3 + slot) * 2; pm[0] = m; pm[1] = lt; } }
    } else {
        const int cnt = __builtin_popcount(mask);
        float ms[3], ls[3]; u32x4 ps[3][4];
#pragma unroll
        for (int s3 = 0; s3 < 3; ++s3) { const bool on = s3 < cnt; const size_t ix = on ? prow * 3 + s3 : prow * 3;
            const float* pm = mpml + ix * 2; const float mv = pm[0], lv = pm[1]; ms[s3] = on ? mv : -1e30f; ls[s3] = on ? lv : 0.f;
            const u32x4* po = (const u32x4*)(mpo + (ix * 2 + hi) * 32);
#pragma unroll
            for (int g = 0; g < 4; ++g) { const u32x4 pv = po[g]; ps[s3][g] = on ? pv : (u32x4){0u, 0u, 0u, 0u}; } }
        const float M = fmaxf(fmaxf(m, ms[0]), fmaxf(ms[1], ms[2]));
        const float aown = __builtin_amdgcn_exp2f(m - M);
        float wsl[3], L = lt * aown;
#pragma unroll
        for (int s3 = 0; s3 < 3; ++s3) { wsl[s3] = ls[s3] * __builtin_amdgcn_exp2f(ms[s3] - M); L += wsl[s3]; }
        const float inv = 1.0f / L;
#pragma unroll
        for (int r = 0; r < 16; ++r) { o0[r] *= aown; o1[r] *= aown; }
#pragma unroll
        for (int s3 = 0; s3 < 3; ++s3)
#pragma unroll
            for (int g = 0; g < 2; ++g)
#pragma unroll
                for (int i = 0; i < 4; ++i) { const unsigned a = ps[s3][g][i], c = ps[s3][2 + g][i];
                    o0[8 * g + 2 * i] += wsl[s3] * bf2f(a & 0xffffu); o0[8 * g + 2 * i + 1] += wsl[s3] * bf2f(a >> 16);
                    o1[8 * g + 2 * i] += wsl[s3] * bf2f(c & 0xffffu); o1[8 * g + 2 * i + 1] += wsl[s3] * bf2f(c >> 16); }
        bf16_t* op = OCAT + (size_t)(b * S + qa) * D + 768 + h * 64 + 4 * hi;
#pragma unroll
        for (int g = 0; g < 4; ++g) {
            u32x2 w0; w0.x = cvtpk(o0[4 * g] * inv, o0[4 * g + 1] * inv); w0.y = cvtpk(o0[4 * g + 2] * inv, o0[4 * g + 3] * inv); *(u32x2*)(op + 8 * g) = w0;
            u32x2 w1; w1.x = cvtpk(o1[4 * g] * inv, o1[4 * g + 1] * inv); w1.y = cvtpk(o1[4 * g + 2] * inv, o1[4 * g + 3] * inv); *(u32x2*)(op + 32 + 8 * g) = w1; }
    }
    if (standalone) __syncthreads();
}
__device__ __forceinline__ void moba_gather_phase(LAS unsigned char* lds, volatile LAS unsigned* LC, const bf16_t* PROJ, const unsigned short* msel, const unsigned short* mlist, const int* mcnt, bf16_t* mpo, float* mpml, int wv) {
    const int tid = tid_of(wv), x = (int)blockIdx.x & 7, jcu = (int)blockIdx.x >> 3, W = (int)gridDim.x >> 3;
    if (tid < 60) LC[MB_CNT + tid] = (unsigned)mcnt[(x + 8 * (tid / 15)) * 16 + (tid % 15)];
    __syncthreads();
    if (tid <= 60) { int a = 0;
#pragma unroll 4
        for (int e = 0; e < 60; ++e) { const int t = ((int)LC[MB_CNT + e] + 255) >> 8; a += (e < tid) ? t : 0; }
        LC[MB_TP + tid] = (unsigned)a; }
    __syncthreads();
    if (tid < 16) { const int u = jcu + W * tid; unsigned word = 0u;
        if (u < (int)LC[MB_TP + 60]) { int e = 0;
            for (int t = 1; t < 60; ++t) e = ((int)LC[MB_TP + t] <= u) ? t : e;
            word = 0x80000000u | ((unsigned)e << 8) | (unsigned)(u - (int)LC[MB_TP + e]); }
        LC[MB_UT + tid] = word; }
    __syncthreads();
#pragma unroll 1
    for (int i = 0; i < 16; ++i) {
        const unsigned word = (unsigned)__builtin_amdgcn_readfirstlane((int)LC[MB_UT + i]); if (!(word >> 31)) break;
        const int e = (int)((word >> 8) & 63u), chunk = (int)(word & 255u), bh = x + 8 * (e / 15), jb = e % 15, n = (int)LC[MB_CNT + e];
        moba_block<false>(lds, 0, wv, true, bh >> 2, bh & 3, jb, chunk, n, PROJ, msel, mlist, mpo, mpml, nullptr, wv);
    }
}

__device__ __forceinline__ void attn_phase(LAS unsigned char* lds, int l, const bf16_t* PROJ, const float* lf, const float* kmean_l, const float* sinks_l, bf16_t* OCAT, int wv, const float* qkg_l,
                                           unsigned short* msel, unsigned short* mlist, int* mcnt_l) {
    const int G = gridDim.x, bx = blockIdx.x;
    const int vcu = (G % 8 == 0) ? (bx % 8) * (G / 8) + bx / 8 : bx;
    for (int p = vcu; p < 256; p += G) { const int bh = p >> 3, s8 = p & 7;
        moba_select(lds, bh >> 2, bh & 3, 15 - s8, PROJ, kmean_l, msel, mlist, mcnt_l, wv);
        moba_select(lds, bh >> 2, bh & 3, s8, PROJ, kmean_l, msel, mlist, mcnt_l, wv); }
    for (int p = vcu; p < 256; p += G) { const int bh = p >> 3, s = p & 7;
        attn_unit<0>(lds, bh >> 2, bh & 3, 15 - s, PROJ, lf, nullptr, nullptr, OCAT, wv, qkg_l);
        attn_unit<0>(lds, bh >> 2, bh & 3, s, PROJ, lf, nullptr, nullptr, OCAT, wv, qkg_l); }
    for (int p = vcu; p < 256; p += G) swa_unit(lds, p >> 5, (p >> 4) & 1, p & 15, PROJ, sinks_l, OCAT, wv);
    (void)l;
}
__device__ __forceinline__ void moba_own_phase(LAS unsigned char* lds, const bf16_t* PROJ, const unsigned short* msel, bf16_t* mpo, float* mpml, bf16_t* OCAT, int wv) {
    const int G = gridDim.x, bx = blockIdx.x;
    const int vcu = (G % 8 == 0) ? (bx % 8) * (G / 8) + bx / 8 : bx;
    const int w = wv, lane = opaque(lane_id());
    for (int p = vcu; p < 256; p += G) {
        const int pa = p, pb = p + 256;
        { u32x4 kr[2][4], vr[2][4];
          const int kdst = w * 1024 + lane * 16, vdst = 32768 + (w >> 2) * 4096 + (16 * (w & 3) + (lane >> 2)) * 64 + (lane & 3) * 16;
#pragma unroll
          for (int u = 0; u < 2; ++u) { const int pp = u ? pb : pa, b = pp >> 6, h = (pp >> 4) & 3, tb = 4 * (pp & 15);
              const bf16_t* base = PROJ + (size_t)b * S * PW;
              const bf16_t* kg = base + (size_t)lane * PW + MK + h * 64 + w * 8;
              const bf16_t* vg = base + (size_t)(16 * (w & 3) + (lane >> 2)) * PW + MV + h * 64 + (w >> 2) * 32 + (lane & 3) * 8;
#pragma unroll
              for (int i = 0; i < 4; ++i) { kr[u][i] = *(const u32x4*)(kg + (size_t)(64 * (tb + i)) * PW); vr[u][i] = *(const u32x4*)(vg + (size_t)(64 * (tb + i)) * PW); } }
#pragma unroll
          for (int u = 0; u < 2; ++u)
#pragma unroll
              for (int i = 0; i < 4; ++i) { *(LAS u32x4*)(lds + u * 65536 + i * 8192 + kdst) = kr[u][i]; *(LAS u32x4*)(lds + u * 65536 + i * 8192 + vdst) = vr[u][i]; } }
        __syncthreads();
        moba_block<true>(lds, 0, w, false, pa >> 6, (pa >> 4) & 3, pa & 15, 0, 0, PROJ, msel, nullptr, mpo, mpml, OCAT, wv);
        moba_block<true>(lds, 65536, 7 - w, false, pb >> 6, (pb >> 4) & 3, pb & 15, 0, 0, PROJ, msel, nullptr, mpo, mpml, OCAT, wv);
        __syncthreads();
    }
}
}

template <bool FINAL>
__device__ __forceinline__ void norm1_wave(const NormP& p, int gw, int NGW, int lane, const int* seg, LAS f32x4* wfL  ) {
    const bool comb = p.modprev != nullptr;
    for (int t0 = gw * 16; t0 < T; t0 += NGW * 16) {
        const int b = t0 / S;
        f32x4 gm[4], shv[4], g2[4];
#pragma unroll
        for (int j = 0; j < 4; ++j) {
            if (!FINAL) { const f32x4 g = *((const f32x4*)p.gain + lane + 64 * j), c1 = *((const f32x4*)(p.mod + (size_t)b * 6144 + D) + lane + 64 * j);
                gm[j] = g * (1.0f + c1); shv[j] = *((const f32x4*)(p.mod + (size_t)b * 6144) + lane + 64 * j); }
            if (comb) g2[j] = *((const f32x4*)(p.modprev + (size_t)b * 6144 + 5 * D) + lane + 64 * j); }
#pragma unroll 1
        for (int r2 = 0; r2 < 16; r2 += 2) {
            f32x4 v[2][4];
#pragma unroll
            for (int q = 0; q < 2; ++q) {
                if (p.xin) { const f32x4* xr = (const f32x4*)(p.xin + (size_t)(t0 + r2 + q) * D) + lane;
#pragma unroll
                    for (int j = 0; j < 4; ++j) v[q][j] = __builtin_nontemporal_load(xr + 64 * j); }
                else { const u32x2* xr = (const u32x2*)(p.xinb + (size_t)(t0 + r2 + q) * D) + lane;
#pragma unroll
                    for (int j = 0; j < 4; ++j) { const u32x2 w = xr[64 * j]; v[q][j] = (f32x4){bf2f(w.x & 0xffffu), bf2f(w.x >> 16), bf2f(w.y & 0xffffu), bf2f(w.y >> 16)}; } } }
            if (comb) {
                u32x2 yw[2][4][4];
#pragma unroll
                for (int q = 0; q < 2; ++q) { const int t = t0 + r2 + q;
                    const int4 e4 = *(const int4*)(p.toke + t * 4), p4 = *(const int4*)(p.tokp + t * 4);
                    const int ee[4] = {e4.x, e4.y, e4.z, e4.w}, pp[4] = {p4.x, p4.y, p4.z, p4.w};
#pragma unroll
                    for (int kk = 0; kk < 4; ++kk) { const u32x2* yr = (const u32x2*)(p.Y + (size_t)(seg[ee[kk]] + pp[kk]) * D) + lane;
#pragma unroll
                        for (int j = 0; j < 4; ++j) yw[q][kk][j] = __builtin_nontemporal_load(yr + 64 * j); } }
#pragma unroll
                for (int q = 0; q < 2; ++q)
#pragma unroll
                    for (int j = 0; j < 4; ++j) { f32x4 a = {0.f, 0.f, 0.f, 0.f};
#pragma unroll
                        for (int kk = 0; kk < 4; ++kk) { const u32x2 w = yw[q][kk][j]; a[0] += bf2f(w.x & 0xffffu); a[1] += bf2f(w.x >> 16); a[2] += bf2f(w.y & 0xffffu); a[3] += bf2f(w.y >> 16); }
                        v[q][j] += g2[j] * a; }
            }
#pragma unroll
            for (int q = 0; q < 2; ++q) {
                if (FINAL) { f32x4* xo = (f32x4*)(p.X + (size_t)(t0 + r2 + q) * D) + lane;
#pragma unroll
                    for (int j = 0; j < 4; ++j) __builtin_nontemporal_store(v[q][j], xo + 64 * j); }
                else { u32x2* xo = (u32x2*)(p.Xb + (size_t)(t0 + r2 + q) * D) + lane;
#pragma unroll
                    for (int j = 0; j < 4; ++j) { u32x2 w; w.x = pg::cvt_pk_bf16(v[q][j][0], v[q][j][1]); w.y = pg::cvt_pk_bf16(v[q][j][2], v[q][j][3]); xo[64 * j] = w; } } }
            if (FINAL) continue;
            float ss[2];
#pragma unroll
            for (int q = 0; q < 2; ++q) { ss[q] = 0.f;
#pragma unroll
                for (int j = 0; j < 4; ++j) ss[q] += (v[q][j][0] * v[q][j][0] + v[q][j][1] * v[q][j][1]) + (v[q][j][2] * v[q][j][2] + v[q][j][3] * v[q][j][3]); }
            ss[0] = wsum(ss[0]); ss[1] = wsum(ss[1]);
#pragma unroll
            for (int q = 0; q < 2; ++q) { const int t = t0 + r2 + q; const float r = rsqrtf(ss[q] * (1.0f / D) + EPS);
                u32x2* ho = (u32x2*)(p.H + (size_t)t * D) + lane;
                float f0 = 0.f, f1 = 0.f, f2 = 0.f, f3 = 0.f;
#pragma unroll
                for (int j = 0; j < 4; ++j) { const f32x4 h = (v[q][j] * r) * gm[j] + shv[j];
                    u32x2 w; w.x = pk2(h[0], h[1]); w.y = pk2(h[2], h[3]); ho[64 * j] = w;
#pragma unroll
                    for (int i = 0; i < 4; ++i) { const f32x4 wv4 = wfL[(j * 4 + i) * 64 + lane]; f0 += h[i] * wv4[0]; f1 += h[i] * wv4[1]; f2 += h[i] * wv4[2]; f3 += h[i] * wv4[3]; } }
                f0 = wsum(f0); f1 = wsum(f1); f2 = wsum(f2); f3 = wsum(f3);
                if (lane < 4) { const float z = (lane == 0 ? f0 : lane == 1 ? f1 : lane == 2 ? f2 : f3) + p.bf[lane];
                    p.lf[(size_t)(b * 4 + lane) * S + (t % S)] = fminf(z, 0.f) - log1pf(__expf(-fabsf(z))); } }
        }
    }
}

__device__ __forceinline__ void router_prep(const float* __restrict__ modl, const float* __restrict__ gain2, const float* __restrict__ wr, const float* __restrict__ br, bf16_t* __restrict__ WgT, float* __restrict__ cb, int wv) {
    const int w = opaque_s(wv), lane = opaque(lane_id()), tid = w * 64 + lane;
    const int per = (NB * NE * (D / 8) + (int)gridDim.x - 1) / (int)gridDim.x;
    for (int ii = tid; ii < per; ii += NTHR) { const int i = (int)blockIdx.x * per + ii; if (i >= NB * NE * (D / 8)) break;
        const int e = i & 31, k8 = (i >> 5) & 127, b = i >> 12;
        float g[8], m[8], wv8[8];
#pragma unroll
        for (int c = 0; c < 8; ++c) { const int k = 8 * k8 + c; g[c] = gain2[k]; m[c] = modl[(size_t)b * 6144 + 4 * D + k]; wv8[c] = wr[k * NE + e]; }
        unsigned hp[4], mp[4], lp[4];
#pragma unroll
        for (int c = 0; c < 8; ++c) {
            const float v = g[c] * (1.0f + m[c]) * wv8[c];
            const unsigned h = f2bf(v); const float r1 = v - bf2f(h); const unsigned mm = f2bf(r1); const float r2 = r1 - bf2f(mm); const unsigned lo = f2bf(r2);
            if (c & 1) { hp[c >> 1] |= h << 16; mp[c >> 1] |= mm << 16; lp[c >> 1] |= lo << 16; } else { hp[c >> 1] = h; mp[c >> 1] = mm; lp[c >> 1] = lo; } }
        bf16_t* o = WgT + (((size_t)(b * 3) * 128 + k8) * NE + e) * 8;
        *(u32x4*)(o) = (u32x4){hp[0], hp[1], hp[2], hp[3]}; *(u32x4*)(o + (size_t)NE * D) = (u32x4){mp[0], mp[1], mp[2], mp[3]}; *(u32x4*)(o + (size_t)2 * NE * D) = (u32x4){lp[0], lp[1], lp[2], lp[3]}; }
    if (w == 2) {
        for (int i = (int)blockIdx.x; i < NB * NE; i += (int)gridDim.x) { const int e = i & 31, b = i >> 5;
            float mv[16], wv16[16];
#pragma unroll
            for (int j = 0; j < 16; ++j) { const int k = lane + 64 * j; mv[j] = modl[(size_t)b * 6144 + 3 * D + k]; wv16[j] = wr[k * NE + e]; }
            float a = 0.f;
#pragma unroll
            for (int j = 0; j < 16; ++j) a += mv[j] * wv16[j];
            a = wsum(a); if (lane == 0) cb[i] = a + br[e]; } }
}
constexpr int RF_BUF = 0, RF_LG = 16384, RF_RS = 36864, RF_SS = 37376, RF_HIST = 37888, RF_BASE = 38016;
__device__ __forceinline__ void norm2_router(LAS unsigned char* lds, int vb, const bf16_t* __restrict__ X, bf16_t* __restrict__ H, const float* __restrict__ modl, const float* __restrict__ gain2,
                                             const bf16_t* __restrict__ WgT, const float* __restrict__ cb, int* __restrict__ cnt, int* __restrict__ toke, int* __restrict__ tokp, int* __restrict__ list, float* __restrict__ listw, int wv) {
    const int w = wv, lane = opaque(lane_id()), tid = w * 64 + lane, r32 = lane & 31, hi = lane >> 5;
    const int tile = w & 3, kh = w >> 2, t0 = 128 * vb + 32 * tile, b = (128 * vb) / S;
    LAS float* buf = (LAS float*)(lds + RF_BUF); LAS float* LG = (LAS float*)(lds + RF_LG); LAS float* RS = (LAS float*)(lds + RF_RS); LAS float* SS = (LAS float*)(lds + RF_SS);
    LAS int* hist = (LAS int*)(lds + RF_HIST); LAS int* basep = (LAS int*)(lds + RF_BASE);
    if (tid < 32) hist[tid] = 0;
    f32x16 acc = {}; float ss = 0.f;
    { const bf16_t* xrow = X + (size_t)(t0 + r32) * D + kh * 512 + 8 * hi;
      const bf16_t* wp = WgT + (((size_t)(b * 3) * 128 + kh * 64 + hi) * NE + r32) * 8;
#pragma unroll 1
      for (int j0 = 0; j0 < 32; j0 += 8) {
          u32x4 aw[8]; bf16x8 w0[8], w1[8], w2[8];
#pragma unroll
          for (int j = 0; j < 8; ++j) { aw[j] = *(const u32x4*)(xrow + 16 * (j0 + j)); w0[j] = *(const bf16x8*)(wp + 512 * (j0 + j));
              w1[j] = *(const bf16x8*)(wp + (size_t)NE * D + 512 * (j0 + j)); w2[j] = *(const bf16x8*)(wp + (size_t)2 * NE * D + 512 * (j0 + j)); }
          asm volatile("s_waitcnt vmcnt(0)" ::: "memory");
#pragma unroll
          for (int j = 0; j < 8; ++j) {
#pragma unroll
              for (int c = 0; c < 4; ++c) { const float lo = bf2f(aw[j][c] & 0xffffu), hv = __uint_as_float(aw[j][c] & 0xffff0000u); ss += lo * lo + hv * hv; }
              bf16x8 a; { union { u32x4 u; bf16x8 v; } cv; cv.u = aw[j]; a = cv.v; }
              acc = __builtin_amdgcn_mfma_f32_32x32x16_bf16(a, w2[j], acc, 0, 0, 0);
              acc = __builtin_amdgcn_mfma_f32_32x32x16_bf16(a, w1[j], acc, 0, 0, 0);
              acc = __builtin_amdgcn_mfma_f32_32x32x16_bf16(a, w0[j], acc, 0, 0, 0); } } }
    ss = at::halves_sum(ss);
    if (kh == 1) {
#pragma unroll
        for (int r = 0; r < 16; ++r) buf[(tile * 16 + r) * 64 + lane] = acc[r];
        if (hi == 0) SS[tile * 32 + r32] = ss; }
    __syncthreads();
    int se[4] = {0, 0, 0, 0}, sr[4] = {0, 0, 0, 0}; float sw[4] = {0.f, 0.f, 0.f, 0.f};
    if (kh == 0) {
#pragma unroll
        for (int r = 0; r < 16; ++r) acc[r] += buf[(tile * 16 + r) * 64 + lane];
        ss += SS[tile * 32 + r32];
        const float rstd = rsqrtf(ss * (1.0f / D) + EPS);
        if (hi == 0) RS[tile * 32 + r32] = rstd;
        asm volatile("s_waitcnt lgkmcnt(0)" ::: "memory");
        const float cbe = cb[b * NE + r32];
#pragma unroll
        for (int r = 0; r < 16; ++r) { const int tk = at::crow(r, hi); LG[(tile * 32 + tk) * 33 + r32] = RS[tile * 32 + tk] * acc[r] + cbe; }
        asm volatile("s_waitcnt lgkmcnt(0)" ::: "memory");
        if (lane < 32) {
            float lg[32];
#pragma unroll
            for (int e = 0; e < 32; ++e) lg[e] = LG[(tile * 32 + lane) * 33 + e];
            float tv[4];
#pragma unroll
            for (int kk = 0; kk < 4; ++kk) { float bv = -INFINITY; int bi = 0;
#pragma unroll
                for (int e = 0; e < 32; ++e) { const bool tk = lg[e] > bv; bv = tk ? lg[e] : bv; bi = tk ? e : bi; }
                tv[kk] = bv; se[kk] = bi;
#pragma unroll
                for (int e = 0; e < 32; ++e) lg[e] = (e == bi) ? -INFINITY : lg[e]; }
            float sum = 0.f;
#pragma unroll
            for (int kk = 0; kk < 4; ++kk) { sw[kk] = __expf(tv[kk] - tv[0]); sum += sw[kk]; }
            const float inv = 1.0f / sum;
#pragma unroll
            for (int kk = 0; kk < 4; ++kk) { sw[kk] *= inv; sr[kk] = atomicAdd((int*)(hist + se[kk]), 1); }
        }
    }
    __syncthreads();
    if (tid < 32) basep[tid] = atomicAdd(cnt + tid * CNT_STRIDE, hist[tid]);
    __syncthreads();
    if (kh == 0 && lane < 32) { const int t = t0 + lane;
#pragma unroll
        for (int kk = 0; kk < 4; ++kk) { const int e = se[kk], pos = basep[e] + sr[kk];
            toke[t * 4 + kk] = e; tokp[t * 4 + kk] = pos; list[(size_t)e * CAP + pos] = t; listw[(size_t)e * CAP + pos] = sw[kk]; } }
    { f32x4 gm[4], shv[4];
#pragma unroll
      for (int j = 0; j < 4; ++j) { const f32x4 g = *((const f32x4*)gain2 + lane + 64 * j), c1 = *((const f32x4*)(modl + (size_t)b * 6144 + 4 * D) + lane + 64 * j);
          gm[j] = g * (1.0f + c1); shv[j] = *((const f32x4*)(modl + (size_t)b * 6144 + 3 * D) + lane + 64 * j); }
#pragma unroll 1
      for (int i0 = 0; i0 < 16; i0 += 8) {
          u32x2 xw[8][4]; float rs[8];
#pragma unroll
          for (int q = 0; q < 8; ++q) { const int rr = 16 * w + i0 + q; rs[q] = RS[rr]; const u32x2* xr = (const u32x2*)(X + (size_t)(128 * vb + rr) * D) + lane;
#pragma unroll
              for (int j = 0; j < 4; ++j) xw[q][j] = xr[64 * j]; }
#pragma unroll
          for (int q = 0; q < 8; ++q) { u32x2* ho = (u32x2*)(H + (size_t)(128 * vb + 16 * w + i0 + q) * D) + lane;
#pragma unroll
              for (int j = 0; j < 4; ++j) { const u32x2 x2 = xw[q][j]; const f32x4 xv = {bf2f(x2.x & 0xffffu), bf2f(x2.x >> 16), bf2f(x2.y & 0xffffu), bf2f(x2.y >> 16)};
                  const f32x4 v = (xv * rs[q]) * gm[j] + shv[j]; u32x2 o; o.x = pg::cvt_pk_bf16(v[0], v[1]); o.y = pg::cvt_pk_bf16(v[2], v[3]); ho[64 * j] = o; } } } }
    __syncthreads();
}

template <int MPR  , bool GATHER>
__device__ __forceinline__ void moe_tables(volatile LAS unsigned* LC, LAS unsigned short* gtab, const int* cnt, const int* list, int wv) {
    const int tid = tid_of(wv);
    if (tid < NE) LC[LC_CNT + tid] = (unsigned)cnt[tid * CNT_STRIDE];
    __syncthreads();
    if (tid <= NE) LC[LC_TPF + tid] = (unsigned)tile_prefix(LC + LC_CNT, tid);
    __syncthreads();
    if (tid < pg::GTAB_UNITS) { pg::Unit u; const bool ok = pg::moe_unit<(GATHER ? 8 : 4)>(LC, (int)blockIdx.x, (int)gridDim.x, tid, u);
        LC[LC_UT + tid] = ok ? (0x80000000u | (unsigned)u.pm | ((unsigned)u.pn << 10) | ((unsigned)u.e << 13)) : 0u; }
    __syncthreads();
    if (GATHER) {
        const LAS unsigned* L = (const LAS unsigned*)LC;
        int tok[pg::GTAB_UNITS / 2];
#pragma unroll
        for (int k = 0; k < pg::GTAB_UNITS / 2; ++k) { const int i = 2 * k + (tid >> 8), r = tid & 255; const unsigned w = L[LC_UT + i]; tok[k] = 0;
            if (w >> 31) { const int e = (int)((w >> 13) & 31u), mg = (int)(w & 1023u); int pos = (mg - (int)L[LC_TPF + e]) * 256 + r; const int cn = (int)L[LC_CNT + e]; pos = pos < cn ? pos : cn - 1; tok[k] = list[(size_t)e * CAP + pos]; } }
#pragma unroll
        for (int k = 0; k < pg::GTAB_UNITS / 2; ++k) gtab[(2 * k + (tid >> 8)) * 256 + (tid & 255)] = (unsigned short)tok[k];
        __syncthreads();
    }
}

__device__ __forceinline__ void conv_drain(KArgs ka, unsigned char* ws, LAS unsigned char* lds, volatile LAS unsigned* LC, int wv_, int need) {
    const int wv = opaque_s(wv_);
    unsigned* q = (unsigned*)ws + CW_CONVQ;
    const int lane = opaque(lane_id());
    LAS float* scr = (LAS float*)lds + wv * (64 * 33 + 16);
    bf16_t* wt = (bf16_t*)(ws + WS_WT);
    constexpr int NPW = 4;
#pragma unroll 1
    for (;;) {
        if (wv == 0 && lane == 0) {
            const unsigned head = __hip_atomic_load(q, __ATOMIC_RELAXED, __HIP_MEMORY_SCOPE_AGENT);
            LC[LC_CVQ] = ((int)head >= need) ? 0xffffffffu : __hip_atomic_fetch_add(q, (unsigned)(NWAVES * NPW), __ATOMIC_RELAXED, __HIP_MEMORY_SCOPE_AGENT); }
        __syncthreads();
        const unsigned bw = (unsigned)__builtin_amdgcn_readfirstlane((int)LC[LC_CVQ]);
        __syncthreads();
        if (bw == 0xffffffffu) break;
        const int base = (int)bw;
#pragma unroll 1
        for (int k = 0; k < NPW; ++k) { const int it = base + k * NWAVES + wv; if (it < CV_N) conv_item(ka, wt, it, scr, lane); }
        if (base + NWAVES * NPW >= need) break;
    }
}
template <int NN>
__device__ __forceinline__ void moe_tail(KArgs ka, unsigned char* ws, LAS unsigned char* lds, volatile LAS unsigned* LCv, int wv) {
    const LAS unsigned* LC = (const LAS unsigned*)LCv;
    int mine = 0;
#pragma unroll 1
    for (int i = 0; i < pg::GTAB_UNITS; ++i) mine += (int)(LC[LC_UT + i] >> 31);
    mine = __builtin_amdgcn_readfirstlane(mine);
    const int U = (int)LC[LC_TPF + NE] * NN, W = opaque_s((int)gridDim.x) >> 3, mx = __builtin_amdgcn_readfirstlane((((U + 7) >> 3) + W - 1) / W);
    if (mine < mx) conv_tail(ka, ws, lds, (volatile LAS unsigned*)LCv, wv, CV_QUOTA * (mx - mine));
}

constexpr int PH_END = 34;
__device__ __forceinline__ KArgs kargs() { auto p = __builtin_amdgcn_kernarg_segment_ptr(); asm volatile("" : "+s"(p)); return (KArgs)p; }
__global__ void __launch_bounds__(NTHR, 2) mega(MArgs args_unused) {
    extern __shared__ __attribute__((aligned(16))) unsigned char lds_raw[];
    LAS unsigned char* lds = (LAS unsigned char*)lds_raw;
    volatile LAS unsigned* LC = (volatile LAS unsigned*)(lds + LDS_CTL);
    const int wv = __builtin_amdgcn_readfirstlane((int)threadIdx.x >> 6);
#define TID() opaque(tid_of(wv))
#define GW() opaque_s((int)blockIdx.x * NWAVES + wv)
    for (int u = TID(); u < (LDS_BYTES - LDS_CTL) / 4; u += NTHR) LC[u] = 0u;
    __syncthreads();
    XcdBarrier bar;
    { KArgs ka = kargs(); bar = xcd_barrier_post((unsigned*)ka->ws + CW_BAR + ka->li * XCD_BAR_WORDS, LC + LC_BAR, wv); }
#define SEAM() do { xcd_barrier(bar); if (PROBE_KIND == 9) for (int r_ = 0; r_ < PROBE_REPS; ++r_) xcd_barrier(bar); } while (0)
    {
        KArgs ka = kargs(); unsigned char* ws = ka->ws;
        p0_mod(ka->in[I_C], ka->in[I_WADA], ka->in[I_BADA], (float*)(ws + WS_MOD), (LAS float*)lds, wv);
        __syncthreads();
        conv_flush(ka, ws, lds, wv, CV_S1);
    }
    SEAM();
#pragma unroll 1
    for (int l = 0; l < NL; ++l) {
        {
            const int lq = opaque_s(l); KArgs ka = kargs(); unsigned char* ws = ka->ws; const int G = opaque_s((int)gridDim.x);
            const float* modl = (const float*)(ws + WS_MOD) + (size_t)lq * NB * 6144; bf16_t* XB = (bf16_t*)(ws + WS_XB); int* cnt = (int*)(ws + CTL_CNT);
            NormP p{};
            p.xin = (lq == 0) ? ka->in[I_X] : nullptr; p.xinb = XB; p.X = nullptr; p.Xb = XB; p.H = (bf16_t*)(ws + WS_H); p.mod = modl; p.modprev = (lq == 0) ? nullptr : modl - (size_t)NB * 6144;
            p.gain = ka->in[I_NGAIN] + (size_t)(lq * 2 + 0) * D; p.Y = (const bf16_t*)(ws + WS_Y); p.toke = (const int*)(ws + WS_TOKE); p.tokp = (const int*)(ws + WS_TOKP); p.cntprev = cnt + (lq > 0 ? (lq - 1) * NE * CNT_STRIDE : 0);
            p.wf = ka->in[I_WIN] + (size_t)lq * D * DIN + 768; p.bf = ka->in[I_BF] + lq * 4; p.lf = (float*)(ws + WS_LF);
            if (lq > 0) { const int tid = TID(); if (tid < NE) LC[LC_CNT + tid] = (unsigned)p.cntprev[tid * CNT_STRIDE]; __syncthreads();
                if (tid <= NE) LC[LC_SEG + tid] = (unsigned)(tile_prefix(LC + LC_CNT, tid) << 8); __syncthreads(); }
            { const int tid = TID(); LAS f32x4* wfL = (LAS f32x4*)lds;
              f32x4 wq[2];
#pragma unroll
              for (int h = 0; h < 2; ++h) { const int q = tid + h * NTHR, ln = q & 63, ji = q >> 6; wq[h] = *(const f32x4*)(p.wf + (size_t)(4 * ln + 256 * (ji >> 2) + (ji & 3)) * DIN); }
              wfL[tid] = wq[0]; wfL[tid + NTHR] = wq[1];
              __syncthreads(); }
            norm1_wave<false>(p, GW(), G * NWAVES, TID() & 63, (const int*)(lds_raw + LDS_CTL) + LC_SEG, (LAS f32x4*)lds);
            if (PROBE_KIND == 0 && PROBE_REPS > 0) { __syncthreads(); p.xin = nullptr; p.modprev = nullptr; norm1_wave<false>(p, GW(), G * NWAVES, TID() & 63, (const int*)(lds_raw + LDS_CTL) + LC_SEG, (LAS f32x4*)lds); }
            __syncthreads();
            router_prep(modl, ka->in[I_NGAIN] + (size_t)(lq * 2 + 1) * D, ka->in[I_WR] + (size_t)lq * D * NE, ka->in[I_BR] + lq * NE, (bf16_t*)(ws + WS_WGT), (float*)(ws + WS_CB), wv);
            if (lq > 0) conv_flush(ka, ws, lds, wv, lq * CV_PER_L + CV_S1);
        }
        SEAM();
        {
            const int lq = opaque_s(l); KArgs ka = kargs(); unsigned char* ws = ka->ws;
            conv_raise(ws, wv, lq * CV_PER_L + CV_S1);
            pg::GIn g; g.ord.init(T / 256, PW / 256, (int)gridDim.x, (int)blockIdx.x); g.A = (const bf16_t*)(ws + WS_H); g.Bt = (const bf16_t*)(ws + WS_WT) + (size_t)lq * WT_LAYER + WT_IN; g.PROJ = (bf16_t*)(ws + WS_PROJ);
            g.qkg = ka->in[I_QKG] + lq * 6 * 64; g.kmean = (float*)(ws + CTL_KMEAN) + (size_t)lq * NB * 16 * 256;
            for (int rep = 0; rep < 1 + (PROBE_KIND == 1 ? PROBE_REPS : 0); ++rep) { g.dry = rep; pg::gemm_phase(lds, g, wv); }
            { const int nwg = (T / 256) * (PW / 256), G = opaque_s((int)gridDim.x), mine = (nwg - opaque_s((int)blockIdx.x) + G - 1) / G, mx = (nwg + G - 1) / G;
              if (mine < mx) conv_tail(ka, ws, lds, LC, wv, CV_QUOTA * (mx - mine)); }
        }
        SEAM();
        {
            const int lq = opaque_s(l); KArgs ka = kargs(); unsigned char* ws = ka->ws;
            at::attn_phase(lds, lq, (const bf16_t*)(ws + WS_PROJ), (const float*)(ws + WS_LF), (const float*)(ws + CTL_KMEAN) + (size_t)lq * NB * 16 * 256, ka->in[I_SINK] + lq * 8, (bf16_t*)(ws + WS_OCAT), wv, ka->in[I_QKG] + lq * 6 * 64,
                           (unsigned short*)(ws + WS_MSEL), (unsigned short*)(ws + WS_MLIST), (int*)(ws + CTL_MCNT) + lq * NB * 4 * 16);
        }
        SEAM();
        {
            const int lq = opaque_s(l); KArgs ka = kargs(); unsigned char* ws = ka->ws;
            at::moba_gather_phase(lds, LC, (const bf16_t*)(ws + WS_PROJ), (const unsigned short*)(ws + WS_MSEL), (const unsigned short*)(ws + WS_MLIST), (const int*)(ws + CTL_MCNT) + lq * NB * 4 * 16, (bf16_t*)(ws + WS_MPO), (float*)(ws + WS_MPML), wv);
        }
        SEAM();
        {
            KArgs ka = kargs(); unsigned char* ws = ka->ws;
            at::moba_own_phase(lds, (const bf16_t*)(ws + WS_PROJ), (const unsigned short*)(ws + WS_MSEL), (bf16_t*)(ws + WS_MPO), (float*)(ws + WS_MPML), (bf16_t*)(ws + WS_OCAT), wv);
        }
        SEAM();
        {
            const int lq = opaque_s(l); KArgs ka = kargs(); unsigned char* ws = ka->ws;
            pg::GBranch g; g.ord.init(T / 256, D / 256, (int)gridDim.x, (int)blockIdx.x); g.A = (const bf16_t*)(ws + WS_OCAT); g.Bt = (const bf16_t*)(ws + WS_WT) + (size_t)lq * WT_LAYER + WT_BR; g.PROJ = (const bf16_t*)(ws + WS_PROJ); g.MERGED = (bf16_t*)(ws + WS_MERGED);
            for (int rep = 0; rep < 1 + (PROBE_KIND == 3 ? PROBE_REPS : 0); ++rep) { g.dry = rep; pg::gemm_phase(lds, g, wv); }
        }
        SEAM();
        {
            const int lq = opaque_s(l); KArgs ka = kargs(); unsigned char* ws = ka->ws;
            pg::GOut g; g.ord.init(T / 256, D / 256, (int)gridDim.x, (int)blockIdx.x); g.A = (const bf16_t*)(ws + WS_MERGED); g.Bt = (const bf16_t*)(ws + WS_WT) + (size_t)lq * WT_LAYER + WT_OUT; g.X = (bf16_t*)(ws + WS_XB); g.modl = (const float*)(ws + WS_MOD) + (size_t)lq * NB * 6144;
            for (int rep = 0; rep < 1 + (PROBE_KIND == 4 ? PROBE_REPS : 0); ++rep) { g.dry = rep; pg::gemm_phase(lds, g, wv); }
        }
        SEAM();
        {
            const int lq = opaque_s(l); KArgs ka = kargs(); unsigned char* ws = ka->ws; const int G = opaque_s((int)gridDim.x);
            for (int vb = blockIdx.x; vb < T / 128; vb += G) norm2_router(lds, vb, (const bf16_t*)(ws + WS_XB), (bf16_t*)(ws + WS_H), (const float*)(ws + WS_MOD) + (size_t)lq * NB * 6144, ka->in[I_NGAIN] + (size_t)(lq * 2 + 1) * D, (const bf16_t*)(ws + WS_WGT), (const float*)(ws + WS_CB),
                                                                         (int*)(ws + CTL_CNT) + lq * NE * CNT_STRIDE, (int*)(ws + WS_TOKE), (int*)(ws + WS_TOKP), (int*)(ws + WS_LIST), (float*)(ws + WS_LISTW), wv);
            conv_flush(ka, ws, lds, wv, lq * CV_PER_L + CV_S1 + CV_1);
            if (PROBE_KIND == 5 && PROBE_REPS > 0) __syncthreads();
            if (PROBE_KIND == 5 && PROBE_REPS > 0)
                for (int vb = blockIdx.x; vb < T / 128; vb += G) norm2_router(lds, vb, (const bf16_t*)(ws + WS_XB), (bf16_t*)(ws + WS_H), (const float*)(ws + WS_MOD) + (size_t)lq * NB * 6144, ka->in[I_NGAIN] + (size_t)(lq * 2 + 1) * D, (const bf16_t*)(ws + WS_WGT), (const float*)(ws + WS_CB),
                                                                             (int*)(ws + CTL_CNT) + (NL + lq) * NE * CNT_STRIDE, (int*)(ws + 1160 * MiB), (int*)(ws + 1161 * MiB), (int*)(ws + 1162 * MiB), (float*)(ws + 1168 * MiB), wv);
        }
        SEAM();
        {
            const int lq = opaque_s(l); KArgs ka = kargs(); unsigned char* ws = ka->ws;
            conv_raise(ws, wv, lq * CV_PER_L + CV_S1 + CV_1);
            moe_tables<32, true>(LC, (LAS unsigned short*)(lds + pg::LDS_GTAB), (const int*)(ws + CTL_CNT) + lq * NE * CNT_STRIDE, (const int*)(ws + WS_LIST), wv);
            pg::GMoe1 g; g.LC = LC; g.gtab = (const LAS unsigned short*)(lds + pg::LDS_GTAB); g.A = (const bf16_t*)(ws + WS_H); g.Bt = (const bf16_t*)(ws + WS_WT) + (size_t)lq * WT_LAYER + WT_W1; g.b1 = ka->in[I_B1] + (size_t)lq * NE * 2048; g.A2 = (bf16_t*)(ws + WS_A2); g.c = (int)blockIdx.x;
            for (int rep = 0; rep < 1 + (PROBE_KIND == 6 ? PROBE_REPS : 0); ++rep) { g.dry = rep; pg::gemm_phase(lds, g, wv); }
            moe_tail<8>(ka, ws, lds, LC, wv);
            __syncthreads();
            conv_drain(ka, ws, lds, LC, wv, (lq + 1) * CV_PER_L);
        }
        SEAM();
        {
            const int lq = opaque_s(l); KArgs ka = kargs(); unsigned char* ws = ka->ws;
            moe_tables<64, false>(LC, nullptr, (const int*)(ws + CTL_CNT) + lq * NE * CNT_STRIDE, (const int*)(ws + WS_LIST), wv);
            pg::GMoe2 g; g.LC = LC; g.A = (const bf16_t*)(ws + WS_A2); g.Bt = (const bf16_t*)(ws + WS_WT) + (size_t)lq * WT_LAYER + WT_W2; g.b2 = ka->in[I_B2] + (size_t)lq * NE * D; g.listw = (const float*)(ws + WS_LISTW); g.Y = (bf16_t*)(ws + WS_Y); g.c = (int)blockIdx.x;
            for (int rep = 0; rep < 1 + (PROBE_KIND == 7 ? PROBE_REPS : 0); ++rep) { g.dry = rep; pg::gemm_phase(lds, g, wv); }
            moe_tail<4>(ka, ws, lds, LC, wv);
        }
        SEAM();
    }
    {
        KArgs ka = kargs(); unsigned char* ws = ka->ws; const int G = opaque_s((int)gridDim.x);
        NormP p{}; p.xin = nullptr; p.xinb = (const bf16_t*)(ws + WS_XB); p.X = ka->out; p.Xb = nullptr; p.modprev = (const float*)(ws + WS_MOD) + (size_t)(NL - 1) * NB * 6144; p.Y = (const bf16_t*)(ws + WS_Y); p.toke = (const int*)(ws + WS_TOKE); p.tokp = (const int*)(ws + WS_TOKP); p.cntprev = (const int*)(ws + CTL_CNT) + (NL - 1) * NE * CNT_STRIDE;
        { const int tid = TID(); if (tid < NE) LC[LC_CNT + tid] = (unsigned)p.cntprev[tid * CNT_STRIDE]; __syncthreads();
          if (tid <= NE) LC[LC_SEG + tid] = (unsigned)(tile_prefix(LC + LC_CNT, tid) << 8); __syncthreads(); }
        norm1_wave<true>(p, GW(), G * NWAVES, TID() & 63, (const int*)(lds_raw + LDS_CTL) + LC_SEG, (LAS f32x4*)lds);
    }
#undef SEAM
#undef GW
#undef TID
}

static int g_grid = 0;
static void launch_mega(const float* const* in, float* out, unsigned char* ws, int lo, int hi, int li, hipStream_t stream) {
    MArgs a; memset(&a, 0, sizeof(a));
    for (int i = 0; i < 19; ++i) a.in[i] = in[i];
    a.out = out; a.ws = ws; a.ph_lo = lo; a.ph_hi = hi; a.li = li; a.pad = 0;
    hipLaunchKernelGGL(mega, dim3(g_grid), dim3(NTHR), LDS_BYTES, stream, a);
    const hipError_t le = hipPeekAtLastError();
    if (le != hipSuccess) fprintf(stderr, "kernel_launch: mega launch [%d,%d) failed: %s\n", lo, hi, hipGetErrorName(le));
}
extern "C" void kernel_launch(void* const* d_in, const int* in_sizes, int n_in, void* d_out, int out_size, void* d_ws, size_t ws_size, hipStream_t stream) {
    if (n_in != 19 || out_size != T * D || ws_size < WS_END) { fprintf(stderr, "kernel_launch: unexpected shapes (n_in %d out %d ws %zu need %zu)\n", n_in, out_size, ws_size, (size_t)WS_END); return; }
    if (g_grid == 0) {
        int dev = 0, cus = 0, per_cu = 0;
        if (hipGetDevice(&dev) != hipSuccess || hipDeviceGetAttribute(&cus, hipDeviceAttributeMultiprocessorCount, dev) != hipSuccess) { g_grid = -1; return; }
        if (hipFuncSetAttribute((const void*)mega, hipFuncAttributeMaxDynamicSharedMemorySize, LDS_BYTES) != hipSuccess) { fprintf(stderr, "kernel_launch: hipFuncSetAttribute failed\n"); g_grid = -1; return; }
        if (hipOccupancyMaxActiveBlocksPerMultiprocessor(&per_cu, (const void*)mega, NTHR, LDS_BYTES) != hipSuccess || per_cu < 1) { fprintf(stderr, "kernel_launch: occupancy query says %d\n", per_cu); }
        (void)hipGetLastError();
        g_grid = cus;
    }
    if (g_grid < 0) return;
    const float* const* in = (const float* const*)d_in;
    unsigned char* ws = (unsigned char*)d_ws;
    (void)in_sizes;
    (void)hipMemsetAsync(ws + WS_CTL, 0, CTL_BYTES, stream);
    launch_mega(in, (float*)d_out, ws, 0, PH_END, 0, stream);
}
```
